# Optimizing an MI355X kernel written in HIP

```python
import jax, jax.numpy as jnp
from jax import lax
import numpy as np

D_MODEL = 1024
BATCH = 4
SEQ = 4096
DEPTH = 2

CHUNK = 64
EPS = 1e-6

HEAD_DIM = 64
ATTN_WIDTH = D_MODEL // 2
ATTN_HEADS = ATTN_WIDTH // HEAD_DIM
ROPE_DIM = HEAD_DIM // 4
ROPE_THETA = 500000.0
IDX_HEADS = 4
IDX_DIM = 64
IDX_SCALE = (IDX_DIM ** -0.5) * (IDX_HEADS ** -0.5)
TOPK_MAX = 256
QBLOCK = 64

CONV_WIDTH = D_MODEL // 2
CONV_GROUPS = 8
CONV_K = 3

N_BRANCH = 2
MLP_HIDDEN = 4 * D_MODEL

PROJ_SIZES = (ATTN_WIDTH, ATTN_WIDTH, ATTN_WIDTH, IDX_HEADS * IDX_DIM, IDX_DIM, IDX_HEADS,
              CONV_WIDTH, CONV_WIDTH, CONV_WIDTH, N_BRANCH * D_MODEL)
IN_COLS = sum(PROJ_SIZES)

kernel_name = "hybrid_dsa_shortconv_gated_trunk"


def rmsnorm(x, g):
    xf = x.astype(jnp.float32)
    y = xf * lax.rsqrt(jnp.mean(xf * xf, axis=-1, keepdims=True) + EPS)
    return (y * g.astype(jnp.float32)).astype(x.dtype)


def rope_tables(T):
    inv = 1.0 / (ROPE_THETA ** (jnp.arange(0, ROPE_DIM, 2, dtype=jnp.float32) / ROPE_DIM))
    ang = jnp.arange(T, dtype=jnp.float32)[:, None] * inv[None, :]
    return jnp.cos(ang), jnp.sin(ang)


def apply_partial_rope(x, cos, sin):
    half = ROPE_DIM // 2
    xr = x[..., :ROPE_DIM].astype(jnp.float32)
    x1, x2 = xr[..., :half], xr[..., half:]
    c = cos[None, :, None, :]
    s = sin[None, :, None, :]
    rot = jnp.concatenate([x1 * c - x2 * s, x2 * c + x1 * s], axis=-1)
    return jnp.concatenate([rot.astype(x.dtype), x[..., ROPE_DIM:]], axis=-1)


def dsa_attention(q, k, v, iq, ik, iw):
    B, T, H, Dh = q.shape
    topk = min(TOPK_MAX, T // 4)
    nblk = T // QBLOCK
    key_pos = jnp.arange(T)
    scale = Dh ** -0.5
    ikf = ik.astype(jnp.float32)

    def block(i):
        t0 = i * QBLOCK
        qb = lax.dynamic_slice_in_dim(q, t0, QBLOCK, axis=1)
        iqb = lax.dynamic_slice_in_dim(iq, t0, QBLOCK, axis=1).astype(jnp.float32)
        iwb = lax.dynamic_slice_in_dim(iw, t0, QBLOCK, axis=1).astype(jnp.float32)
        tpos = t0 + jnp.arange(QBLOCK)
        limit = (tpos // CHUNK + 1) * CHUNK
        admissible = key_pos[None, :] < limit[:, None]
        logits = jnp.einsum('bthd,bsd->bths', iqb, ikf)
        score = jnp.einsum('bths,bth->bts', jax.nn.relu(logits), iwb) * IDX_SCALE
        score = jnp.where(admissible[None], score, -jnp.inf)
        _, idx = lax.top_k(score, topk)
        valid = idx < limit[None, :, None]
        kg = jax.vmap(lambda kk, ii: kk[ii])(k, idx)
        vg = jax.vmap(lambda vv, ii: vv[ii])(v, idx)
        s = jnp.einsum('bthd,btkhd->bthk', qb, kg).astype(jnp.float32) * scale
        s = jnp.where(valid[:, :, None, :], s, -jnp.inf)
        p = jax.nn.softmax(s, axis=-1).astype(v.dtype)
        return jnp.einsum('bthk,btkhd->bthd', p, vg)

    out = lax.map(block, jnp.arange(nblk))
    return out.transpose(1, 0, 2, 3, 4).reshape(B, T, H * Dh)


def short_conv(xc, conv_w):
    T = xc.shape[1]
    xp = jnp.pad(xc, ((0, 0), (CONV_K - 1, 0), (0, 0)))
    out = xp[:, 0:T] * conv_w[0]
    for j in range(1, CONV_K):
        out = out + xp[:, j:j + T] * conv_w[j]
    return out


def setup_inputs(seed: int = 0) -> dict:
    key = jax.random.key(seed)
    ks = jax.random.split(key, 12)
    f32 = jnp.float32
    x = jax.random.normal(ks[0], (BATCH, SEQ, D_MODEL), f32)
    norm_mix = 1.0 + 0.02 * jax.random.normal(ks[1], (DEPTH, D_MODEL), f32)
    w_in = jax.random.normal(ks[2], (DEPTH, D_MODEL, IN_COLS), f32) * D_MODEL ** -0.5
    conv_w = jax.random.normal(ks[3], (DEPTH, CONV_K, CONV_WIDTH), f32) * CONV_K ** -0.5
    w_attn_out = jax.random.normal(ks[4], (DEPTH, ATTN_WIDTH, D_MODEL), f32) * ATTN_WIDTH ** -0.5
    w_conv_out = jax.random.normal(ks[5], (DEPTH, CONV_WIDTH, D_MODEL), f32) * CONV_WIDTH ** -0.5
    w_mix_out = jax.random.normal(ks[6], (DEPTH, D_MODEL, D_MODEL), f32) * D_MODEL ** -0.5
    norm_mlp = 1.0 + 0.02 * jax.random.normal(ks[7], (DEPTH, D_MODEL), f32)
    w_mlp_up = jax.random.normal(ks[8], (DEPTH, D_MODEL, MLP_HIDDEN), f32) * D_MODEL ** -0.5
    w_mlp_down = jax.random.normal(ks[9], (DEPTH, MLP_HIDDEN, D_MODEL), f32) * MLP_HIDDEN ** -0.5
    norm_final = 1.0 + 0.02 * jax.random.normal(ks[10], (D_MODEL,), f32)
    return {"x": x, "norm_mix": norm_mix, "w_in": w_in, "conv_w": conv_w,
            "w_attn_out": w_attn_out, "w_conv_out": w_conv_out, "w_mix_out": w_mix_out,
            "norm_mlp": norm_mlp, "w_mlp_up": w_mlp_up, "w_mlp_down": w_mlp_down,
            "norm_final": norm_final}


def reference(x, norm_mix, w_in, conv_w, w_attn_out, w_conv_out, w_mix_out,
              norm_mlp, w_mlp_up, w_mlp_down, norm_final):
    B, T, D = x.shape
    cos, sin = rope_tables(T)
    offsets = np.cumsum(PROJ_SIZES)[:-1].tolist()
    for l in range(DEPTH):
        u = rmsnorm(x, norm_mix[l])
        proj = u @ w_in[l]
        q, k, v, iq, ik, iw, cB, cC, ch, g = jnp.split(proj, offsets, axis=-1)
        q = apply_partial_rope(q.reshape(B, T, ATTN_HEADS, HEAD_DIM), cos, sin)
        k = apply_partial_rope(k.reshape(B, T, ATTN_HEADS, HEAD_DIM), cos, sin)
        v = v.reshape(B, T, ATTN_HEADS, HEAD_DIM)
        iq = apply_partial_rope(iq.reshape(B, T, IDX_HEADS, IDX_DIM), cos, sin)
        ik = apply_partial_rope(ik[:, :, None, :], cos, sin)[:, :, 0, :]
        y_attn = dsa_attention(q, k, v, iq, ik, iw) @ w_attn_out[l]
        y_conv = (cB * short_conv(cC * ch, conv_w[l])) @ w_conv_out[l]
        gates = jax.nn.sigmoid(g.reshape(B, T, N_BRANCH, D))
        merged = gates[:, :, 0] * y_attn + gates[:, :, 1] * y_conv
        x = x + merged @ w_mix_out[l]
        u = rmsnorm(x, norm_mlp[l])
        x = x + jnp.square(jax.nn.relu(u @ w_mlp_up[l])) @ w_mlp_down[l]
    return rmsnorm(x, norm_final)
```

```cpp
#include <hip/hip_runtime.h>
#include <stdint.h>
#include <math.h>

#define D_MODEL 1024
#define BATCH 4
#define SEQ 4096
#define DEPTH 2
#define IN_COLS 5444
#define MLP_H 4096
#define OFF_Q 0
#define OFF_K 512
#define OFF_V 1024
#define OFF_IQ 1536
#define OFF_IK 1792
#define OFF_IW 1856
#define OFF_CB 1860
#define OFF_CC 2372
#define OFF_CH 2884
#define OFF_G 3396

__device__ __forceinline__ float wave_sum_f(float v) {
#pragma unroll
    for (int o = 32; o >= 1; o >>= 1) v += __shfl_xor(v, o);
    return v;
}
__device__ __forceinline__ float wave_max_f(float v) {
#pragma unroll
    for (int o = 32; o >= 1; o >>= 1) v = fmaxf(v, __shfl_xor(v, o));
    return v;
}
__device__ __forceinline__ int wave_sum_i(int v) {
#pragma unroll
    for (int o = 32; o >= 1; o >>= 1) v += __shfl_xor(v, o);
    return v;
}
__device__ __forceinline__ float block_sum_f(float v, float* red) {
    v = wave_sum_f(v);
    __syncthreads();
    if ((threadIdx.x & 63) == 0) red[threadIdx.x >> 6] = v;
    __syncthreads();
    return (red[0] + red[1]) + (red[2] + red[3]);
}
__device__ __forceinline__ float block_max_f(float v, float* red) {
    v = wave_max_f(v);
    __syncthreads();
    if ((threadIdx.x & 63) == 0) red[threadIdx.x >> 6] = v;
    __syncthreads();
    return fmaxf(fmaxf(red[0], red[1]), fmaxf(red[2], red[3]));
}
__device__ __forceinline__ int block_sum_i(int v, int* red) {
    v = wave_sum_i(v);
    __syncthreads();
    if ((threadIdx.x & 63) == 0) red[threadIdx.x >> 6] = v;
    __syncthreads();
    return (red[0] + red[1]) + (red[2] + red[3]);
}

__global__ __launch_bounds__(256) void rmsnorm_k(const float* x, const float* __restrict__ g, float* y) {
    __shared__ float red[4];
    const int row = blockIdx.x, tid = threadIdx.x;
    const float4 v = ((const float4*)(x + (size_t)row * D_MODEL))[tid];
    float s = (v.x * v.x + v.y * v.y) + (v.z * v.z + v.w * v.w);
    s = block_sum_f(s, red);
    const float r = 1.0f / sqrtf(s * (1.0f / D_MODEL) + 1e-6f);
    const float4 gg = ((const float4*)g)[tid];
    float4 o; o.x = v.x * r * gg.x; o.y = v.y * r * gg.y; o.z = v.z * r * gg.z; o.w = v.w * r * gg.w;
    ((float4*)(y + (size_t)row * D_MODEL))[tid] = o;
}

template <int EPI>
__global__ __launch_bounds__(256) void gemm_f32(const float* __restrict__ A, int lda, const float* __restrict__ B, int ldb, float* C, int ldc, int M, int N, int K) {
    __shared__ float As[16][68];
    __shared__ float Bs[16][68];
    const int tid = threadIdx.x, tx = tid & 15, ty = tid >> 4;
    const int m0 = blockIdx.y * 64, n0 = blockIdx.x * 64;
    float acc[4][4];
#pragma unroll
    for (int i = 0; i < 4; ++i)
#pragma unroll
        for (int j = 0; j < 4; ++j) acc[i][j] = 0.f;
    const int ar = tid >> 2, ak = (tid & 3) * 4;
    const int bk = tid >> 4, bn = (tid & 15) * 4;
    const bool bok = (n0 + bn) < N;
    for (int k0 = 0; k0 < K; k0 += 16) {
        const float4 a = *(const float4*)(A + (size_t)(m0 + ar) * lda + k0 + ak);
        float4 b = make_float4(0.f, 0.f, 0.f, 0.f);
        if (bok) b = *(const float4*)(B + (size_t)(k0 + bk) * ldb + n0 + bn);
        __syncthreads();
        As[ak + 0][ar] = a.x; As[ak + 1][ar] = a.y; As[ak + 2][ar] = a.z; As[ak + 3][ar] = a.w;
        *(float4*)&Bs[bk][bn] = b;
        __syncthreads();
#pragma unroll
        for (int kk = 0; kk < 16; ++kk) {
            const float4 av = *(const float4*)&As[kk][ty * 4];
            const float4 bv = *(const float4*)&Bs[kk][tx * 4];
            const float aa[4] = {av.x, av.y, av.z, av.w};
            const float bb[4] = {bv.x, bv.y, bv.z, bv.w};
#pragma unroll
            for (int i = 0; i < 4; ++i)
#pragma unroll
                for (int j = 0; j < 4; ++j) acc[i][j] = fmaf(aa[i], bb[j], acc[i][j]);
        }
    }
    const int col = n0 + tx * 4;
    if (col < N) {
#pragma unroll
        for (int i = 0; i < 4; ++i) {
            float* cp = C + (size_t)(m0 + ty * 4 + i) * ldc + col;
            float4 o;
            if (EPI == 0) { o.x = acc[i][0]; o.y = acc[i][1]; o.z = acc[i][2]; o.w = acc[i][3]; }
            if (EPI == 1) { const float4 c = *(const float4*)cp; o.x = c.x + acc[i][0]; o.y = c.y + acc[i][1]; o.z = c.z + acc[i][2]; o.w = c.w + acc[i][3]; }
            if (EPI == 2) { float r0 = fmaxf(acc[i][0], 0.f), r1 = fmaxf(acc[i][1], 0.f), r2 = fmaxf(acc[i][2], 0.f), r3 = fmaxf(acc[i][3], 0.f); o.x = r0 * r0; o.y = r1 * r1; o.z = r2 * r2; o.w = r3 * r3; }
            *(float4*)cp = o;
        }
    }
}

__device__ __forceinline__ void sincos_acc(float ang_f, float& s_out, float& c_out) {
    const double a = (double)ang_f;
    const double q = rint(a * 0.63661977236758134308);
    double r = fma(-q, 1.57079632679489655800e+00, a);
    r = fma(-q, 6.12323399573676603587e-17, r);
    const double r2 = r * r;
    double sp = 1.0 / 6227020800.0; sp = fma(sp, r2, -1.0 / 39916800.0); sp = fma(sp, r2, 1.0 / 362880.0); sp = fma(sp, r2, -1.0 / 5040.0);
    sp = fma(sp, r2, 1.0 / 120.0); sp = fma(sp, r2, -1.0 / 6.0); sp = fma(sp, r2, 1.0);
    const double sn = sp * r;
    double cp = 1.0 / 87178291200.0; cp = fma(cp, r2, -1.0 / 479001600.0); cp = fma(cp, r2, 1.0 / 3628800.0); cp = fma(cp, r2, -1.0 / 40320.0);
    cp = fma(cp, r2, 1.0 / 720.0); cp = fma(cp, r2, -1.0 / 24.0); cp = fma(cp, r2, 0.5); cp = fma(-cp, r2, 1.0);
    const int qi = ((int)q) & 3;
    double s, c;
    if (qi == 0) { s = sn; c = cp; } else if (qi == 1) { s = cp; c = -sn; } else if (qi == 2) { s = -sn; c = -cp; } else { s = -cp; c = sn; }
    s_out = (float)s; c_out = (float)c;
}
__constant__ float ROPE_INV[8] = {1.0f, 0.193922758102417f, 0.03760603070259094f, 0.00729266507551074f, 0.001414213445968926f, 0.00027424818836152554f, 5.318296462064609e-05f, 1.0313385246263351e-05f};
__global__ __launch_bounds__(256) void rope_k(float* proj) {
    const int idx = blockIdx.x * 256 + threadIdx.x;
    if (idx >= SEQ * 21 * 8) return;
    const int j = idx & 7, hh = (idx >> 3) % 21, t = idx / (21 * 8);
    const int base = hh < 8 ? OFF_Q + hh * 64 : hh < 16 ? OFF_K + (hh - 8) * 64 : hh < 20 ? OFF_IQ + (hh - 16) * 64 : OFF_IK;
    float* p = proj + (size_t)t * IN_COLS + base;
    const float ang = (float)t * ROPE_INV[j];
    float s, c; sincos_acc(ang, s, c);
    const float x1 = p[j], x2 = p[8 + j];
    p[j] = x1 * c - x2 * s;
    p[8 + j] = x2 * c + x1 * s;
}

__global__ __launch_bounds__(256) void dsa_k(const float* __restrict__ proj, float* __restrict__ att) {
    __shared__ unsigned keys[4096];
    __shared__ float qs[512];
    __shared__ float iqs[256];
    __shared__ int sel[256];
    __shared__ float pw[256];
    __shared__ float red4[4][64];
    __shared__ float redf[4];
    __shared__ int redi[4];
    __shared__ int scan[256];
    const int t = blockIdx.x, tid = threadIdx.x;
    const int N = ((t >> 6) + 1) << 6;
    const float* row = proj + (size_t)t * IN_COLS;
    iqs[tid] = row[OFF_IQ + tid];
    qs[tid] = row[OFF_Q + tid]; qs[256 + tid] = row[OFF_Q + 256 + tid];
    const float w0 = row[OFF_IW], w1 = row[OFF_IW + 1], w2 = row[OFF_IW + 2], w3 = row[OFF_IW + 3];
    __syncthreads();
    for (int s = tid; s < N; s += 256) {
        const float4* ik = (const float4*)(proj + (size_t)s * IN_COLS + OFF_IK);
        float d0 = 0.f, d1 = 0.f, d2 = 0.f, d3 = 0.f;
#pragma unroll 4
        for (int d = 0; d < 16; ++d) {
            const float4 kv = ik[d];
            d0 = fmaf(iqs[4 * d], kv.x, d0); d0 = fmaf(iqs[4 * d + 1], kv.y, d0); d0 = fmaf(iqs[4 * d + 2], kv.z, d0); d0 = fmaf(iqs[4 * d + 3], kv.w, d0);
            d1 = fmaf(iqs[64 + 4 * d], kv.x, d1); d1 = fmaf(iqs[64 + 4 * d + 1], kv.y, d1); d1 = fmaf(iqs[64 + 4 * d + 2], kv.z, d1); d1 = fmaf(iqs[64 + 4 * d + 3], kv.w, d1);
            d2 = fmaf(iqs[128 + 4 * d], kv.x, d2); d2 = fmaf(iqs[128 + 4 * d + 1], kv.y, d2); d2 = fmaf(iqs[128 + 4 * d + 2], kv.z, d2); d2 = fmaf(iqs[128 + 4 * d + 3], kv.w, d2);
            d3 = fmaf(iqs[192 + 4 * d], kv.x, d3); d3 = fmaf(iqs[192 + 4 * d + 1], kv.y, d3); d3 = fmaf(iqs[192 + 4 * d + 2], kv.z, d3); d3 = fmaf(iqs[192 + 4 * d + 3], kv.w, d3);
        }
        float sc = 0.f;
        sc += fmaxf(d0, 0.f) * w0; sc += fmaxf(d1, 0.f) * w1; sc += fmaxf(d2, 0.f) * w2; sc += fmaxf(d3, 0.f) * w3;
        sc *= 0.0625f;
        const unsigned b = __float_as_uint(sc);
        keys[s] = (b & 0x80000000u) ? ~b : (b | 0x80000000u);
    }
    __syncthreads();
    int nsel;
    if (N <= 256) {
        nsel = N;
        if (tid < N) sel[tid] = tid;
    } else {
        nsel = 256;
        unsigned T = 0u;
        for (int bit = 31; bit >= 0; --bit) {
            const unsigned cand = T | (1u << bit);
            int c = 0;
            for (int s = tid; s < N; s += 256) c += (keys[s] >= cand) ? 1 : 0;
            c = block_sum_i(c, redi);
            if (c >= 256) T = cand;
        }
        const int base = tid * 16;
        int ng = 0, nt = 0;
#pragma unroll
        for (int i = 0; i < 16; ++i) { const int s = base + i; if (s < N) { const unsigned k = keys[s]; ng += (k > T) ? 1 : 0; nt += (k == T) ? 1 : 0; } }
        const int cg = block_sum_i(ng, redi);
        const int r = 256 - cg;
        int v = ng | (nt << 16);
        __syncthreads();
        scan[tid] = v;
        __syncthreads();
        for (int o = 1; o < 256; o <<= 1) {
            const int add = (tid >= o) ? scan[tid - o] : 0;
            __syncthreads();
            scan[tid] += add;
            __syncthreads();
        }
        const int ex = scan[tid] - v;
        int pg = ex & 0xffff, pt = ex >> 16;
#pragma unroll
        for (int i = 0; i < 16; ++i) {
            const int s = base + i;
            if (s < N) {
                const unsigned k = keys[s];
                if (k > T) { sel[pg] = s; ++pg; }
                else if (k == T) { if (pt < r) sel[cg + pt] = s; ++pt; }
            }
        }
    }
    __syncthreads();
    for (int h = 0; h < 8; ++h) {
        float sl = -INFINITY;
        if (tid < nsel) {
            const float4* kr = (const float4*)(proj + (size_t)sel[tid] * IN_COLS + OFF_K + h * 64);
            float d = 0.f;
#pragma unroll 4
            for (int i = 0; i < 16; ++i) { const float4 kv = kr[i]; d = fmaf(qs[h * 64 + 4 * i], kv.x, d); d = fmaf(qs[h * 64 + 4 * i + 1], kv.y, d); d = fmaf(qs[h * 64 + 4 * i + 2], kv.z, d); d = fmaf(qs[h * 64 + 4 * i + 3], kv.w, d); }
            sl = d * 0.125f;
        }
        const float mx = block_max_f(sl, redf);
        const float e = (tid < nsel) ? expf(sl - mx) : 0.f;
        const float sum = block_sum_f(e, redf);
        pw[tid] = e / sum;
        __syncthreads();
        const int d = tid & 63, part = tid >> 6;
        float acc = 0.f;
        for (int j = part; j < nsel; j += 4) acc = fmaf(pw[j], proj[(size_t)sel[j] * IN_COLS + OFF_V + h * 64 + d], acc);
        red4[part][d] = acc;
        __syncthreads();
        if (tid < 64) att[(size_t)t * 512 + h * 64 + tid] = (red4[0][tid] + red4[1][tid]) + (red4[2][tid] + red4[3][tid]);
        __syncthreads();
    }
}

__global__ __launch_bounds__(256) void conv_k(const float* __restrict__ proj, const float* __restrict__ cw, float* __restrict__ cm) {
    const int idx = blockIdx.x * 256 + threadIdx.x;
    const int t = idx >> 9, c = idx & 511;
    const float* p = proj + (size_t)t * IN_COLS;
    const float p0 = p[OFF_CC + c] * p[OFF_CH + c];
    const float p1 = (t >= 1) ? p[OFF_CC + c - IN_COLS] * p[OFF_CH + c - IN_COLS] : 0.f;
    const float p2 = (t >= 2) ? p[OFF_CC + c - 2 * IN_COLS] * p[OFF_CH + c - 2 * IN_COLS] : 0.f;
    const float o = cw[c] * p2 + cw[512 + c] * p1 + cw[1024 + c] * p0;
    cm[idx] = p[OFF_CB + c] * o;
}

__global__ __launch_bounds__(256) void merge_k(const float* __restrict__ proj, float* ya, const float* __restrict__ yc) {
    const int idx = blockIdx.x * 256 + threadIdx.x;
    const int t = idx >> 10, n = idx & 1023;
    const float ga = proj[(size_t)t * IN_COLS + OFF_G + n], gc = proj[(size_t)t * IN_COLS + OFF_G + 1024 + n];
    ya[idx] = ya[idx] / (1.0f + expf(-ga)) + yc[idx] / (1.0f + expf(-gc));
}

extern "C" void kernel_launch(void* const* d_in, const int* in_sizes, int n_in, void* d_out, int out_size, void* d_ws, size_t ws_size, hipStream_t stream) {
    const float* x_in = (const float*)d_in[0];
    const float* norm_mix = (const float*)d_in[1];
    const float* w_in = (const float*)d_in[2];
    const float* conv_w = (const float*)d_in[3];
    const float* w_attn_out = (const float*)d_in[4];
    const float* w_conv_out = (const float*)d_in[5];
    const float* w_mix_out = (const float*)d_in[6];
    const float* norm_mlp = (const float*)d_in[7];
    const float* w_up = (const float*)d_in[8];
    const float* w_down = (const float*)d_in[9];
    const float* norm_final = (const float*)d_in[10];
    float* x = (float*)d_out;
    char* ws = (char*)d_ws;
    const size_t MiB = 1u << 20;
    float* U = (float*)(ws + 0 * MiB);
    float* PROJ = (float*)(ws + 16 * MiB);
    float* ATT = (float*)(ws + 102 * MiB);
    float* CM = (float*)(ws + 110 * MiB);
    float* YA = (float*)(ws + 118 * MiB);
    float* YC = (float*)(ws + 134 * MiB);
    float* HID = (float*)(ws + 150 * MiB);
    hipMemcpyAsync(x, x_in, (size_t)BATCH * SEQ * D_MODEL * sizeof(float), hipMemcpyDeviceToDevice, stream);
    for (int l = 0; l < DEPTH; ++l) {
        const float* Win = w_in + (size_t)l * D_MODEL * IN_COLS;
        const float* Wao = w_attn_out + (size_t)l * 512 * D_MODEL;
        const float* Wco = w_conv_out + (size_t)l * 512 * D_MODEL;
        const float* Wmx = w_mix_out + (size_t)l * D_MODEL * D_MODEL;
        const float* Wup = w_up + (size_t)l * D_MODEL * MLP_H;
        const float* Wdn = w_down + (size_t)l * MLP_H * D_MODEL;
        for (int b = 0; b < BATCH; ++b) {
            float* xb = x + (size_t)b * SEQ * D_MODEL;
            rmsnorm_k<<<SEQ, 256, 0, stream>>>(xb, norm_mix + l * D_MODEL, U);
            gemm_f32<0><<<dim3((IN_COLS + 63) / 64, SEQ / 64), 256, 0, stream>>>(U, D_MODEL, Win, IN_COLS, PROJ, IN_COLS, SEQ, IN_COLS, D_MODEL);
            rope_k<<<(SEQ * 21 * 8 + 255) / 256, 256, 0, stream>>>(PROJ);
            dsa_k<<<SEQ, 256, 0, stream>>>(PROJ, ATT);
            conv_k<<<SEQ * 512 / 256, 256, 0, stream>>>(PROJ, conv_w + (size_t)l * 3 * 512, CM);
            gemm_f32<0><<<dim3(D_MODEL / 64, SEQ / 64), 256, 0, stream>>>(ATT, 512, Wao, D_MODEL, YA, D_MODEL, SEQ, D_MODEL, 512);
            gemm_f32<0><<<dim3(D_MODEL / 64, SEQ / 64), 256, 0, stream>>>(CM, 512, Wco, D_MODEL, YC, D_MODEL, SEQ, D_MODEL, 512);
            merge_k<<<SEQ * D_MODEL / 256, 256, 0, stream>>>(PROJ, YA, YC);
            gemm_f32<1><<<dim3(D_MODEL / 64, SEQ / 64), 256, 0, stream>>>(YA, D_MODEL, Wmx, D_MODEL, xb, D_MODEL, SEQ, D_MODEL, D_MODEL);
            rmsnorm_k<<<SEQ, 256, 0, stream>>>(xb, norm_mlp + l * D_MODEL, U);
            gemm_f32<2><<<dim3(MLP_H / 64, SEQ / 64), 256, 0, stream>>>(U, D_MODEL, Wup, MLP_H, HID, MLP_H, SEQ, MLP_H, D_MODEL);
            gemm_f32<1><<<dim3(D_MODEL / 64, SEQ / 64), 256, 0, stream>>>(HID, MLP_H, Wdn, D_MODEL, xb, D_MODEL, SEQ, D_MODEL, MLP_H);
        }
    }
    rmsnorm_k<<<BATCH * SEQ, 256, 0, stream>>>(x, norm_final, x);
}
```

```cpp
#include <hip/hip_runtime.h>
#include <stdint.h>
#include <math.h>
#include <cstdio>

#define D_MODEL 1024
#define BATCH 4
#define SEQ 4096
#define MROWS 16384
#define DEPTH 2
#define IN_COLS 5444
#define MLP_H 4096
#define OFF_Q 0
#define OFF_K 512
#define OFF_V 1024
#define OFF_IQ 1536
#define OFF_IK 1792
#define OFF_IW 1856
#define OFF_CB 1860
#define OFF_CC 2372
#define OFF_CH 2884
#define OFF_G 3396
#define NP1 3584
#define NPG 2048
#define NPALL 5632
#define C2F 0.18033688011112042f

typedef unsigned short bf16;
#define LAS __attribute__((address_space(3)))
#define GAS __attribute__((address_space(1)))
__device__ __forceinline__ unsigned f2bf(float f) { unsigned u = __builtin_bit_cast(unsigned, f); return (u + 0x7fffu + ((u >> 16) & 1u)) >> 16; }
__device__ __forceinline__ unsigned pk2(float lo, float hi) { return f2bf(lo) | (f2bf(hi) << 16); }
__device__ __forceinline__ float bf2f(unsigned short b) { return __builtin_bit_cast(float, ((unsigned)b) << 16); }

constexpr size_t MiB = 1u << 20;
constexpr size_t WS_CTL = 0, CTL_ZERO_BYTES = 1 * MiB;
constexpr size_t WS_CS = 1 * MiB;
constexpr size_t WS_ROWSQ = 1 * MiB + 512 * 1024;
constexpr size_t WS_IW = 1 * MiB + 768 * 1024;
constexpr size_t WS_WIN = 2 * MiB;
constexpr size_t WS_WOC = 24 * MiB;
constexpr size_t WS_WMIX = 28 * MiB;
constexpr size_t WS_WUP = 32 * MiB;
constexpr size_t WS_WDN = 48 * MiB;
constexpr size_t WS_XG = 64 * MiB;
constexpr size_t WS_Q = 96 * MiB, WS_K = 112 * MiB, WS_V = 128 * MiB;
constexpr size_t WS_IQ = 144 * MiB;
constexpr size_t WS_IK = 152 * MiB;
constexpr size_t WS_MASK = 154 * MiB;
constexpr size_t WS_CB = 162 * MiB, WS_P = 178 * MiB;
constexpr size_t WS_A2 = 194 * MiB;
constexpr size_t WS_SG = 96 * MiB;
constexpr size_t WS_MERGED = 160 * MiB;
constexpr size_t WS_H = 96 * MiB;
constexpr size_t WS_END = 256 * MiB;
namespace pg8 {
#define PG8_LAS __attribute__((address_space(3)))
typedef unsigned short bf16_t;
typedef short bf16x8 __attribute__((ext_vector_type(8)));
typedef float f32x4 __attribute__((ext_vector_type(4)));
typedef unsigned u32x4 __attribute__((ext_vector_type(4)));
constexpr int BM = 256, BK = 64, HALF = 128, HTB = HALF * BK * 2  , STAGE_BYTES = 8 * HTB, NXCD = 8, WGM = 8;

__host__ __device__ __forceinline__ int lds_byte(int r, int c) { const int st = (r >> 4) * 2 + (c >> 5), rr = r & 15, cc = c & 31, ob = rr * 64 + cc * 2; return st * 1024 + (ob ^ (((ob >> 9) & 1) << 5)); }
__host__ __device__ __forceinline__ void stage_rc(int b, int& R, int& C) { const int st = b / 1024, sb = b % 1024, swz = sb ^ (((sb >> 9) & 1) << 5); R = (st >> 1) * 16 + swz / 64; C = (st & 1) * 32 + (swz % 64) / 2; }
__host__ __device__ __forceinline__ int perm32(int rho) { const int n = rho >> 4, i = rho & 15; return 8 * (i >> 2) + 4 * n + (i & 3); }

struct Unit { int pm, pn; };
struct Gemm { const bf16_t* A; const bf16_t* Bt; int M, N, K; };

struct StaticOrder {
    int nM, nN, nwg, G, c;
    __host__ __device__ void init(int M, int N, int G_, int c_) { nM = M / BM; nN = N / BM; nwg = nM * nN; G = G_; c = c_; }
    __host__ __device__ bool next(int i, Unit& u) const {
        const long L = (long)i * G + c; if (L >= nwg) return false;
        int wgid = (int)L; { const int q = nwg / NXCD, r = nwg % NXCD, xcd = wgid % NXCD, off = wgid / NXCD; wgid = (xcd < r ? xcd * (q + 1) : r * (q + 1) + (xcd - r) * q) + off; }
        const int nig = WGM * nN, gid = wgid / nig, fm = gid * WGM, gsz = (nM - fm) < WGM ? (nM - fm) : WGM;
        u.pm = fm + ((wgid % nig) % gsz); u.pn = (wgid % nig) / gsz; return true;
    }
    __device__ __forceinline__ void a_ready(const Unit&) const {}
    __device__ __forceinline__ void done(const Unit&) const {}
};
__device__ __forceinline__ unsigned cvt_pk_bf16(float lo, float hi) { unsigned r; asm volatile("v_cvt_pk_bf16_f32 %0, %1, %2" : "=v"(r) : "v"(lo), "v"(hi)); return r; }
typedef float f32x2 __attribute__((ext_vector_type(2)));
__device__ __forceinline__ int lane_now() { int l; asm volatile("v_mbcnt_lo_u32_b32 %0, -1, 0\n\tv_mbcnt_hi_u32_b32 %0, -1, %0" : "=v"(l)); return l; }
__device__ __forceinline__ float row_rstd(const float* rowsq, int row) {
    const float s = (rowsq[row] + rowsq[MROWS + row]) + (rowsq[2 * MROWS + row] + rowsq[3 * MROWS + row]);
    return 1.0f / sqrtf(s * (1.0f / 1024.0f) + 1e-6f);
}
struct EpiProj {
    static constexpr bool PERM = true, AFTER_DRAIN = false, HAS_MID = false;
    const float* rowsq; const float* cs; bf16_t *Q, *K, *V, *IQ, *IK, *CB, *P; float* IW;
    __device__ __forceinline__ void operator()(const f32x4 (&acc)[2][2][4][2], const Unit& u, int wr, int wc, int, int) const {
        const int ln_ = lane_now(), fr = ln_ & 15, fq = ln_ >> 4;
        const int pn = u.pn, row0 = u.pm * BM + wr * 64 + fr;
        if (pn == 7) {
            if (wc >= 3) return;
            const bool ropeL = (wc == 0) && (fq < 2);
#pragma unroll
            for (int ai = 0; ai < 2; ++ai)
#pragma unroll
                for (int m = 0; m < 4; ++m) {
                    const int row = row0 + ai * HALF + m * 16; const float rs = row_rstd(rowsq, row); const int t = row & (SEQ - 1);
                    const f32x4 v0 = acc[ai][0][m][0] * rs, v1 = acc[ai][0][m][1] * rs;
                    if (wc < 2) {
                        f32x4 c4 = (f32x4){1.f, 1.f, 1.f, 1.f}, s4 = (f32x4){0.f, 0.f, 0.f, 0.f};
                        if (ropeL) { c4 = *(const f32x4*)(cs + t * 8 + 4 * fq); s4 = *(const f32x4*)(cs + SEQ * 8 + t * 8 + 4 * fq); }
                        const f32x4 o0 = v0 * c4 - v1 * s4, o1 = v1 * c4 + v0 * s4;
                        u32x4 w; w.x = cvt_pk_bf16(o0[0], o0[1]); w.y = cvt_pk_bf16(o0[2], o0[3]); w.z = cvt_pk_bf16(o1[0], o1[1]); w.w = cvt_pk_bf16(o1[2], o1[3]);
                        *(u32x4*)(IK + (size_t)row * 64 + wc * 32 + 8 * fq) = w;
                    } else if (fq == 0) {
                        *(f32x4*)(IW + (size_t)row * 4) = v0;
                    }
                }
            return;
        }
        if (pn >= 10) {
#pragma unroll
            for (int ai = 0; ai < 2; ++ai)
#pragma unroll
                for (int m = 0; m < 4; ++m) {
                    const int row = row0 + ai * HALF + m * 16; const float rs = row_rstd(rowsq, row); const float rs2 = rs * rs;
#pragma unroll
                    for (int bj = 0; bj < 2; ++bj) {
                        const f32x4 p = acc[ai][bj][m][0] * acc[ai][bj][m][1] * rs2;
                        unsigned long long w = (unsigned long long)cvt_pk_bf16(p[0], p[1]) | ((unsigned long long)cvt_pk_bf16(p[2], p[3]) << 32);
                        *(unsigned long long*)(P + (size_t)row * 512 + (((pn - 10) * 256 + bj * HALF + wc * 32 + 8 * fq) >> 1)) = w;
                    }
                }
            return;
        }
        bf16_t* dst; int pitch, colb; float sc = 1.f; bool rope = false;
        if (pn < 2) { dst = Q; pitch = 512; colb = pn * 256; sc = C2F; rope = true; }
        else if (pn < 4) { dst = K; pitch = 512; colb = (pn - 2) * 256; rope = true; }
        else if (pn < 6) { dst = V; pitch = 512; colb = (pn - 4) * 256; }
        else if (pn == 6) { dst = IQ; pitch = 256; colb = 0; rope = true; }
        else { dst = CB; pitch = 512; colb = (pn - 8) * 256; }
        const bool ropeL = rope && ((wc & 1) == 0) && (fq < 2);
#pragma unroll
        for (int ai = 0; ai < 2; ++ai)
#pragma unroll
            for (int m = 0; m < 4; ++m) {
                const int row = row0 + ai * HALF + m * 16; const float rs = row_rstd(rowsq, row) * sc; const int t = row & (SEQ - 1);
                f32x4 c4 = (f32x4){1.f, 1.f, 1.f, 1.f}, s4 = (f32x4){0.f, 0.f, 0.f, 0.f};
                if (ropeL) { c4 = *(const f32x4*)(cs + t * 8 + 4 * fq); s4 = *(const f32x4*)(cs + SEQ * 8 + t * 8 + 4 * fq); }
                bf16_t* rowp = dst + (size_t)row * pitch + colb + wc * 32 + 8 * fq;
#pragma unroll
                for (int bj = 0; bj < 2; ++bj) {
                    const f32x4 v0 = acc[ai][bj][m][0] * rs, v1 = acc[ai][bj][m][1] * rs;
                    const f32x4 o0 = v0 * c4 - v1 * s4, o1 = v1 * c4 + v0 * s4;
                    u32x4 w; w.x = cvt_pk_bf16(o0[0], o0[1]); w.y = cvt_pk_bf16(o0[2], o0[3]); w.z = cvt_pk_bf16(o1[0], o1[1]); w.w = cvt_pk_bf16(o1[2], o1[3]);
                    *(u32x4*)(rowp + bj * HALF) = w;
                }
            }
    }
};
struct EpiSig {
    static constexpr bool PERM = true, AFTER_DRAIN = false, HAS_MID = false;
    const float* rowsq; bf16_t* SG;
    __device__ __forceinline__ void operator()(const f32x4 (&acc)[2][2][4][2], const Unit& u, int wr, int wc, int, int) const {
        const int ln_ = lane_now(), fr = ln_ & 15, fq = ln_ >> 4;
        const int row0 = u.pm * BM + wr * 64 + fr, col0 = u.pn * BM + wc * 32 + 8 * fq;
#pragma unroll
        for (int ai = 0; ai < 2; ++ai)
#pragma unroll
            for (int m = 0; m < 4; ++m) {
                const int row = row0 + ai * HALF + m * 16; const float rs = row_rstd(rowsq, row) * (-1.4426950408889634f);
                bf16_t* rowp = SG + (size_t)row * NPG + col0;
#pragma unroll
                for (int bj = 0; bj < 2; ++bj) {
                    f32x4 v0 = acc[ai][bj][m][0] * rs, v1 = acc[ai][bj][m][1] * rs;
#pragma unroll
                    for (int j = 0; j < 4; ++j) { v0[j] = __builtin_amdgcn_rcpf(1.0f + __builtin_amdgcn_exp2f(v0[j])); v1[j] = __builtin_amdgcn_rcpf(1.0f + __builtin_amdgcn_exp2f(v1[j])); }
                    u32x4 w; w.x = cvt_pk_bf16(v0[0], v0[1]); w.y = cvt_pk_bf16(v0[2], v0[3]); w.z = cvt_pk_bf16(v1[0], v1[1]); w.w = cvt_pk_bf16(v1[2], v1[3]);
                    *(u32x4*)(rowp + bj * HALF) = w;
                }
            }
    }
};
struct EpiMerged {
    static constexpr bool PERM = true, AFTER_DRAIN = false, HAS_MID = true;
    const bf16_t* SG; bf16_t* O;
    __device__ __forceinline__ void mid(f32x4 (&acc)[2][2][4][2], const Unit& u, int wr, int wc, int, int) const {
        const int ln_ = lane_now(), fr = ln_ & 15, fq = ln_ >> 4;
        const int row0 = u.pm * BM + wr * 64 + fr, col0 = u.pn * BM + wc * 32 + 8 * fq;
#pragma unroll
        for (int ai = 0; ai < 2; ++ai)
#pragma unroll
            for (int m = 0; m < 4; ++m) {
                const bf16_t* sp = SG + (size_t)(row0 + ai * HALF + m * 16) * NPG + col0;
#pragma unroll
                for (int bj = 0; bj < 2; ++bj) {
                    const u32x4 a = *(const u32x4*)(sp + bj * HALF), c = *(const u32x4*)(sp + 1024 + bj * HALF);
#pragma unroll
                    for (int j = 0; j < 4; ++j) {
                        const float a0 = __builtin_bit_cast(float, a[j] << 16), a1 = __builtin_bit_cast(float, a[j] & 0xffff0000u);
                        const float c0 = __builtin_bit_cast(float, c[j] << 16), c1 = __builtin_bit_cast(float, c[j] & 0xffff0000u);
                        const float r0 = a0 * __builtin_amdgcn_rcpf(c0), r1 = a1 * __builtin_amdgcn_rcpf(c1);
                        acc[ai][bj][m][j >> 1][(j & 1) * 2] *= r0; acc[ai][bj][m][j >> 1][(j & 1) * 2 + 1] *= r1;
                    }
                }
            }
    }
    __device__ __forceinline__ void operator()(const f32x4 (&acc)[2][2][4][2], const Unit& u, int wr, int wc, int, int) const {
        const int ln_ = lane_now(), fr = ln_ & 15, fq = ln_ >> 4;
        const int row0 = u.pm * BM + wr * 64 + fr, col0 = u.pn * BM + wc * 32 + 8 * fq;
#pragma unroll
        for (int ai = 0; ai < 2; ++ai)
#pragma unroll
            for (int m = 0; m < 4; ++m) {
                const int row = row0 + ai * HALF + m * 16;
                const bf16_t* sp = SG + (size_t)row * NPG + 1024 + col0;
                bf16_t* rowp = O + (size_t)row * 1024 + col0;
#pragma unroll
                for (int bj = 0; bj < 2; ++bj) {
                    const u32x4 c = *(const u32x4*)(sp + bj * HALF);
                    float o[8];
#pragma unroll
                    for (int j = 0; j < 4; ++j) {
                        const float c0 = __builtin_bit_cast(float, c[j] << 16), c1 = __builtin_bit_cast(float, c[j] & 0xffff0000u);
                        o[2 * j] = acc[ai][bj][m][j >> 1][(j & 1) * 2] * c0; o[2 * j + 1] = acc[ai][bj][m][j >> 1][(j & 1) * 2 + 1] * c1;
                    }
                    u32x4 w; w.x = cvt_pk_bf16(o[0], o[1]); w.y = cvt_pk_bf16(o[2], o[3]); w.z = cvt_pk_bf16(o[4], o[5]); w.w = cvt_pk_bf16(o[6], o[7]);
                    *(u32x4*)(rowp + bj * HALF) = w;
                }
            }
    }
};
struct EpiRelu2 {
    static constexpr bool PERM = true, AFTER_DRAIN = false, HAS_MID = false;
    const float* rowsq; bf16_t* O;
    __device__ __forceinline__ void operator()(const f32x4 (&acc)[2][2][4][2], const Unit& u, int wr, int wc, int, int) const {
        const int ln_ = lane_now(), fr = ln_ & 15, fq = ln_ >> 4;
        const int row0 = u.pm * BM + wr * 64 + fr, col0 = u.pn * BM + wc * 32 + 8 * fq;
#pragma unroll
        for (int ai = 0; ai < 2; ++ai)
#pragma unroll
            for (int m = 0; m < 4; ++m) {
                const int row = row0 + ai * HALF + m * 16; const float rs = row_rstd(rowsq, row);
                bf16_t* rowp = O + (size_t)row * MLP_H + col0;
#pragma unroll
                for (int bj = 0; bj < 2; ++bj) {
                    f32x4 v0 = acc[ai][bj][m][0] * rs, v1 = acc[ai][bj][m][1] * rs;
#pragma unroll
                    for (int j = 0; j < 4; ++j) { const float a = fmaxf(v0[j], 0.f), b = fmaxf(v1[j], 0.f); v0[j] = a * a; v1[j] = b * b; }
                    u32x4 w; w.x = cvt_pk_bf16(v0[0], v0[1]); w.y = cvt_pk_bf16(v0[2], v0[3]); w.z = cvt_pk_bf16(v1[0], v1[1]); w.w = cvt_pk_bf16(v1[2], v1[3]);
                    *(u32x4*)(rowp + bj * HALF) = w;
                }
            }
    }
};
struct EpiResid {
    static constexpr bool PERM = false, AFTER_DRAIN = true, HAS_MID = false;
    const float* base; float* out; bf16_t* xg; const float* gnext; float* rowsq;
    __device__ __forceinline__ void fused(f32x4 (&acc)[2][2][4][2], const Unit& u, int wr, int wc, int, int, PG8_LAS unsigned char* lds, int wid, int) const {
        const int lane = lane_now(), fr = lane & 15, fq = lane >> 4;
        PG8_LAS float* Pt = (PG8_LAS float*)lds;
        const int col0 = u.pn * BM + wc * 32 + 4 * fq;
        f32x4 gv[2][2];
#pragma unroll
        for (int bj = 0; bj < 2; ++bj)
#pragma unroll
            for (int n = 0; n < 2; ++n) gv[bj][n] = gnext ? *(const f32x4*)(gnext + col0 + bj * HALF + n * 16) : (f32x4){0.f, 0.f, 0.f, 0.f};
#pragma unroll
        for (int ai = 0; ai < 2; ++ai)
#pragma unroll
            for (int m = 0; m < 4; ++m) {
                const int r = ai * HALF + wr * 64 + m * 16 + fr; const size_t off = (size_t)(u.pm * BM + r) * D_MODEL + col0; float s = 0.f;
#pragma unroll
                for (int bj = 0; bj < 2; ++bj)
#pragma unroll
                    for (int n = 0; n < 2; ++n) {
                        const f32x4 bs = *(const f32x4*)(base + off + bj * HALF + n * 16); const f32x4 xn = bs + acc[ai][bj][m][n];
                        *(f32x4*)(out + off + bj * HALF + n * 16) = xn;
                        s += (xn[0] * xn[0] + xn[1] * xn[1]) + (xn[2] * xn[2] + xn[3] * xn[3]);
                        if (gnext) { const f32x4 y = xn * gv[bj][n];
                            *(unsigned long long*)(xg + off + bj * HALF + n * 16) = (unsigned long long)cvt_pk_bf16(y[0], y[1]) | ((unsigned long long)cvt_pk_bf16(y[2], y[3]) << 32); }
                    }
                s += __shfl_xor(s, 16); s += __shfl_xor(s, 32);
                if (fq == 0) Pt[r * 4 + wc] = s;
                asm volatile("" ::: "memory");
            }
        asm volatile("s_waitcnt lgkmcnt(0)" ::: "memory"); __builtin_amdgcn_s_barrier(); asm volatile("" ::: "memory");
        const int tid = wid * 64 + lane;
        if (tid < 256) rowsq[(size_t)u.pn * MROWS + u.pm * BM + tid] = (Pt[tid * 4] + Pt[tid * 4 + 1]) + (Pt[tid * 4 + 2] + Pt[tid * 4 + 3]);
    }
};
template <class Epi, class Sched, bool ALIGN_EPI = false, bool SP2 = false>
__device__ __forceinline__ void gemm_phase(PG8_LAS unsigned char* lds, const Gemm g, const Sched& S, const Epi& E, const int wid) {
    const int lane = lane_now(), tid = wid * 64 + lane, wr = wid >> 2, wc = wid & 3, fr = lane & 15, fq = lane >> 4;
    const int K = g.K, nt = K / BK;
    unsigned voffA[2], voffB[2];
#pragma unroll
    for (int i = 0; i < 2; ++i) { int R, C; stage_rc(tid * 16 + i * 8192, R, C); const int Rb = Epi::PERM ? ((R & ~31) + perm32(R & 31)) : R;
        voffA[i] = (unsigned)(R * K + C) * 2u; voffB[i] = (unsigned)(Rb * K + C) * 2u; }
    const size_t kstep = (size_t)(BK * 2);
    const size_t hstep = (size_t)HALF * K * 2;
    const size_t tstep = 2 * hstep;
    const unsigned ldsw = (unsigned)wid * 1024u;
    const int aoff = lds_byte(wr * 64 + fr, fq * 8), boff = lds_byte(wc * 32 + fr, fq * 8);
#define PG8_SA(b, h) (((b) * 2 + (h)) * HTB)
#define PG8_SB(b, h) ((4 + (b) * 2 + (h)) * HTB)
#define PG8_STAGE(bufoff, gbase, voff) do { _Pragma("unroll") for (int _i = 0; _i < 2; ++_i) \
        __builtin_amdgcn_global_load_lds((const unsigned*)((const char*)(gbase) + (voff)[_i]), (PG8_LAS unsigned*)(lds + (bufoff) + ldsw + _i * 8192), 16, 0, 0); } while (0)
#define PG8_LDA(dst, b, h) do { _Pragma("unroll") for (int m = 0; m < 4; ++m) _Pragma("unroll") for (int k = 0; k < 2; ++k) dst[m][k] = *(const PG8_LAS bf16x8*)(lds + PG8_SA(b, h) + aoff + m * 2048 + k * 1024); } while (0)
#define PG8_LDB(dst, b, h) do { _Pragma("unroll") for (int n = 0; n < 2; ++n) _Pragma("unroll") for (int k = 0; k < 2; ++k) dst[n][k] = *(const PG8_LAS bf16x8*)(lds + PG8_SB(b, h) + boff + n * 2048 + k * 1024); } while (0)
#define PG8_MMA(ai, bj, At, Bt) do { __builtin_amdgcn_s_setprio(1); _Pragma("unroll") for (int m = 0; m < 4; ++m) _Pragma("unroll") for (int n = 0; n < 2; ++n) _Pragma("unroll") for (int k = 0; k < 2; ++k) \
        acc[ai][bj][m][n] = __builtin_amdgcn_mfma_f32_16x16x32_bf16(Bt[n][k], At[m][k], acc[ai][bj][m][n], 0, 0, 0); __builtin_amdgcn_s_setprio(0); } while (0)
#define PG8_WAIT_V(n) asm volatile("s_waitcnt vmcnt(" #n ")" ::: "memory")
#define PG8_WAIT_L(n) asm volatile("s_waitcnt lgkmcnt(" #n ")" ::: "memory")
#define PG8_BAR __builtin_amdgcn_s_barrier()
#define PG8_SCHED __builtin_amdgcn_sched_barrier(0)
    Unit cur, nxt; int ui = 0;
    if (!S.next(0, cur)) return;
    f32x4 acc[2][2][4][2];
#pragma unroll
    for (int a = 0; a < 2; ++a)
#pragma unroll
        for (int b = 0; b < 2; ++b)
#pragma unroll
            for (int m = 0; m < 4; ++m)
#pragma unroll
                for (int n = 0; n < 2; ++n) acc[a][b][m][n] = (f32x4){0.f, 0.f, 0.f, 0.f};
    bf16x8 At[4][2], B0[2][2], B1[2][2];
    const char* cA = (const char*)g.A + (size_t)cur.pm * tstep; const char* cB = (const char*)g.Bt + (size_t)cur.pn * tstep;
    S.a_ready(cur);
    if constexpr (SP2) {
        PG8_STAGE(PG8_SB(0, 0), cB, voffB); PG8_STAGE(PG8_SB(0, 1), cB + hstep, voffB); PG8_STAGE(PG8_SA(0, 0), cA, voffA); PG8_STAGE(PG8_SA(0, 1), cA + hstep, voffA);
        if (wr == 1) PG8_BAR;
        PG8_WAIT_V(2); PG8_BAR;
        PG8_STAGE(PG8_SB(1, 0), cB + kstep, voffB); PG8_STAGE(PG8_SA(1, 0), cA + kstep, voffA); PG8_STAGE(PG8_SB(1, 1), cB + hstep + kstep, voffB);
        PG8_WAIT_V(6); PG8_BAR;
    } else {
        PG8_STAGE(PG8_SB(0, 0), cB, voffB); PG8_STAGE(PG8_SA(0, 0), cA, voffA); PG8_STAGE(PG8_SB(0, 1), cB + hstep, voffB); PG8_STAGE(PG8_SA(0, 1), cA + hstep, voffA);
        if (wr == 1) PG8_BAR;
        PG8_WAIT_V(4); PG8_BAR;
        PG8_STAGE(PG8_SB(1, 0), cB + kstep, voffB); PG8_STAGE(PG8_SA(1, 0), cA + kstep, voffA); PG8_STAGE(PG8_SB(1, 1), cB + hstep + kstep, voffB);
        PG8_WAIT_V(6); PG8_BAR;
    }
    for (;;) {
        const bool has_next = S.next(ui + 1, nxt);
        const char* nA = has_next ? (const char*)g.A + (size_t)nxt.pm * tstep : cA; const char* nB = has_next ? (const char*)g.Bt + (size_t)nxt.pn * tstep : cB;
        for (int t = 0; t < nt; t += 2) {
            const bool last = (t == nt - 2);
            const char* a1 = cA + (size_t)(t + 1) * kstep;
            const char* a2 = last ? nA : cA + (size_t)(t + 2) * kstep; const char* b2 = last ? nB : cB + (size_t)(t + 2) * kstep;
            const char* a3 = a2 + kstep; const char* b3 = b2 + kstep;
            if (last && has_next) S.a_ready(nxt);
            if constexpr (Epi::HAS_MID) { if (t == (nt >> 1)) E.mid(acc, cur, wr, wc, fr, fq); }
            if constexpr (SP2) {
            PG8_LDB(B0, 0, 0); PG8_LDB(B1, 0, 1); PG8_SCHED; PG8_LDA(At, 0, 0); PG8_STAGE(PG8_SA(1, 1), a1 + hstep, voffA);
            PG8_WAIT_V(8); PG8_WAIT_L(0); PG8_BAR; PG8_MMA(0, 0, At, B0); PG8_MMA(0, 1, At, B1); PG8_BAR; PG8_SCHED;
            PG8_LDA(At, 0, 1); PG8_STAGE(PG8_SB(0, 0), b2, voffB); PG8_STAGE(PG8_SB(0, 1), b2 + hstep, voffB); PG8_STAGE(PG8_SA(0, 0), a2, voffA);
            PG8_WAIT_V(8); PG8_WAIT_L(0); PG8_BAR; PG8_MMA(1, 0, At, B0); PG8_MMA(1, 1, At, B1); PG8_BAR; PG8_SCHED;
            PG8_LDB(B0, 1, 0); PG8_LDB(B1, 1, 1); PG8_SCHED; PG8_LDA(At, 1, 0); PG8_STAGE(PG8_SA(0, 1), a2 + hstep, voffA);
            PG8_WAIT_V(8); PG8_WAIT_L(0); PG8_BAR; PG8_MMA(0, 0, At, B0); PG8_MMA(0, 1, At, B1); PG8_BAR; PG8_SCHED;
            PG8_LDA(At, 1, 1); PG8_STAGE(PG8_SB(1, 0), b3, voffB); PG8_STAGE(PG8_SB(1, 1), b3 + hstep, voffB); PG8_STAGE(PG8_SA(1, 0), a3, voffA);
            PG8_WAIT_V(8); PG8_WAIT_L(0); PG8_BAR; PG8_MMA(1, 0, At, B0); PG8_MMA(1, 1, At, B1); PG8_BAR; PG8_SCHED;
            } else {
            PG8_LDB(B0, 0, 0); PG8_SCHED; PG8_LDA(At, 0, 0); PG8_STAGE(PG8_SA(1, 1), a1 + hstep, voffA);
            PG8_WAIT_L(8); PG8_BAR; PG8_WAIT_L(0); PG8_MMA(0, 0, At, B0); PG8_BAR; PG8_SCHED;
            PG8_LDB(B1, 0, 1); PG8_STAGE(PG8_SB(0, 0), b2, voffB);
            PG8_BAR; PG8_WAIT_L(0); PG8_MMA(0, 1, At, B1); PG8_BAR;
            PG8_LDA(At, 0, 1); PG8_STAGE(PG8_SA(0, 0), a2, voffA);
            PG8_BAR; PG8_WAIT_L(0); PG8_MMA(1, 0, At, B0); PG8_BAR; PG8_SCHED;
            PG8_STAGE(PG8_SB(0, 1), b2 + hstep, voffB);
            PG8_WAIT_V(6); PG8_BAR; PG8_MMA(1, 1, At, B1); PG8_BAR;
            PG8_LDB(B0, 1, 0); PG8_SCHED; PG8_LDA(At, 1, 0); PG8_STAGE(PG8_SA(0, 1), a2 + hstep, voffA);
            PG8_WAIT_L(8); PG8_BAR; PG8_WAIT_L(0); PG8_MMA(0, 0, At, B0); PG8_BAR; PG8_SCHED;
            PG8_LDB(B1, 1, 1); PG8_STAGE(PG8_SB(1, 0), b3, voffB);
            PG8_BAR; PG8_WAIT_L(0); PG8_MMA(0, 1, At, B1); PG8_BAR;
            PG8_LDA(At, 1, 1); PG8_STAGE(PG8_SA(1, 0), a3, voffA);
            PG8_BAR; PG8_WAIT_L(0); PG8_MMA(1, 0, At, B0); PG8_BAR; PG8_SCHED;
            PG8_STAGE(PG8_SB(1, 1), b3 + hstep, voffB);
            PG8_WAIT_V(6); PG8_BAR; PG8_MMA(1, 1, At, B1); PG8_BAR;
            }
        }
        if constexpr (ALIGN_EPI) { if (wr == 0) PG8_BAR; }
        if constexpr (!Epi::AFTER_DRAIN) { E(acc, cur, wr, wc, fr, fq); S.done(cur); }
        if (!has_next) break;
#pragma unroll
        for (int a = 0; a < 2; ++a)
#pragma unroll
            for (int b = 0; b < 2; ++b)
#pragma unroll
                for (int m = 0; m < 4; ++m)
#pragma unroll
                    for (int n = 0; n < 2; ++n) acc[a][b][m][n] = (f32x4){0.f, 0.f, 0.f, 0.f};
        cur = nxt; cA = nA; cB = nB; ++ui;
        if constexpr (ALIGN_EPI) { if (wr == 1) PG8_BAR; }
    }
    PG8_WAIT_V(0);
    if constexpr (!ALIGN_EPI) { if (wr == 0) PG8_BAR; }
    PG8_BAR;
    if constexpr (Epi::AFTER_DRAIN) { E.fused(acc, cur, wr, wc, fr, fq, lds, wid, lane); S.done(cur); }
#undef PG8_SA
#undef PG8_SB
#undef PG8_STAGE
#undef PG8_LDA
#undef PG8_LDB
#undef PG8_MMA
#undef PG8_WAIT_V
#undef PG8_WAIT_L
#undef PG8_BAR
#undef PG8_SCHED
}
}
constexpr int NWAVES = 8;
constexpr int RING_OFF = 0, RING_BYTES = 131072;
constexpr int LDS_BYTES = 147456;
constexpr int MISC_OFF = 140000;
static_assert(MISC_OFF % 16 == 0 && MISC_OFF + 256 <= LDS_BYTES, "LDS map");

typedef unsigned v4u __attribute__((ext_vector_type(4)));
typedef float f32x4 __attribute__((ext_vector_type(4)));
#define LDS_WAIT() asm volatile("s_waitcnt lgkmcnt(0)" ::: "memory")
#define VM_WAIT() asm volatile("s_waitcnt vmcnt(0)" ::: "memory")

__device__ __forceinline__ float wave_sum(float v) {
#pragma unroll
    for (int o = 1; o < 64; o <<= 1) v += __shfl_xor(v, o);
    return v;
}

__device__ __forceinline__ int rperm(int p) { return p < 16 ? ((p & 3) | ((p & 4) << 1) | ((p & 8) >> 1)) : p; }
__device__ __forceinline__ int win_src_col(int n) {
    if (n < 512) return OFF_Q + (n & ~63) + rperm(n & 63);
    if (n < 1024) { const int m = n - 512; return OFF_K + (m & ~63) + rperm(m & 63); }
    if (n < 1536) return OFF_V + (n - 1024);
    if (n < 1792) { const int m = n - 1536; return OFF_IQ + (m & ~63) + rperm(m & 63); }
    if (n < 1856) return OFF_IK + rperm(n - 1792);
    if (n < 1860) return OFF_IW + (n - 1856);
    if (n < 2048) return -1;
    if (n < 2560) return OFF_CB + (n - 2048);
    if (n < 3584) { const int m = n - 2560, G = m >> 3, i = m & 7; return i < 4 ? OFF_CC + 4 * G + i : OFF_CH + 4 * G + (i - 4); }
    return OFF_G + (n - 3584);
}
template <bool MAPPED>
__device__ __forceinline__ void transpose_item(const float* __restrict__ W, int Nsrc, bf16* WT, int dst_ld, int dst_col0, int k0, int n0, LAS float* scr, int lane) {
    const int nn = n0 + (lane & 31);
    const int sc = MAPPED ? win_src_col(nn) : nn;
#pragma unroll 8
    for (int i = 0; i < 32; ++i) { const int kk = 2 * i + (lane >> 5); scr[kk * 33 + (lane & 31)] = (sc >= 0) ? W[(size_t)(k0 + kk) * Nsrc + sc] : 0.f; }
    LDS_WAIT(); asm volatile("" ::: "memory");
    const int c = lane & 7;
#pragma unroll
    for (int j = 0; j < 4; ++j) { const int n = (lane >> 3) + 8 * j; const LAS float* s = scr + (8 * c) * 33 + n;
        v4u o; o.x = pk2(s[0 * 33], s[1 * 33]); o.y = pk2(s[2 * 33], s[3 * 33]); o.z = pk2(s[4 * 33], s[5 * 33]); o.w = pk2(s[6 * 33], s[7 * 33]);
        *(GAS v4u*)(WT + (size_t)(n0 + n) * dst_ld + dst_col0 + k0 + 8 * c) = o; }
    LDS_WAIT(); asm volatile("" ::: "memory");
}
__device__ __forceinline__ void sincos_acc(float ang_f, float& s_out, float& c_out) {
    const double a = (double)ang_f;
    const double q = rint(a * 0.63661977236758134308);
    double r = fma(-q, 1.57079632679489655800e+00, a);
    r = fma(-q, 6.12323399573676603587e-17, r);
    const double r2 = r * r;
    double sp = 1.0 / 6227020800.0; sp = fma(sp, r2, -1.0 / 39916800.0); sp = fma(sp, r2, 1.0 / 362880.0); sp = fma(sp, r2, -1.0 / 5040.0);
    sp = fma(sp, r2, 1.0 / 120.0); sp = fma(sp, r2, -1.0 / 6.0); sp = fma(sp, r2, 1.0);
    const double sn = sp * r;
    double cp = 1.0 / 87178291200.0; cp = fma(cp, r2, -1.0 / 479001600.0); cp = fma(cp, r2, 1.0 / 3628800.0); cp = fma(cp, r2, -1.0 / 40320.0);
    cp = fma(cp, r2, 1.0 / 720.0); cp = fma(cp, r2, -1.0 / 24.0); cp = fma(cp, r2, 0.5); cp = fma(-cp, r2, 1.0);
    const int qi = ((int)q) & 3;
    double s, c;
    if (qi == 0) { s = sn; c = cp; } else if (qi == 1) { s = cp; c = -sn; } else if (qi == 2) { s = -sn; c = -cp; } else { s = -cp; c = sn; }
    s_out = (float)s; c_out = (float)c;
}
__device__ __forceinline__ float rope_inv(int j) {
    return j == 0 ? 1.0f : j == 1 ? 0.193922758102417f : j == 2 ? 0.03760603070259094f : j == 3 ? 0.00729266507551074f : j == 4 ? 0.001414213445968926f
         : j == 5 ? 0.00027424818836152554f : j == 6 ? 5.318296462064609e-05f : 1.0313385246263351e-05f;
}
__device__ __forceinline__ void xg_row(const float* xrow, const float* g, bf16* orow, float* rowsq, int row, int lane) {
    const GAS f32x4* xr = (const GAS f32x4*)xrow + lane; const GAS f32x4* gr = (const GAS f32x4*)g + lane;
    f32x4 v[4]; float s = 0.f;
#pragma unroll
    for (int j = 0; j < 4; ++j) { v[j] = xr[64 * j]; s += (v[j].x * v[j].x + v[j].y * v[j].y) + (v[j].z * v[j].z + v[j].w * v[j].w); }
    s = wave_sum(s);
    GAS unsigned long long* o8 = (GAS unsigned long long*)orow + lane;
#pragma unroll
    for (int j = 0; j < 4; ++j) { const f32x4 gg = gr[64 * j]; o8[64 * j] = (unsigned long long)pk2(v[j].x * gg.x, v[j].y * gg.y) | ((unsigned long long)pk2(v[j].z * gg.z, v[j].w * gg.w) << 32); }
    if (lane < 4) rowsq[lane * MROWS + row] = (lane == 0) ? s : 0.f;
}

struct Args { const float* in[11]; float* out; unsigned char* ws; int ph_lo, ph_hi, layer, pad; };

__device__ __forceinline__ void p0_prologue(const Args& a, LAS unsigned char* lds, int wave, int lane, int vcu, int G) {
    unsigned char* ws = a.ws;
    LAS float* scr = (LAS float*)(lds + RING_OFF + wave * 16384);
    const int gw = vcu * NWAVES + wave, NGW = G * NWAVES;
    constexpr int I_IN = 16 * (NPALL / 32), I_AO = 8 * 32, I_CO = 8 * 32, I_MX = 16 * 32, I_UP = 16 * 128, I_DN = 64 * 32;
    constexpr int I_LAYER = I_IN + I_AO + I_CO + I_MX + I_UP + I_DN;
    for (int it = gw; it < DEPTH * I_LAYER; it += NGW) {
        const int l = it / I_LAYER; int r = it % I_LAYER;
        if (r < I_IN) { const int nb = r % (NPALL / 32), kb = r / (NPALL / 32);
            transpose_item<true>(a.in[2] + (size_t)l * D_MODEL * IN_COLS, IN_COLS, (bf16*)(ws + WS_WIN) + (size_t)l * NPALL * 1024, 1024, 0, kb * 64, nb * 32, scr, lane); continue; } r -= I_IN;
        if (r < I_AO) { const int nb = r % 32, kb = r / 32;
            transpose_item<false>(a.in[4] + (size_t)l * 512 * 1024, 1024, (bf16*)(ws + WS_WOC) + (size_t)l * 1024 * 1024, 1024, 0, kb * 64, nb * 32, scr, lane); continue; } r -= I_AO;
        if (r < I_CO) { const int nb = r % 32, kb = r / 32;
            transpose_item<false>(a.in[5] + (size_t)l * 512 * 1024, 1024, (bf16*)(ws + WS_WOC) + (size_t)l * 1024 * 1024, 1024, 512, kb * 64, nb * 32, scr, lane); continue; } r -= I_CO;
        if (r < I_MX) { const int nb = r % 32, kb = r / 32;
            transpose_item<false>(a.in[6] + (size_t)l * 1024 * 1024, 1024, (bf16*)(ws + WS_WMIX) + (size_t)l * 1024 * 1024, 1024, 0, kb * 64, nb * 32, scr, lane); continue; } r -= I_MX;
        if (r < I_UP) { const int nb = r % 128, kb = r / 128;
            transpose_item<false>(a.in[8] + (size_t)l * 1024 * 4096, 4096, (bf16*)(ws + WS_WUP) + (size_t)l * 4096 * 1024, 1024, 0, kb * 64, nb * 32, scr, lane); continue; } r -= I_UP;
        { const int nb = r % 32, kb = r / 32;
            transpose_item<false>(a.in[9] + (size_t)l * 4096 * 1024, 1024, (bf16*)(ws + WS_WDN) + (size_t)l * 1024 * 4096, 4096, 0, kb * 64, nb * 32, scr, lane); }
    }
    float* cs = (float*)(ws + WS_CS);
    for (int i = gw * 64 + lane; i < SEQ * 8; i += NGW * 64) { const int t = i >> 3, j = i & 7; float s, c; sincos_acc((float)t * rope_inv(j), s, c); cs[i] = c; cs[SEQ * 8 + i] = s; }
    for (int m = gw; m < MROWS; m += NGW) xg_row(a.in[0] + (size_t)m * D_MODEL, a.in[1], (bf16*)(ws + WS_XG) + (size_t)m * D_MODEL, (float*)(ws + WS_ROWSQ), m, lane);
}

__global__ void __launch_bounds__(NWAVES * 64, 2) mk_fwd(Args args) {
    extern __shared__ __attribute__((aligned(16))) unsigned char lds_raw[];
    LAS unsigned char* lds = (LAS unsigned char*)lds_raw;
    const int wave = __builtin_amdgcn_readfirstlane(threadIdx.x >> 6);
#define lane (pg8::lane_now())
    const int G = gridDim.x; const int bx = blockIdx.x; const int vcu = (G % 8 == 0) ? (bx % 8) * (G / 8) + bx / 8 : bx;
    unsigned char* ws = args.ws;
    const int lo = args.ph_lo, hi = args.ph_hi, L = args.layer;
#define IN(k) (lo <= (k) && (k) < hi)
    if (IN(0)) { p0_prologue(args, lds, wave, lane, vcu, G); }
    if (IN(1)) {
        pg8::Gemm g{(const bf16*)(ws + WS_XG), (const bf16*)(ws + WS_WIN) + (size_t)L * NPALL * 1024, MROWS, NP1, D_MODEL};
        pg8::StaticOrder S; S.init(MROWS, NP1, G, (int)blockIdx.x);
        pg8::EpiProj E{(const float*)(ws + WS_ROWSQ), (const float*)(ws + WS_CS), (bf16*)(ws + WS_Q), (bf16*)(ws + WS_K), (bf16*)(ws + WS_V), (bf16*)(ws + WS_IQ), (bf16*)(ws + WS_IK),
                       (bf16*)(ws + WS_CB), (bf16*)(ws + WS_P), (float*)(ws + WS_IW)};
        pg8::gemm_phase<pg8::EpiProj, pg8::StaticOrder, true, true>(lds + RING_OFF, g, S, E, wave);
    }
    if (IN(4)) {
        pg8::Gemm g{(const bf16*)(ws + WS_XG), (const bf16*)(ws + WS_WIN) + (size_t)L * NPALL * 1024 + (size_t)NP1 * 1024, MROWS, NPG, D_MODEL};
        pg8::StaticOrder S; S.init(MROWS, NPG, G, (int)blockIdx.x);
        pg8::EpiSig E{(const float*)(ws + WS_ROWSQ), (bf16*)(ws + WS_SG)};
        pg8::gemm_phase<pg8::EpiSig, pg8::StaticOrder, true, true>(lds + RING_OFF, g, S, E, wave);
    }
    if (IN(5)) {
        pg8::Gemm g{(const bf16*)(ws + WS_A2), (const bf16*)(ws + WS_WOC) + (size_t)L * 1024 * 1024, MROWS, D_MODEL, 1024};
        pg8::StaticOrder S; S.init(MROWS, D_MODEL, G, (int)blockIdx.x);
        pg8::EpiMerged E{(const bf16*)(ws + WS_SG), (bf16*)(ws + WS_MERGED)};
        pg8::gemm_phase<pg8::EpiMerged, pg8::StaticOrder, true, true>(lds + RING_OFF, g, S, E, wave);
    }
    if (IN(6)) {
        pg8::Gemm g{(const bf16*)(ws + WS_MERGED), (const bf16*)(ws + WS_WMIX) + (size_t)L * 1024 * 1024, MROWS, D_MODEL, 1024};
        pg8::StaticOrder S; S.init(MROWS, D_MODEL, G, (int)blockIdx.x);
        pg8::EpiResid E{L == 0 ? args.in[0] : args.out, args.out, (bf16*)(ws + WS_XG), args.in[7] + L * D_MODEL, (float*)(ws + WS_ROWSQ)};
        pg8::gemm_phase<pg8::EpiResid, pg8::StaticOrder, false, true>(lds + RING_OFF, g, S, E, wave);
    }
    if (IN(7)) {
        pg8::Gemm g{(const bf16*)(ws + WS_XG), (const bf16*)(ws + WS_WUP) + (size_t)L * 4096 * 1024, MROWS, MLP_H, D_MODEL};
        pg8::StaticOrder S; S.init(MROWS, MLP_H, G, (int)blockIdx.x);
        pg8::EpiRelu2 E{(const float*)(ws + WS_ROWSQ), (bf16*)(ws + WS_H)};
        pg8::gemm_phase<pg8::EpiRelu2, pg8::StaticOrder, true, true>(lds + RING_OFF, g, S, E, wave);
    }
    if (IN(8)) {
        pg8::Gemm g{(const bf16*)(ws + WS_H), (const bf16*)(ws + WS_WDN) + (size_t)L * 1024 * 4096, MROWS, D_MODEL, MLP_H};
        pg8::StaticOrder S; S.init(MROWS, D_MODEL, G, (int)blockIdx.x);
        pg8::EpiResid E{args.out, args.out, (bf16*)(ws + WS_XG), (L + 1 < DEPTH) ? args.in[1] + (L + 1) * D_MODEL : (const float*)nullptr, (float*)(ws + WS_ROWSQ)};
        pg8::gemm_phase<pg8::EpiResid, pg8::StaticOrder, false, true>(lds + RING_OFF, g, S, E, wave);
    }
    if (IN(9)) {
        const float* rowsq = (const float*)(ws + WS_ROWSQ); const float* gf = args.in[10];
        const int gw = vcu * NWAVES + wave, NGW = G * NWAVES;
        for (int m = gw; m < MROWS; m += NGW) {
            const float rs = pg8::row_rstd(rowsq, m);
            GAS f32x4* xr = (GAS f32x4*)(args.out + (size_t)m * D_MODEL) + lane; const GAS f32x4* gr = (const GAS f32x4*)gf + lane;
#pragma unroll
            for (int j = 0; j < 4; ++j) { const f32x4 v = xr[64 * j], gg = gr[64 * j]; xr[64 * j] = v * rs * gg; }
        }
    }
#undef IN
#undef lane
}
__device__ __forceinline__ float n_wave_sum_f(float v) {
#pragma unroll
    for (int o = 32; o >= 1; o >>= 1) v += __shfl_xor(v, o);
    return v; }
__device__ __forceinline__ float n_wave_max_f(float v) {
#pragma unroll
    for (int o = 32; o >= 1; o >>= 1) v = fmaxf(v, __shfl_xor(v, o));
    return v; }
__device__ __forceinline__ int n_wave_sum_i(int v) {
#pragma unroll
    for (int o = 32; o >= 1; o >>= 1) v += __shfl_xor(v, o);
    return v; }
__device__ __forceinline__ float n_block_sum_f(float v, float* red) { v = n_wave_sum_f(v); __syncthreads(); if ((threadIdx.x & 63) == 0) red[threadIdx.x >> 6] = v; __syncthreads(); return (red[0] + red[1]) + (red[2] + red[3]); }
__device__ __forceinline__ float n_block_max_f(float v, float* red) { v = n_wave_max_f(v); __syncthreads(); if ((threadIdx.x & 63) == 0) red[threadIdx.x >> 6] = v; __syncthreads(); return fmaxf(fmaxf(red[0], red[1]), fmaxf(red[2], red[3])); }
__device__ __forceinline__ int n_block_sum_i(int v, int* red) { v = n_wave_sum_i(v); __syncthreads(); if ((threadIdx.x & 63) == 0) red[threadIdx.x >> 6] = v; __syncthreads(); return (red[0] + red[1]) + (red[2] + red[3]); }

__global__ __launch_bounds__(256) void n_rmsnorm_k(const float* x, const float* __restrict__ g, float* y) {
    __shared__ float red[4];
    const int row = blockIdx.x, tid = threadIdx.x;
    const float4 v = ((const float4*)(x + (size_t)row * D_MODEL))[tid];
    float s = (v.x * v.x + v.y * v.y) + (v.z * v.z + v.w * v.w);
    s = n_block_sum_f(s, red);
    const float r = 1.0f / sqrtf(s * (1.0f / D_MODEL) + 1e-6f);
    const float4 gg = ((const float4*)g)[tid];
    float4 o; o.x = v.x * r * gg.x; o.y = v.y * r * gg.y; o.z = v.z * r * gg.z; o.w = v.w * r * gg.w;
    ((float4*)(y + (size_t)row * D_MODEL))[tid] = o;
}
__global__ __launch_bounds__(64) void n_xg_k(const float* x, const float* g, bf16* xg, float* rowsq) {
    xg_row(x + (size_t)blockIdx.x * D_MODEL, g, xg + (size_t)blockIdx.x * D_MODEL, rowsq, blockIdx.x, threadIdx.x);
}
__device__ __forceinline__ float4 ld4(const float* p) { return *(const float4*)p; }
__device__ __forceinline__ float4 ld4(const bf16* p) { const uint2 u = *(const uint2*)p; float4 r; r.x = bf2f(u.x & 0xffff); r.y = bf2f(u.x >> 16); r.z = bf2f(u.y & 0xffff); r.w = bf2f(u.y >> 16); return r; }
template <int EPI, typename TA>
__global__ __launch_bounds__(256) void n_gemm(const TA* __restrict__ A, int lda, const float* __restrict__ B, int ldb, float* C, int ldc, int M, int N, int K) {
    __shared__ float As[16][68];
    __shared__ float Bs[16][68];
    const int tid = threadIdx.x, tx = tid & 15, ty = tid >> 4;
    const int m0 = blockIdx.y * 64, n0 = blockIdx.x * 64;
    float acc[4][4];
#pragma unroll
    for (int i = 0; i < 4; ++i)
#pragma unroll
        for (int j = 0; j < 4; ++j) acc[i][j] = 0.f;
    const int ar = tid >> 2, ak = (tid & 3) * 4, bk = tid >> 4, bn = (tid & 15) * 4;
    const bool bok = (n0 + bn) < N;
    for (int k0 = 0; k0 < K; k0 += 16) {
        const float4 a = ld4(A + (size_t)(m0 + ar) * lda + k0 + ak);
        float4 b = make_float4(0.f, 0.f, 0.f, 0.f);
        if (bok) b = *(const float4*)(B + (size_t)(k0 + bk) * ldb + n0 + bn);
        __syncthreads();
        As[ak + 0][ar] = a.x; As[ak + 1][ar] = a.y; As[ak + 2][ar] = a.z; As[ak + 3][ar] = a.w;
        *(float4*)&Bs[bk][bn] = b;
        __syncthreads();
#pragma unroll
        for (int kk = 0; kk < 16; ++kk) {
            const float4 av = *(const float4*)&As[kk][ty * 4];
            const float4 bv = *(const float4*)&Bs[kk][tx * 4];
            const float aa[4] = {av.x, av.y, av.z, av.w};
            const float bb[4] = {bv.x, bv.y, bv.z, bv.w};
#pragma unroll
            for (int i = 0; i < 4; ++i)
#pragma unroll
                for (int j = 0; j < 4; ++j) acc[i][j] = fmaf(aa[i], bb[j], acc[i][j]);
        }
    }
    const int col = n0 + tx * 4;
    if (col < N) {
#pragma unroll
        for (int i = 0; i < 4; ++i) {
            float* cp = C + (size_t)(m0 + ty * 4 + i) * ldc + col;
            float4 o;
            if (EPI == 0) { o.x = acc[i][0]; o.y = acc[i][1]; o.z = acc[i][2]; o.w = acc[i][3]; }
            if (EPI == 1) { const float4 c = *(const float4*)cp; o.x = c.x + acc[i][0]; o.y = c.y + acc[i][1]; o.z = c.z + acc[i][2]; o.w = c.w + acc[i][3]; }
            if (EPI == 2) { float r0 = fmaxf(acc[i][0], 0.f), r1 = fmaxf(acc[i][1], 0.f), r2 = fmaxf(acc[i][2], 0.f), r3 = fmaxf(acc[i][3], 0.f); o.x = r0 * r0; o.y = r1 * r1; o.z = r2 * r2; o.w = r3 * r3; }
            *(float4*)cp = o;
        }
    }
}
__global__ __launch_bounds__(256) void n_dsa_k(const bf16* __restrict__ Q, const bf16* __restrict__ Kt, const bf16* __restrict__ V, const bf16* __restrict__ IQ, const bf16* __restrict__ IK, const float* __restrict__ IW, bf16* __restrict__ A2) {
    __shared__ unsigned keys[4096];
    __shared__ float qs[512];
    __shared__ float iqs[256];
    __shared__ int sel[256];
    __shared__ float pw[256];
    __shared__ float red4[4][64];
    __shared__ float redf[4];
    __shared__ int redi[4];
    __shared__ int scan[256];
    const int row = blockIdx.x, tid = threadIdx.x, t = row & (SEQ - 1);
    const size_t b0 = (size_t)(row - t);
    const int N = ((t >> 6) + 1) << 6;
    iqs[tid] = bf2f(IQ[(size_t)row * 256 + tid]);
    qs[tid] = bf2f(Q[(size_t)row * 512 + tid]); qs[256 + tid] = bf2f(Q[(size_t)row * 512 + 256 + tid]);
    const float w0 = IW[(size_t)row * 4], w1 = IW[(size_t)row * 4 + 1], w2 = IW[(size_t)row * 4 + 2], w3 = IW[(size_t)row * 4 + 3];
    __syncthreads();
    for (int s = tid; s < N; s += 256) {
        const bf16* ik = IK + (b0 + s) * 64;
        float d0 = 0.f, d1 = 0.f, d2 = 0.f, d3 = 0.f;
#pragma unroll 4
        for (int d = 0; d < 16; ++d) {
            const float4 kv = ld4(ik + 4 * d);
            d0 = fmaf(iqs[4 * d], kv.x, d0); d0 = fmaf(iqs[4 * d + 1], kv.y, d0); d0 = fmaf(iqs[4 * d + 2], kv.z, d0); d0 = fmaf(iqs[4 * d + 3], kv.w, d0);
            d1 = fmaf(iqs[64 + 4 * d], kv.x, d1); d1 = fmaf(iqs[64 + 4 * d + 1], kv.y, d1); d1 = fmaf(iqs[64 + 4 * d + 2], kv.z, d1); d1 = fmaf(iqs[64 + 4 * d + 3], kv.w, d1);
            d2 = fmaf(iqs[128 + 4 * d], kv.x, d2); d2 = fmaf(iqs[128 + 4 * d + 1], kv.y, d2); d2 = fmaf(iqs[128 + 4 * d + 2], kv.z, d2); d2 = fmaf(iqs[128 + 4 * d + 3], kv.w, d2);
            d3 = fmaf(iqs[192 + 4 * d], kv.x, d3); d3 = fmaf(iqs[192 + 4 * d + 1], kv.y, d3); d3 = fmaf(iqs[192 + 4 * d + 2], kv.z, d3); d3 = fmaf(iqs[192 + 4 * d + 3], kv.w, d3);
        }
        float sc = 0.f;
        sc += fmaxf(d0, 0.f) * w0; sc += fmaxf(d1, 0.f) * w1; sc += fmaxf(d2, 0.f) * w2; sc += fmaxf(d3, 0.f) * w3;
        const unsigned b = __float_as_uint(sc);
        keys[s] = (b & 0x80000000u) ? ~b : (b | 0x80000000u);
    }
    __syncthreads();
    int nsel;
    if (N <= 256) { nsel = N; if (tid < N) sel[tid] = tid; }
    else {
        nsel = 256;
        unsigned T = 0u;
        for (int bit = 31; bit >= 0; --bit) {
            const unsigned cand = T | (1u << bit);
            int c = 0;
            for (int s = tid; s < N; s += 256) c += (keys[s] >= cand) ? 1 : 0;
            c = n_block_sum_i(c, redi);
            if (c >= 256) T = cand;
        }
        const int base = tid * 16;
        int ng = 0, nt = 0;
#pragma unroll
        for (int i = 0; i < 16; ++i) { const int s = base + i; if (s < N) { const unsigned k = keys[s]; ng += (k > T) ? 1 : 0; nt += (k == T) ? 1 : 0; } }
        const int cg = n_block_sum_i(ng, redi);
        const int r = 256 - cg;
        int v = ng | (nt << 16);
        __syncthreads();
        scan[tid] = v;
        __syncthreads();
        for (int o = 1; o < 256; o <<= 1) { const int add = (tid >= o) ? scan[tid - o] : 0; __syncthreads(); scan[tid] += add; __syncthreads(); }
        const int ex = scan[tid] - v;
        int pg = ex & 0xffff, pt = ex >> 16;
#pragma unroll
        for (int i = 0; i < 16; ++i) { const int s = base + i;
            if (s < N) { const unsigned k = keys[s]; if (k > T) { sel[pg] = s; ++pg; } else if (k == T) { if (pt < r) sel[cg + pt] = s; ++pt; } } }
    }
    __syncthreads();
    for (int h = 0; h < 8; ++h) {
        float sl = -INFINITY;
        if (tid < nsel) {
            const bf16* kr = Kt + (b0 + sel[tid]) * 512 + h * 64;
            float d = 0.f;
#pragma unroll 4
            for (int i = 0; i < 16; ++i) { const float4 kv = ld4(kr + 4 * i); d = fmaf(qs[h * 64 + 4 * i], kv.x, d); d = fmaf(qs[h * 64 + 4 * i + 1], kv.y, d); d = fmaf(qs[h * 64 + 4 * i + 2], kv.z, d); d = fmaf(qs[h * 64 + 4 * i + 3], kv.w, d); }
            sl = d;
        }
        const float mx = n_block_max_f(sl, redf);
        const float e = (tid < nsel) ? exp2f(sl - mx) : 0.f;
        const float sum = n_block_sum_f(e, redf);
        pw[tid] = e / sum;
        __syncthreads();
        const int d = tid & 63, part = tid >> 6;
        float acc = 0.f;
        for (int j = part; j < nsel; j += 4) acc = fmaf(pw[j], bf2f(V[(b0 + sel[j]) * 512 + h * 64 + d]), acc);
        red4[part][d] = acc;
        __syncthreads();
        if (tid < 64) A2[(size_t)row * 1024 + h * 64 + tid] = (bf16)f2bf((red4[0][tid] + red4[1][tid]) + (red4[2][tid] + red4[3][tid]));
        __syncthreads();
    }
}
__global__ __launch_bounds__(256) void n_conv_k(const bf16* __restrict__ CB, const bf16* __restrict__ P, const float* __restrict__ cw, bf16* __restrict__ A2) {
    const int idx = blockIdx.x * 256 + threadIdx.x;
    const int row = idx >> 9, c = idx & 511, t = row & (SEQ - 1);
    const float p0 = bf2f(P[(size_t)row * 512 + c]);
    const float p1 = (t >= 1) ? bf2f(P[(size_t)(row - 1) * 512 + c]) : 0.f;
    const float p2 = (t >= 2) ? bf2f(P[(size_t)(row - 2) * 512 + c]) : 0.f;
    const float o = cw[c] * p2 + cw[512 + c] * p1 + cw[1024 + c] * p0;
    A2[(size_t)row * 1024 + 512 + c] = (bf16)f2bf(bf2f(CB[(size_t)row * 512 + c]) * o);
}
__global__ __launch_bounds__(256) void n_merge_k(const bf16* __restrict__ SG, float* ya, const float* __restrict__ yc) {
    const int idx = blockIdx.x * 256 + threadIdx.x;
    const int r = idx >> 10, n = idx & 1023;
    ya[idx] = ya[idx] * bf2f(SG[(size_t)r * NPG + n]) + yc[idx] * bf2f(SG[(size_t)r * NPG + 1024 + n]);
}

extern "C" void kernel_launch(void* const* d_in, const int* in_sizes, int n_in, void* d_out, int out_size, void* d_ws, size_t ws_size, hipStream_t stream) {
    static int grid = 0;
    if (grid == 0) {
        int dev = 0, cus = 0, per_cu = 0;
        if (n_in != 11 || out_size != MROWS * D_MODEL || ws_size < WS_END) { fprintf(stderr, "kernel_launch: unexpected problem shape / workspace (%d inputs, out %d, ws %zu)\n", n_in, out_size, ws_size); grid = -1; return; }
        hipGetDevice(&dev); hipDeviceGetAttribute(&cus, hipDeviceAttributeMultiprocessorCount, dev);
        if (hipFuncSetAttribute((const void*)mk_fwd, hipFuncAttributeMaxDynamicSharedMemorySize, LDS_BYTES) != hipSuccess) { fprintf(stderr, "kernel_launch: hipFuncSetAttribute failed\n"); grid = -1; return; }
        if (hipOccupancyMaxActiveBlocksPerMultiprocessor(&per_cu, (const void*)mk_fwd, NWAVES * 64, LDS_BYTES) != hipSuccess || per_cu < 1) { fprintf(stderr, "kernel_launch: occupancy query says %d blocks per CU\n", per_cu); per_cu = 1; }
        (void)hipGetLastError();
        grid = cus;
    }
    if (grid < 0) return;
    const float* x_in = (const float*)d_in[0];
    float* x = (float*)d_out;
    unsigned char* ws = (unsigned char*)d_ws;
    Args a{};
    for (int i = 0; i < 11; ++i) a.in[i] = (const float*)d_in[i];
    a.out = x; a.ws = ws;
    bf16 *Q = (bf16*)(ws + WS_Q), *K = (bf16*)(ws + WS_K), *V = (bf16*)(ws + WS_V), *IQ = (bf16*)(ws + WS_IQ), *IK = (bf16*)(ws + WS_IK), *CB = (bf16*)(ws + WS_CB), *P = (bf16*)(ws + WS_P), *A2 = (bf16*)(ws + WS_A2), *SG = (bf16*)(ws + WS_SG);
    float* IW = (float*)(ws + WS_IW);
#define MK(P0, P1, LL) do { a.ph_lo = (P0); a.ph_hi = (P1); a.layer = (LL); hipLaunchKernelGGL(mk_fwd, dim3(grid), dim3(NWAVES * 64), LDS_BYTES, stream, a); } while (0)
    MK(0, 1, 0);
    for (int l = 0; l < DEPTH; ++l) {
        MK(1, 2, l);
        n_dsa_k<<<MROWS, 256, 0, stream>>>(Q, K, V, IQ, IK, IW, A2);
        n_conv_k<<<MROWS * 512 / 256, 256, 0, stream>>>(CB, P, (const float*)d_in[3] + (size_t)l * 3 * 512, A2);
        MK(4, 5, l); MK(5, 6, l); MK(6, 7, l); MK(7, 8, l); MK(8, 9, l);
    }
    MK(9, 10, 0);
}
```

```cpp
#include <hip/hip_runtime.h>
#include <stdint.h>
#include <math.h>
#include <cstdio>

#define D_MODEL 1024
#define BATCH 4
#define SEQ 4096
#define MROWS 16384
#define DEPTH 2
#define IN_COLS 5444
#define MLP_H 4096
#define OFF_Q 0
#define OFF_K 512
#define OFF_V 1024
#define OFF_IQ 1536
#define OFF_IK 1792
#define OFF_IW 1856
#define OFF_CB 1860
#define OFF_CC 2372
#define OFF_CH 2884
#define OFF_G 3396
#define NP1 3584
#define NPG 2048
#define NPALL 5632
#define C2F 0.18033688011112042f

typedef unsigned short bf16;
#define LAS __attribute__((address_space(3)))
#define GAS __attribute__((address_space(1)))
__device__ __forceinline__ unsigned f2bf(float f) { unsigned u = __builtin_bit_cast(unsigned, f); return (u + 0x7fffu + ((u >> 16) & 1u)) >> 16; }
__device__ __forceinline__ unsigned pk2(float lo, float hi) { return f2bf(lo) | (f2bf(hi) << 16); }
__device__ __forceinline__ float bf2f(unsigned short b) { return __builtin_bit_cast(float, ((unsigned)b) << 16); }

constexpr size_t MiB = 1u << 20;
constexpr size_t WS_CTL = 0, CTL_ZERO_BYTES = 1 * MiB;
constexpr size_t WS_CS = 1 * MiB;
constexpr size_t WS_ROWSQ = 1 * MiB + 512 * 1024;
constexpr size_t WS_IW = 1 * MiB + 768 * 1024;
constexpr size_t WS_WIN = 2 * MiB;
constexpr size_t WS_WOC = 24 * MiB;
constexpr size_t WS_WMIX = 28 * MiB;
constexpr size_t WS_WUP = 32 * MiB;
constexpr size_t WS_WDN = 48 * MiB;
constexpr size_t WS_XG = 64 * MiB;
constexpr size_t WS_Q = 96 * MiB, WS_K = 112 * MiB, WS_V = 128 * MiB;
constexpr size_t WS_IQ = 144 * MiB;
constexpr size_t WS_IK = 152 * MiB;
constexpr size_t WS_MASK = 154 * MiB;
constexpr size_t WS_CB = 162 * MiB, WS_P = 178 * MiB;
constexpr size_t WS_A2 = 194 * MiB;
constexpr size_t WS_SG = 96 * MiB;
constexpr size_t WS_MERGED = 160 * MiB;
constexpr size_t WS_H = 96 * MiB;
constexpr size_t WS_END = 256 * MiB;
namespace pg8 {
#define PG8_LAS __attribute__((address_space(3)))
typedef unsigned short bf16_t;
typedef short bf16x8 __attribute__((ext_vector_type(8)));
typedef float f32x4 __attribute__((ext_vector_type(4)));
typedef unsigned u32x4 __attribute__((ext_vector_type(4)));
constexpr int BM = 256, BK = 64, HALF = 128, HTB = HALF * BK * 2  , STAGE_BYTES = 8 * HTB, NXCD = 8, WGM = 8;

__host__ __device__ __forceinline__ int lds_byte(int r, int c) { const int st = (r >> 4) * 2 + (c >> 5), rr = r & 15, cc = c & 31, ob = rr * 64 + cc * 2; return st * 1024 + (ob ^ (((ob >> 9) & 1) << 5)); }
__host__ __device__ __forceinline__ void stage_rc(int b, int& R, int& C) { const int st = b / 1024, sb = b % 1024, swz = sb ^ (((sb >> 9) & 1) << 5); R = (st >> 1) * 16 + swz / 64; C = (st & 1) * 32 + (swz % 64) / 2; }
__host__ __device__ __forceinline__ int perm32(int rho) { const int n = rho >> 4, i = rho & 15; return 8 * (i >> 2) + 4 * n + (i & 3); }

struct Unit { int pm, pn; };
struct Gemm { const bf16_t* A; const bf16_t* Bt; int M, N, K; };

struct StaticOrder {
    int nM, nN, nwg, G, c;
    __host__ __device__ void init(int M, int N, int G_, int c_) { nM = M / BM; nN = N / BM; nwg = nM * nN; G = G_; c = c_; }
    __host__ __device__ bool next(int i, Unit& u) const {
        const long L = (long)i * G + c; if (L >= nwg) return false;
        int wgid = (int)L; { const int q = nwg / NXCD, r = nwg % NXCD, xcd = wgid % NXCD, off = wgid / NXCD; wgid = (xcd < r ? xcd * (q + 1) : r * (q + 1) + (xcd - r) * q) + off; }
        const int nig = WGM * nN, gid = wgid / nig, fm = gid * WGM, gsz = (nM - fm) < WGM ? (nM - fm) : WGM;
        u.pm = fm + ((wgid % nig) % gsz); u.pn = (wgid % nig) / gsz; return true;
    }
    __device__ __forceinline__ void a_ready(const Unit&) const {}
    __device__ __forceinline__ void done(const Unit&) const {}
};
__device__ __forceinline__ unsigned cvt_pk_bf16(float lo, float hi) { unsigned r; asm volatile("v_cvt_pk_bf16_f32 %0, %1, %2" : "=v"(r) : "v"(lo), "v"(hi)); return r; }
typedef float f32x2 __attribute__((ext_vector_type(2)));
__device__ __forceinline__ int lane_now() { int l; asm volatile("v_mbcnt_lo_u32_b32 %0, -1, 0\n\tv_mbcnt_hi_u32_b32 %0, -1, %0" : "=v"(l)); return l; }
__device__ __forceinline__ float row_rstd(const float* rowsq, int row) {
    const float s = (rowsq[row] + rowsq[MROWS + row]) + (rowsq[2 * MROWS + row] + rowsq[3 * MROWS + row]);
    return 1.0f / sqrtf(s * (1.0f / 1024.0f) + 1e-6f);
}
struct EpiProj {
    static constexpr bool PERM = true, AFTER_DRAIN = false, HAS_MID = false;
    const float* rowsq; const float* cs; bf16_t *Q, *K, *V, *IQ, *IK, *CB, *P; float* IW;
    __device__ __forceinline__ void operator()(const f32x4 (&acc)[2][2][4][2], const Unit& u, int wr, int wc, int, int) const {
        const int ln_ = lane_now(), fr = ln_ & 15, fq = ln_ >> 4;
        const int pn = u.pn, row0 = u.pm * BM + wr * 64 + fr;
        if (pn == 7) {
            if (wc >= 3) return;
            const bool ropeL = (wc == 0) && (fq < 2);
#pragma unroll
            for (int ai = 0; ai < 2; ++ai)
#pragma unroll
                for (int m = 0; m < 4; ++m) {
                    const int row = row0 + ai * HALF + m * 16; const float rs = row_rstd(rowsq, row); const int t = row & (SEQ - 1);
                    const f32x4 v0 = acc[ai][0][m][0] * rs, v1 = acc[ai][0][m][1] * rs;
                    if (wc < 2) {
                        f32x4 c4 = (f32x4){1.f, 1.f, 1.f, 1.f}, s4 = (f32x4){0.f, 0.f, 0.f, 0.f};
                        if (ropeL) { c4 = *(const f32x4*)(cs + t * 8 + 4 * fq); s4 = *(const f32x4*)(cs + SEQ * 8 + t * 8 + 4 * fq); }
                        const f32x4 o0 = v0 * c4 - v1 * s4, o1 = v1 * c4 + v0 * s4;
                        u32x4 w; w.x = cvt_pk_bf16(o0[0], o0[1]); w.y = cvt_pk_bf16(o0[2], o0[3]); w.z = cvt_pk_bf16(o1[0], o1[1]); w.w = cvt_pk_bf16(o1[2], o1[3]);
                        *(u32x4*)(IK + (size_t)row * 64 + wc * 32 + 8 * fq) = w;
                    } else if (fq == 0) {
                        *(f32x4*)(IW + (size_t)row * 4) = v0;
                    }
                }
            return;
        }
        if (pn >= 10) {
#pragma unroll
            for (int ai = 0; ai < 2; ++ai)
#pragma unroll
                for (int m = 0; m < 4; ++m) {
                    const int row = row0 + ai * HALF + m * 16; const float rs = row_rstd(rowsq, row); const float rs2 = rs * rs;
#pragma unroll
                    for (int bj = 0; bj < 2; ++bj) {
                        const f32x4 p = acc[ai][bj][m][0] * acc[ai][bj][m][1] * rs2;
                        unsigned long long w = (unsigned long long)cvt_pk_bf16(p[0], p[1]) | ((unsigned long long)cvt_pk_bf16(p[2], p[3]) << 32);
                        *(unsigned long long*)(P + (size_t)row * 512 + (((pn - 10) * 256 + bj * HALF + wc * 32 + 8 * fq) >> 1)) = w;
                    }
                }
            return;
        }
        bf16_t* dst; int pitch, colb; float sc = 1.f; bool rope = false;
        if (pn < 2) { dst = Q; pitch = 512; colb = pn * 256; sc = C2F; rope = true; }
        else if (pn < 4) { dst = K; pitch = 512; colb = (pn - 2) * 256; rope = true; }
        else if (pn < 6) { dst = V; pitch = 512; colb = (pn - 4) * 256; }
        else if (pn == 6) { dst = IQ; pitch = 256; colb = 0; rope = true; }
        else { dst = CB; pitch = 512; colb = (pn - 8) * 256; }
        const bool ropeL = rope && ((wc & 1) == 0) && (fq < 2);
#pragma unroll
        for (int ai = 0; ai < 2; ++ai)
#pragma unroll
            for (int m = 0; m < 4; ++m) {
                const int row = row0 + ai * HALF + m * 16; const float rs = row_rstd(rowsq, row) * sc; const int t = row & (SEQ - 1);
                f32x4 c4 = (f32x4){1.f, 1.f, 1.f, 1.f}, s4 = (f32x4){0.f, 0.f, 0.f, 0.f};
                if (ropeL) { c4 = *(const f32x4*)(cs + t * 8 + 4 * fq); s4 = *(const f32x4*)(cs + SEQ * 8 + t * 8 + 4 * fq); }
                bf16_t* rowp = dst + (size_t)row * pitch + colb + wc * 32 + 8 * fq;
#pragma unroll
                for (int bj = 0; bj < 2; ++bj) {
                    const f32x4 v0 = acc[ai][bj][m][0] * rs, v1 = acc[ai][bj][m][1] * rs;
                    const f32x4 o0 = v0 * c4 - v1 * s4, o1 = v1 * c4 + v0 * s4;
                    u32x4 w; w.x = cvt_pk_bf16(o0[0], o0[1]); w.y = cvt_pk_bf16(o0[2], o0[3]); w.z = cvt_pk_bf16(o1[0], o1[1]); w.w = cvt_pk_bf16(o1[2], o1[3]);
                    *(u32x4*)(rowp + bj * HALF) = w;
                }
            }
    }
};
struct EpiSig {
    static constexpr bool PERM = true, AFTER_DRAIN = false, HAS_MID = false;
    const float* rowsq; bf16_t* SG;
    __device__ __forceinline__ void operator()(const f32x4 (&acc)[2][2][4][2], const Unit& u, int wr, int wc, int, int) const {
        const int ln_ = lane_now(), fr = ln_ & 15, fq = ln_ >> 4;
        const int row0 = u.pm * BM + wr * 64 + fr, col0 = u.pn * BM + wc * 32 + 8 * fq;
#pragma unroll
        for (int ai = 0; ai < 2; ++ai)
#pragma unroll
            for (int m = 0; m < 4; ++m) {
                const int row = row0 + ai * HALF + m * 16; const float rs = row_rstd(rowsq, row) * (-1.4426950408889634f);
                bf16_t* rowp = SG + (size_t)row * NPG + col0;
#pragma unroll
                for (int bj = 0; bj < 2; ++bj) {
                    f32x4 v0 = acc[ai][bj][m][0] * rs, v1 = acc[ai][bj][m][1] * rs;
#pragma unroll
                    for (int j = 0; j < 4; ++j) { v0[j] = __builtin_amdgcn_rcpf(1.0f + __builtin_amdgcn_exp2f(v0[j])); v1[j] = __builtin_amdgcn_rcpf(1.0f + __builtin_amdgcn_exp2f(v1[j])); }
                    u32x4 w; w.x = cvt_pk_bf16(v0[0], v0[1]); w.y = cvt_pk_bf16(v0[2], v0[3]); w.z = cvt_pk_bf16(v1[0], v1[1]); w.w = cvt_pk_bf16(v1[2], v1[3]);
                    *(u32x4*)(rowp + bj * HALF) = w;
                }
            }
    }
};
struct EpiMerged {
    static constexpr bool PERM = true, AFTER_DRAIN = false, HAS_MID = true;
    const bf16_t* SG; bf16_t* O;
    __device__ __forceinline__ void mid(f32x4 (&acc)[2][2][4][2], const Unit& u, int wr, int wc, int, int) const {
        const int ln_ = lane_now(), fr = ln_ & 15, fq = ln_ >> 4;
        const int row0 = u.pm * BM + wr * 64 + fr, col0 = u.pn * BM + wc * 32 + 8 * fq;
#pragma unroll
        for (int ai = 0; ai < 2; ++ai)
#pragma unroll
            for (int m = 0; m < 4; ++m) {
                const bf16_t* sp = SG + (size_t)(row0 + ai * HALF + m * 16) * NPG + col0;
#pragma unroll
                for (int bj = 0; bj < 2; ++bj) {
                    const u32x4 a = *(const u32x4*)(sp + bj * HALF), c = *(const u32x4*)(sp + 1024 + bj * HALF);
#pragma unroll
                    for (int j = 0; j < 4; ++j) {
                        const float a0 = __builtin_bit_cast(float, a[j] << 16), a1 = __builtin_bit_cast(float, a[j] & 0xffff0000u);
                        const float c0 = __builtin_bit_cast(float, c[j] << 16), c1 = __builtin_bit_cast(float, c[j] & 0xffff0000u);
                        const float r0 = a0 * __builtin_amdgcn_rcpf(c0), r1 = a1 * __builtin_amdgcn_rcpf(c1);
                        acc[ai][bj][m][j >> 1][(j & 1) * 2] *= r0; acc[ai][bj][m][j >> 1][(j & 1) * 2 + 1] *= r1;
                    }
                }
            }
    }
    __device__ __forceinline__ void operator()(const f32x4 (&acc)[2][2][4][2], const Unit& u, int wr, int wc, int, int) const {
        const int ln_ = lane_now(), fr = ln_ & 15, fq = ln_ >> 4;
        const int row0 = u.pm * BM + wr * 64 + fr, col0 = u.pn * BM + wc * 32 + 8 * fq;
#pragma unroll
        for (int ai = 0; ai < 2; ++ai)
#pragma unroll
            for (int m = 0; m < 4; ++m) {
                const int row = row0 + ai * HALF + m * 16;
                const bf16_t* sp = SG + (size_t)row * NPG + 1024 + col0;
                bf16_t* rowp = O + (size_t)row * 1024 + col0;
#pragma unroll
                for (int bj = 0; bj < 2; ++bj) {
                    const u32x4 c = *(const u32x4*)(sp + bj * HALF);
                    float o[8];
#pragma unroll
                    for (int j = 0; j < 4; ++j) {
                        const float c0 = __builtin_bit_cast(float, c[j] << 16), c1 = __builtin_bit_cast(float, c[j] & 0xffff0000u);
                        o[2 * j] = acc[ai][bj][m][j >> 1][(j & 1) * 2] * c0; o[2 * j + 1] = acc[ai][bj][m][j >> 1][(j & 1) * 2 + 1] * c1;
                    }
                    u32x4 w; w.x = cvt_pk_bf16(o[0], o[1]); w.y = cvt_pk_bf16(o[2], o[3]); w.z = cvt_pk_bf16(o[4], o[5]); w.w = cvt_pk_bf16(o[6], o[7]);
                    *(u32x4*)(rowp + bj * HALF) = w;
                }
            }
    }
};
struct EpiRelu2 {
    static constexpr bool PERM = true, AFTER_DRAIN = false, HAS_MID = false;
    const float* rowsq; bf16_t* O;
    __device__ __forceinline__ void operator()(const f32x4 (&acc)[2][2][4][2], const Unit& u, int wr, int wc, int, int) const {
        const int ln_ = lane_now(), fr = ln_ & 15, fq = ln_ >> 4;
        const int row0 = u.pm * BM + wr * 64 + fr, col0 = u.pn * BM + wc * 32 + 8 * fq;
#pragma unroll
        for (int ai = 0; ai < 2; ++ai)
#pragma unroll
            for (int m = 0; m < 4; ++m) {
                const int row = row0 + ai * HALF + m * 16; const float rs = row_rstd(rowsq, row);
                bf16_t* rowp = O + (size_t)row * MLP_H + col0;
#pragma unroll
                for (int bj = 0; bj < 2; ++bj) {
                    f32x4 v0 = acc[ai][bj][m][0] * rs, v1 = acc[ai][bj][m][1] * rs;
#pragma unroll
                    for (int j = 0; j < 4; ++j) { const float a = fmaxf(v0[j], 0.f), b = fmaxf(v1[j], 0.f); v0[j] = a * a; v1[j] = b * b; }
                    u32x4 w; w.x = cvt_pk_bf16(v0[0], v0[1]); w.y = cvt_pk_bf16(v0[2], v0[3]); w.z = cvt_pk_bf16(v1[0], v1[1]); w.w = cvt_pk_bf16(v1[2], v1[3]);
                    *(u32x4*)(rowp + bj * HALF) = w;
                }
            }
    }
};
struct EpiResid {
    static constexpr bool PERM = false, AFTER_DRAIN = true, HAS_MID = false;
    const float* base; float* out; bf16_t* xg; const float* gnext; float* rowsq;
    __device__ __forceinline__ void fused(f32x4 (&acc)[2][2][4][2], const Unit& u, int wr, int wc, int, int, PG8_LAS unsigned char* lds, int wid, int) const {
        const int lane = lane_now(), fr = lane & 15, fq = lane >> 4;
        PG8_LAS float* Pt = (PG8_LAS float*)lds;
        const int col0 = u.pn * BM + wc * 32 + 4 * fq;
        f32x4 gv[2][2];
#pragma unroll
        for (int bj = 0; bj < 2; ++bj)
#pragma unroll
            for (int n = 0; n < 2; ++n) gv[bj][n] = gnext ? *(const f32x4*)(gnext + col0 + bj * HALF + n * 16) : (f32x4){0.f, 0.f, 0.f, 0.f};
#pragma unroll
        for (int ai = 0; ai < 2; ++ai)
#pragma unroll
            for (int m = 0; m < 4; ++m) {
                const int r = ai * HALF + wr * 64 + m * 16 + fr; const size_t off = (size_t)(u.pm * BM + r) * D_MODEL + col0; float s = 0.f;
#pragma unroll
                for (int bj = 0; bj < 2; ++bj)
#pragma unroll
                    for (int n = 0; n < 2; ++n) {
                        const f32x4 bs = *(const f32x4*)(base + off + bj * HALF + n * 16); const f32x4 xn = bs + acc[ai][bj][m][n];
                        *(f32x4*)(out + off + bj * HALF + n * 16) = xn;
                        s += (xn[0] * xn[0] + xn[1] * xn[1]) + (xn[2] * xn[2] + xn[3] * xn[3]);
                        if (gnext) { const f32x4 y = xn * gv[bj][n];
                            *(unsigned long long*)(xg + off + bj * HALF + n * 16) = (unsigned long long)cvt_pk_bf16(y[0], y[1]) | ((unsigned long long)cvt_pk_bf16(y[2], y[3]) << 32); }
                    }
                s += __shfl_xor(s, 16); s += __shfl_xor(s, 32);
                if (fq == 0) Pt[r * 4 + wc] = s;
                asm volatile("" ::: "memory");
            }
        asm volatile("s_waitcnt lgkmcnt(0)" ::: "memory"); __builtin_amdgcn_s_barrier(); asm volatile("" ::: "memory");
        const int tid = wid * 64 + lane;
        if (tid < 256) rowsq[(size_t)u.pn * MROWS + u.pm * BM + tid] = (Pt[tid * 4] + Pt[tid * 4 + 1]) + (Pt[tid * 4 + 2] + Pt[tid * 4 + 3]);
    }
};
template <class Epi, class Sched, bool ALIGN_EPI = false, bool SP2 = false>
__device__ __forceinline__ void gemm_phase(PG8_LAS unsigned char* lds, const Gemm g, const Sched& S, const Epi& E, const int wid) {
    const int lane = lane_now(), tid = wid * 64 + lane, wr = wid >> 2, wc = wid & 3, fr = lane & 15, fq = lane >> 4;
    const int K = g.K, nt = K / BK;
    unsigned voffA[2], voffB[2];
#pragma unroll
    for (int i = 0; i < 2; ++i) { int R, C; stage_rc(tid * 16 + i * 8192, R, C); const int Rb = Epi::PERM ? ((R & ~31) + perm32(R & 31)) : R;
        voffA[i] = (unsigned)(R * K + C) * 2u; voffB[i] = (unsigned)(Rb * K + C) * 2u; }
    const size_t kstep = (size_t)(BK * 2);
    const size_t hstep = (size_t)HALF * K * 2;
    const size_t tstep = 2 * hstep;
    const unsigned ldsw = (unsigned)wid * 1024u;
    const int aoff = lds_byte(wr * 64 + fr, fq * 8), boff = lds_byte(wc * 32 + fr, fq * 8);
#define PG8_SA(b, h) (((b) * 2 + (h)) * HTB)
#define PG8_SB(b, h) ((4 + (b) * 2 + (h)) * HTB)
#define PG8_STAGE(bufoff, gbase, voff) do { _Pragma("unroll") for (int _i = 0; _i < 2; ++_i) \
        __builtin_amdgcn_global_load_lds((const unsigned*)((const char*)(gbase) + (voff)[_i]), (PG8_LAS unsigned*)(lds + (bufoff) + ldsw + _i * 8192), 16, 0, 0); } while (0)
#define PG8_LDA(dst, b, h) do { _Pragma("unroll") for (int m = 0; m < 4; ++m) _Pragma("unroll") for (int k = 0; k < 2; ++k) dst[m][k] = *(const PG8_LAS bf16x8*)(lds + PG8_SA(b, h) + aoff + m * 2048 + k * 1024); } while (0)
#define PG8_LDB(dst, b, h) do { _Pragma("unroll") for (int n = 0; n < 2; ++n) _Pragma("unroll") for (int k = 0; k < 2; ++k) dst[n][k] = *(const PG8_LAS bf16x8*)(lds + PG8_SB(b, h) + boff + n * 2048 + k * 1024); } while (0)
#define PG8_MMA(ai, bj, At, Bt) do { __builtin_amdgcn_s_setprio(1); _Pragma("unroll") for (int m = 0; m < 4; ++m) _Pragma("unroll") for (int n = 0; n < 2; ++n) _Pragma("unroll") for (int k = 0; k < 2; ++k) \
        acc[ai][bj][m][n] = __builtin_amdgcn_mfma_f32_16x16x32_bf16(Bt[n][k], At[m][k], acc[ai][bj][m][n], 0, 0, 0); __builtin_amdgcn_s_setprio(0); } while (0)
#define PG8_WAIT_V(n) asm volatile("s_waitcnt vmcnt(" #n ")" ::: "memory")
#define PG8_WAIT_L(n) asm volatile("s_waitcnt lgkmcnt(" #n ")" ::: "memory")
#define PG8_BAR __builtin_amdgcn_s_barrier()
#define PG8_SCHED __builtin_amdgcn_sched_barrier(0)
    Unit cur, nxt; int ui = 0;
    if (!S.next(0, cur)) return;
    f32x4 acc[2][2][4][2];
#pragma unroll
    for (int a = 0; a < 2; ++a)
#pragma unroll
        for (int b = 0; b < 2; ++b)
#pragma unroll
            for (int m = 0; m < 4; ++m)
#pragma unroll
                for (int n = 0; n < 2; ++n) acc[a][b][m][n] = (f32x4){0.f, 0.f, 0.f, 0.f};
    bf16x8 At[4][2], B0[2][2], B1[2][2];
    const char* cA = (const char*)g.A + (size_t)cur.pm * tstep; const char* cB = (const char*)g.Bt + (size_t)cur.pn * tstep;
    S.a_ready(cur);
    if constexpr (SP2) {
        PG8_STAGE(PG8_SB(0, 0), cB, voffB); PG8_STAGE(PG8_SB(0, 1), cB + hstep, voffB); PG8_STAGE(PG8_SA(0, 0), cA, voffA); PG8_STAGE(PG8_SA(0, 1), cA + hstep, voffA);
        if (wr == 1) PG8_BAR;
        PG8_WAIT_V(2); PG8_BAR;
        PG8_STAGE(PG8_SB(1, 0), cB + kstep, voffB); PG8_STAGE(PG8_SA(1, 0), cA + kstep, voffA); PG8_STAGE(PG8_SB(1, 1), cB + hstep + kstep, voffB);
        PG8_WAIT_V(6); PG8_BAR;
    } else {
        PG8_STAGE(PG8_SB(0, 0), cB, voffB); PG8_STAGE(PG8_SA(0, 0), cA, voffA); PG8_STAGE(PG8_SB(0, 1), cB + hstep, voffB); PG8_STAGE(PG8_SA(0, 1), cA + hstep, voffA);
        if (wr == 1) PG8_BAR;
        PG8_WAIT_V(4); PG8_BAR;
        PG8_STAGE(PG8_SB(1, 0), cB + kstep, voffB); PG8_STAGE(PG8_SA(1, 0), cA + kstep, voffA); PG8_STAGE(PG8_SB(1, 1), cB + hstep + kstep, voffB);
        PG8_WAIT_V(6); PG8_BAR;
    }
    for (;;) {
        const bool has_next = S.next(ui + 1, nxt);
        const char* nA = has_next ? (const char*)g.A + (size_t)nxt.pm * tstep : cA; const char* nB = has_next ? (const char*)g.Bt + (size_t)nxt.pn * tstep : cB;
        for (int t = 0; t < nt; t += 2) {
            const bool last = (t == nt - 2);
            const char* a1 = cA + (size_t)(t + 1) * kstep;
            const char* a2 = last ? nA : cA + (size_t)(t + 2) * kstep; const char* b2 = last ? nB : cB + (size_t)(t + 2) * kstep;
            const char* a3 = a2 + kstep; const char* b3 = b2 + kstep;
            if (last && has_next) S.a_ready(nxt);
            if constexpr (Epi::HAS_MID) { if (t == (nt >> 1)) E.mid(acc, cur, wr, wc, fr, fq); }
            if constexpr (SP2) {
            PG8_LDB(B0, 0, 0); PG8_LDB(B1, 0, 1); PG8_SCHED; PG8_LDA(At, 0, 0); PG8_STAGE(PG8_SA(1, 1), a1 + hstep, voffA);
            PG8_WAIT_V(8); PG8_WAIT_L(0); PG8_BAR; PG8_MMA(0, 0, At, B0); PG8_MMA(0, 1, At, B1); PG8_BAR; PG8_SCHED;
            PG8_LDA(At, 0, 1); PG8_STAGE(PG8_SB(0, 0), b2, voffB); PG8_STAGE(PG8_SB(0, 1), b2 + hstep, voffB); PG8_STAGE(PG8_SA(0, 0), a2, voffA);
            PG8_WAIT_V(8); PG8_WAIT_L(0); PG8_BAR; PG8_MMA(1, 0, At, B0); PG8_MMA(1, 1, At, B1); PG8_BAR; PG8_SCHED;
            PG8_LDB(B0, 1, 0); PG8_LDB(B1, 1, 1); PG8_SCHED; PG8_LDA(At, 1, 0); PG8_STAGE(PG8_SA(0, 1), a2 + hstep, voffA);
            PG8_WAIT_V(8); PG8_WAIT_L(0); PG8_BAR; PG8_MMA(0, 0, At, B0); PG8_MMA(0, 1, At, B1); PG8_BAR; PG8_SCHED;
            PG8_LDA(At, 1, 1); PG8_STAGE(PG8_SB(1, 0), b3, voffB); PG8_STAGE(PG8_SB(1, 1), b3 + hstep, voffB); PG8_STAGE(PG8_SA(1, 0), a3, voffA);
            PG8_WAIT_V(8); PG8_WAIT_L(0); PG8_BAR; PG8_MMA(1, 0, At, B0); PG8_MMA(1, 1, At, B1); PG8_BAR; PG8_SCHED;
            } else {
            PG8_LDB(B0, 0, 0); PG8_SCHED; PG8_LDA(At, 0, 0); PG8_STAGE(PG8_SA(1, 1), a1 + hstep, voffA);
            PG8_WAIT_L(8); PG8_BAR; PG8_WAIT_L(0); PG8_MMA(0, 0, At, B0); PG8_BAR; PG8_SCHED;
            PG8_LDB(B1, 0, 1); PG8_STAGE(PG8_SB(0, 0), b2, voffB);
            PG8_BAR; PG8_WAIT_L(0); PG8_MMA(0, 1, At, B1); PG8_BAR;
            PG8_LDA(At, 0, 1); PG8_STAGE(PG8_SA(0, 0), a2, voffA);
            PG8_BAR; PG8_WAIT_L(0); PG8_MMA(1, 0, At, B0); PG8_BAR; PG8_SCHED;
            PG8_STAGE(PG8_SB(0, 1), b2 + hstep, voffB);
            PG8_WAIT_V(6); PG8_BAR; PG8_MMA(1, 1, At, B1); PG8_BAR;
            PG8_LDB(B0, 1, 0); PG8_SCHED; PG8_LDA(At, 1, 0); PG8_STAGE(PG8_SA(0, 1), a2 + hstep, voffA);
            PG8_WAIT_L(8); PG8_BAR; PG8_WAIT_L(0); PG8_MMA(0, 0, At, B0); PG8_BAR; PG8_SCHED;
            PG8_LDB(B1, 1, 1); PG8_STAGE(PG8_SB(1, 0), b3, voffB);
            PG8_BAR; PG8_WAIT_L(0); PG8_MMA(0, 1, At, B1); PG8_BAR;
            PG8_LDA(At, 1, 1); PG8_STAGE(PG8_SA(1, 0), a3, voffA);
            PG8_BAR; PG8_WAIT_L(0); PG8_MMA(1, 0, At, B0); PG8_BAR; PG8_SCHED;
            PG8_STAGE(PG8_SB(1, 1), b3 + hstep, voffB);
            PG8_WAIT_V(6); PG8_BAR; PG8_MMA(1, 1, At, B1); PG8_BAR;
            }
        }
        if constexpr (ALIGN_EPI) { if (wr == 0) PG8_BAR; }
        if constexpr (!Epi::AFTER_DRAIN) { E(acc, cur, wr, wc, fr, fq); S.done(cur); }
        if (!has_next) break;
#pragma unroll
        for (int a = 0; a < 2; ++a)
#pragma unroll
            for (int b = 0; b < 2; ++b)
#pragma unroll
                for (int m = 0; m < 4; ++m)
#pragma unroll
                    for (int n = 0; n < 2; ++n) acc[a][b][m][n] = (f32x4){0.f, 0.f, 0.f, 0.f};
        cur = nxt; cA = nA; cB = nB; ++ui;
        if constexpr (ALIGN_EPI) { if (wr == 1) PG8_BAR; }
    }
    PG8_WAIT_V(0);
    if constexpr (!ALIGN_EPI) { if (wr == 0) PG8_BAR; }
    PG8_BAR;
    if constexpr (Epi::AFTER_DRAIN) { E.fused(acc, cur, wr, wc, fr, fq, lds, wid, lane); S.done(cur); }
#undef PG8_SA
#undef PG8_SB
#undef PG8_STAGE
#undef PG8_LDA
#undef PG8_LDB
#undef PG8_MMA
#undef PG8_WAIT_V
#undef PG8_WAIT_L
#undef PG8_BAR
#undef PG8_SCHED
}
}
constexpr int NWAVES = 8;
constexpr int RING_OFF = 0, RING_BYTES = 131072;
constexpr int LDS_BYTES = 147456;
constexpr int MISC_OFF = 140000;
static_assert(MISC_OFF % 16 == 0 && MISC_OFF + 256 <= LDS_BYTES, "LDS map");

typedef unsigned v4u __attribute__((ext_vector_type(4)));
typedef float f32x4 __attribute__((ext_vector_type(4)));
#define LDS_WAIT() asm volatile("s_waitcnt lgkmcnt(0)" ::: "memory")
#define VM_WAIT() asm volatile("s_waitcnt vmcnt(0)" ::: "memory")

__device__ __forceinline__ float wave_sum(float v) {
#pragma unroll
    for (int o = 1; o < 64; o <<= 1) v += __shfl_xor(v, o);
    return v;
}

__device__ __forceinline__ int rperm(int p) { return p < 16 ? ((p & 3) | ((p & 4) << 1) | ((p & 8) >> 1)) : p; }
__device__ __forceinline__ int win_src_col(int n) {
    if (n < 512) return OFF_Q + (n & ~63) + rperm(n & 63);
    if (n < 1024) { const int m = n - 512; return OFF_K + (m & ~63) + rperm(m & 63); }
    if (n < 1536) return OFF_V + (n - 1024);
    if (n < 1792) { const int m = n - 1536; return OFF_IQ + (m & ~63) + rperm(m & 63); }
    if (n < 1856) return OFF_IK + rperm(n - 1792);
    if (n < 1860) return OFF_IW + (n - 1856);
    if (n < 2048) return -1;
    if (n < 2560) return OFF_CB + (n - 2048);
    if (n < 3584) { const int m = n - 2560, G = m >> 3, i = m & 7; return i < 4 ? OFF_CC + 4 * G + i : OFF_CH + 4 * G + (i - 4); }
    return OFF_G + (n - 3584);
}
template <bool MAPPED>
__device__ __forceinline__ void transpose_item(const float* __restrict__ W, int Nsrc, bf16* WT, int dst_ld, int dst_col0, int k0, int n0, LAS float* scr, int lane) {
    const int nn = n0 + (lane & 31);
    const int sc = MAPPED ? win_src_col(nn) : nn;
#pragma unroll 8
    for (int i = 0; i < 32; ++i) { const int kk = 2 * i + (lane >> 5); scr[kk * 33 + (lane & 31)] = (sc >= 0) ? W[(size_t)(k0 + kk) * Nsrc + sc] : 0.f; }
    LDS_WAIT(); asm volatile("" ::: "memory");
    const int c = lane & 7;
#pragma unroll
    for (int j = 0; j < 4; ++j) { const int n = (lane >> 3) + 8 * j; const LAS float* s = scr + (8 * c) * 33 + n;
        v4u o; o.x = pk2(s[0 * 33], s[1 * 33]); o.y = pk2(s[2 * 33], s[3 * 33]); o.z = pk2(s[4 * 33], s[5 * 33]); o.w = pk2(s[6 * 33], s[7 * 33]);
        *(GAS v4u*)(WT + (size_t)(n0 + n) * dst_ld + dst_col0 + k0 + 8 * c) = o; }
    LDS_WAIT(); asm volatile("" ::: "memory");
}
__device__ __forceinline__ void sincos_acc(float ang_f, float& s_out, float& c_out) {
    const double a = (double)ang_f;
    const double q = rint(a * 0.63661977236758134308);
    double r = fma(-q, 1.57079632679489655800e+00, a);
    r = fma(-q, 6.12323399573676603587e-17, r);
    const double r2 = r * r;
    double sp = 1.0 / 6227020800.0; sp = fma(sp, r2, -1.0 / 39916800.0); sp = fma(sp, r2, 1.0 / 362880.0); sp = fma(sp, r2, -1.0 / 5040.0);
    sp = fma(sp, r2, 1.0 / 120.0); sp = fma(sp, r2, -1.0 / 6.0); sp = fma(sp, r2, 1.0);
    const double sn = sp * r;
    double cp = 1.0 / 87178291200.0; cp = fma(cp, r2, -1.0 / 479001600.0); cp = fma(cp, r2, 1.0 / 3628800.0); cp = fma(cp, r2, -1.0 / 40320.0);
    cp = fma(cp, r2, 1.0 / 720.0); cp = fma(cp, r2, -1.0 / 24.0); cp = fma(cp, r2, 0.5); cp = fma(-cp, r2, 1.0);
    const int qi = ((int)q) & 3;
    double s, c;
    if (qi == 0) { s = sn; c = cp; } else if (qi == 1) { s = cp; c = -sn; } else if (qi == 2) { s = -sn; c = -cp; } else { s = -cp; c = sn; }
    s_out = (float)s; c_out = (float)c;
}
__device__ __forceinline__ float rope_inv(int j) {
    return j == 0 ? 1.0f : j == 1 ? 0.193922758102417f : j == 2 ? 0.03760603070259094f : j == 3 ? 0.00729266507551074f : j == 4 ? 0.001414213445968926f
         : j == 5 ? 0.00027424818836152554f : j == 6 ? 5.318296462064609e-05f : 1.0313385246263351e-05f;
}
__device__ __forceinline__ void xg_row(const float* xrow, const float* g, bf16* orow, float* rowsq, int row, int lane) {
    const GAS f32x4* xr = (const GAS f32x4*)xrow + lane; const GAS f32x4* gr = (const GAS f32x4*)g + lane;
    f32x4 v[4]; float s = 0.f;
#pragma unroll
    for (int j = 0; j < 4; ++j) { v[j] = xr[64 * j]; s += (v[j].x * v[j].x + v[j].y * v[j].y) + (v[j].z * v[j].z + v[j].w * v[j].w); }
    s = wave_sum(s);
    GAS unsigned long long* o8 = (GAS unsigned long long*)orow + lane;
#pragma unroll
    for (int j = 0; j < 4; ++j) { const f32x4 gg = gr[64 * j]; o8[64 * j] = (unsigned long long)pk2(v[j].x * gg.x, v[j].y * gg.y) | ((unsigned long long)pk2(v[j].z * gg.z, v[j].w * gg.w) << 32); }
    if (lane < 4) rowsq[lane * MROWS + row] = (lane == 0) ? s : 0.f;
}

namespace sel {
typedef short bf16x8 __attribute__((ext_vector_type(8)));
typedef float f32x4 __attribute__((ext_vector_type(4)));
typedef unsigned u32x4 __attribute__((ext_vector_type(4)));
constexpr int ROWB = 8208;
constexpr int K16_BYTES = 16 * ROWB;
constexpr int MSK_OFF = K16_BYTES;
static_assert(MSK_OFF + 8192 <= MISC_OFF, "selection LDS map");
__device__ __forceinline__ int lane_now() { int l; asm volatile("v_mbcnt_lo_u32_b32 %0, -1, 0\n\tv_mbcnt_hi_u32_b32 %0, -1, %0" : "=v"(l)); return l; }
__device__ __forceinline__ void wg_barrier() { asm volatile("s_waitcnt vmcnt(0) lgkmcnt(0)\n\ts_barrier" ::: "memory"); }
__device__ __forceinline__ unsigned long long low_n_bits(unsigned long long m, int n) { unsigned long long a = 0ull; for (int i = 0; i < n; ++i) { const unsigned long long lb = m & (0ull - m); a |= lb; m ^= lb; } return a; }
__device__ __forceinline__ unsigned key_pair(float a, float b) {
    const unsigned x = __builtin_bit_cast(unsigned, __builtin_amdgcn_cvt_pkrtz(a, b));
    const unsigned neg = (x >> 15) & 0x00010001u;
    return x ^ (0x80008000u | (neg * 0x7fffu));
}
__device__ __forceinline__ void sel_unit(LAS unsigned char* lds, const int b, const int qb16, const bf16* __restrict__ IQ, const bf16* __restrict__ IK, const float* __restrict__ IW,
                                         unsigned long long* __restrict__ MASK, const int wid) {
    const int lane = lane_now();
    const int q = lane & 15, g = lane >> 4;
    const int t0 = qb16 * 16;
    const int N = ((t0 >> 6) + 1) << 6;
    const int NST = (N + 127) >> 7;
    const size_t rb = (size_t)b * SEQ;
    {
        bf16x8 bq[4][2];
#pragma unroll
        for (int h = 0; h < 4; ++h)
#pragma unroll
            for (int ks = 0; ks < 2; ++ks) bq[h][ks] = *(const bf16x8*)(IQ + (rb + t0 + q) * 256 + h * 64 + ks * 32 + 8 * g);
        const f32x4 w4 = *(const f32x4*)(IW + (rb + t0 + q) * 4);
        for (int st = wid; st < NST; st += 8) {
            const int k0 = st * 128;
            const bool hiok = (k0 + 64) < N;
#pragma unroll
            for (int kt = 0; kt < 4; ++kt) {
                const bf16* ikA = IK + (rb + k0 + 16 * kt + q) * 64 + 8 * g;
                const bf16* ikB = ikA + 64 * 64;
                const bf16x8 aA0 = *(const bf16x8*)ikA, aA1 = *(const bf16x8*)(ikA + 32), aB0 = *(const bf16x8*)ikB, aB1 = *(const bf16x8*)(ikB + 32);
                f32x4 sA = (f32x4){0.f, 0.f, 0.f, 0.f}, sB = (f32x4){0.f, 0.f, 0.f, 0.f};
#pragma unroll
                for (int h = 0; h < 4; ++h) {
                    f32x4 cA = __builtin_amdgcn_mfma_f32_16x16x32_bf16(aA0, bq[h][0], (f32x4){0.f, 0.f, 0.f, 0.f}, 0, 0, 0);
                    cA = __builtin_amdgcn_mfma_f32_16x16x32_bf16(aA1, bq[h][1], cA, 0, 0, 0);
                    f32x4 cB = __builtin_amdgcn_mfma_f32_16x16x32_bf16(aB0, bq[h][0], (f32x4){0.f, 0.f, 0.f, 0.f}, 0, 0, 0);
                    cB = __builtin_amdgcn_mfma_f32_16x16x32_bf16(aB1, bq[h][1], cB, 0, 0, 0);
#pragma unroll
                    for (int r = 0; r < 4; ++r) { sA[r] = fmaf(fmaxf(cA[r], 0.f), w4[h], sA[r]); sB[r] = fmaf(fmaxf(cB[r], 0.f), w4[h], sB[r]); }
                }
                u32x4 d;
#pragma unroll
                for (int r = 0; r < 4; ++r) { const unsigned k = key_pair(sA[r], sB[r]); d[r] = hiok ? k : (k & 0xffffu); }
                *(LAS u32x4*)(lds + q * ROWB + (st * 64 + 16 * kt + 4 * g) * 4) = d;
            }
        }
    }
    wg_barrier();
#pragma unroll 1
    for (int qq = 0; qq < 2; ++qq) {
        const int ql = 2 * wid + qq;
        const LAS unsigned* rowp = (const LAS unsigned*)(lds + ql * ROWB);
        unsigned xh[32], xl[32];
#pragma unroll
        for (int j = 0; j < 32; ++j) { xh[j] = (j < NST) ? rowp[j * 64 + lane] : 0u; xl[j] = xh[j] << 16; }
        unsigned T = 0u; int rem = 0;
        if (N > 256) {
#pragma unroll 1
            for (int bit = 15; bit >= 0; --bit) {
                const unsigned cand = (T | (1u << bit)) << 16;
                int c = 0;
#pragma unroll
                for (int g8 = 0; g8 < 4; ++g8) if (g8 * 8 < NST) {
#pragma unroll
                    for (int jj = 0; jj < 8; ++jj) { const int j = g8 * 8 + jj;
                        c += __builtin_popcountll(__builtin_amdgcn_ballot_w64(xh[j] >= cand)) + __builtin_popcountll(__builtin_amdgcn_ballot_w64(xl[j] >= cand)); }
                }
                if (c >= 256) T |= (1u << bit);
            }
            const unsigned tg = (T + 1u) << 16;
            int cg = 0;
#pragma unroll
            for (int j = 0; j < 32; ++j) cg += __builtin_popcountll(__builtin_amdgcn_ballot_w64(xh[j] >= tg)) + __builtin_popcountll(__builtin_amdgcn_ballot_w64(xl[j] >= tg));
            rem = 256 - cg;
        }
        const unsigned te = T << 16, tg2 = (T + 1u) << 16;
        unsigned mlo = 0u, mhi = 0u;
#pragma unroll
        for (int j = 0; j < 32; ++j) {
#pragma unroll
            for (int hf = 0; hf < 2; ++hf) {
                const int tile = 2 * j + hf;
                unsigned long long m;
                if (N <= 256) m = (tile * 64 < N) ? ~0ull : 0ull;
                else {
                    const unsigned v = hf ? (xh[j] & 0xffff0000u) : xl[j];
                    m = __builtin_amdgcn_ballot_w64(v >= tg2);
                    const unsigned long long eq = __builtin_amdgcn_ballot_w64(v == te);
                    const int ce = __builtin_popcountll(eq);
                    if (ce <= rem) { m |= eq; rem -= ce; } else { m |= low_n_bits(eq, rem); rem = 0; }
                }
                { const unsigned ml_ = __builtin_amdgcn_readfirstlane((unsigned)m), mh_ = __builtin_amdgcn_readfirstlane((unsigned)(m >> 32));
                  asm volatile("v_writelane_b32 %0, %1, %2" : "+v"(mlo) : "s"(ml_), "n"(tile));
                  asm volatile("v_writelane_b32 %0, %1, %2" : "+v"(mhi) : "s"(mh_), "n"(tile)); }
            }
        }
        *(LAS unsigned long long*)(lds + MSK_OFF + ql * 512 + lane * 8) = (unsigned long long)mlo | ((unsigned long long)mhi << 32);
    }
    wg_barrier();
    {
        const int tid = wid * 64 + lane, tile = tid >> 3, pr = tid & 7;
        const unsigned long long m0 = *(const LAS unsigned long long*)(lds + MSK_OFF + (2 * pr) * 512 + tile * 8);
        const unsigned long long m1 = *(const LAS unsigned long long*)(lds + MSK_OFF + (2 * pr + 1) * 512 + tile * 8);
        u32x4 o; o.x = (unsigned)m0; o.y = (unsigned)(m0 >> 32); o.z = (unsigned)m1; o.w = (unsigned)(m1 >> 32);
        *(u32x4*)(MASK + ((size_t)(b * 64 + tile) * SEQ + t0 + 2 * pr)) = o;
    }
    wg_barrier();
}
__device__ __forceinline__ void convmid_rows(const bf16* __restrict__ CB, const bf16* __restrict__ P, const float* __restrict__ cw, bf16* __restrict__ A2, const int row_base, const int wid) {
    const int lane = lane_now(); const int c8 = lane * 8;
    f32x4 w[3][2];
#pragma unroll
    for (int k = 0; k < 3; ++k) { w[k][0] = *(const f32x4*)(cw + k * 512 + c8); w[k][1] = *(const f32x4*)(cw + k * 512 + c8 + 4); }
#pragma unroll 1
    for (int pass = 0; pass < 8; ++pass) {
        const int row = row_base + pass * 8 + wid, t = row & (SEQ - 1);
        const u32x4 zero = (u32x4){0u, 0u, 0u, 0u};
        const u32x4 p0 = *(const u32x4*)(P + (size_t)row * 512 + c8);
        const u32x4 p1 = (t >= 1) ? *(const u32x4*)(P + (size_t)(row - 1) * 512 + c8) : zero;
        const u32x4 p2 = (t >= 2) ? *(const u32x4*)(P + (size_t)(row - 2) * 512 + c8) : zero;
        const u32x4 cb = *(const u32x4*)(CB + (size_t)row * 512 + c8);
        float o[8];
#pragma unroll
        for (int j = 0; j < 4; ++j) {
            const float a0 = __builtin_bit_cast(float, p0[j] << 16), a1 = __builtin_bit_cast(float, p0[j] & 0xffff0000u);
            const float b0 = __builtin_bit_cast(float, p1[j] << 16), b1 = __builtin_bit_cast(float, p1[j] & 0xffff0000u);
            const float c0 = __builtin_bit_cast(float, p2[j] << 16), c1 = __builtin_bit_cast(float, p2[j] & 0xffff0000u);
            const float g0 = __builtin_bit_cast(float, cb[j] << 16), g1 = __builtin_bit_cast(float, cb[j] & 0xffff0000u);
            const int e0 = 2 * j, e1 = 2 * j + 1;
            o[e0] = g0 * (w[0][e0 >> 2][e0 & 3] * c0 + w[1][e0 >> 2][e0 & 3] * b0 + w[2][e0 >> 2][e0 & 3] * a0);
            o[e1] = g1 * (w[0][e1 >> 2][e1 & 3] * c1 + w[1][e1 >> 2][e1 & 3] * b1 + w[2][e1 >> 2][e1 & 3] * a1);
        }
        u32x4 r; r.x = pk2(o[0], o[1]); r.y = pk2(o[2], o[3]); r.z = pk2(o[4], o[5]); r.w = pk2(o[6], o[7]);
        *(u32x4*)(A2 + (size_t)row * 1024 + 512 + c8) = r;
    }
}
}
namespace att {
typedef short bf16x8 __attribute__((ext_vector_type(8)));
typedef short s16x4 __attribute__((ext_vector_type(4)));
typedef float f32x16 __attribute__((ext_vector_type(16)));
typedef unsigned u32x4 __attribute__((ext_vector_type(4)));
typedef float f32x2_t __attribute__((ext_vector_type(2))); typedef __bf16 bf16x2_t __attribute__((ext_vector_type(2)));
constexpr int NSLOT = 3, SLOTB = 8192, MSLOTB = 2048;
constexpr int LDS_K = 0, LDS_V = NSLOT * SLOTB, LDS_M = 2 * NSLOT * SLOTB, LDS_WS = LDS_M + NSLOT * MSLOTB, LDS_OST = LDS_WS + 8 * 64 * 4, LDS_END = LDS_OST + 8 * 4096;
static_assert(LDS_END <= RING_BYTES, "attention LDS map");
__device__ __forceinline__ int lane_now() { int l; asm volatile("v_mbcnt_lo_u32_b32 %0, -1, 0\n\tv_mbcnt_hi_u32_b32 %0, -1, %0" : "=v"(l)); return l; }
__device__ __forceinline__ int crow(int r, int hi) { return (r & 3) + 8 * (r >> 2) + 4 * hi; }
__device__ __forceinline__ void glds16(const void* gsrc, unsigned lds_dst) { unsigned keep;
    asm volatile("s_mov_b32 %0, m0\n\ts_mov_b32 m0, %2\n\ts_nop 0\n\tglobal_load_lds_dwordx4 %1, off\n\ts_mov_b32 m0, %0" : "=&s"(keep) : "v"(gsrc), "s"(lds_dst) : "memory"); }
__device__ __forceinline__ void glds4(const void* gsrc, unsigned lds_dst) { unsigned keep;
    asm volatile("s_mov_b32 %0, m0\n\ts_mov_b32 m0, %2\n\ts_nop 0\n\tglobal_load_lds_dword %1, off\n\ts_mov_b32 m0, %0" : "=&s"(keep) : "v"(gsrc), "s"(lds_dst) : "memory"); }
__device__ __forceinline__ unsigned cvtpk(float lo, float hi) { f32x2_t v = {lo, hi}; bf16x2_t b = __builtin_convertvector(v, bf16x2_t); return __builtin_bit_cast(unsigned, b); }
#define ATT_WAIT_BAR(N) asm volatile("s_waitcnt vmcnt(" #N ") lgkmcnt(0)\n\ts_barrier" ::: "memory")
#define ATT_SBAR() __builtin_amdgcn_sched_barrier(0)
__device__ __forceinline__ void pv(f32x16* o, int vb, bf16x8 pa0, bf16x8 pa1, bf16x8 pa2, bf16x8 pa3) {
#pragma unroll
    for (int d0 = 0; d0 < 2; ++d0) { s16x4 lo[4], hi[4];
#pragma unroll
        for (int ks = 0; ks < 4; ++ks) {
            asm volatile("ds_read_b64_tr_b16 %0,%1 offset:%c2" : "=&v"(lo[ks]) : "v"(vb), "i"(d0 * 4096 + ks * 1024) : "memory");
            asm volatile("ds_read_b64_tr_b16 %0,%1 offset:%c2" : "=&v"(hi[ks]) : "v"(vb), "i"(d0 * 4096 + ks * 1024 + 512) : "memory"); }
        asm volatile("s_waitcnt lgkmcnt(0)" ::: "memory"); ATT_SBAR();
#define ATT_PK(k) (bf16x8){lo[k][0], lo[k][1], lo[k][2], lo[k][3], hi[k][0], hi[k][1], hi[k][2], hi[k][3]}
        o[d0] = __builtin_amdgcn_mfma_f32_32x32x16_bf16(pa0, ATT_PK(0), o[d0], 0, 0, 0);
        o[d0] = __builtin_amdgcn_mfma_f32_32x32x16_bf16(pa1, ATT_PK(1), o[d0], 0, 0, 0);
        o[d0] = __builtin_amdgcn_mfma_f32_32x32x16_bf16(pa2, ATT_PK(2), o[d0], 0, 0, 0);
        o[d0] = __builtin_amdgcn_mfma_f32_32x32x16_bf16(pa3, ATT_PK(3), o[d0], 0, 0, 0);
#undef ATT_PK
    }
}
__device__ __forceinline__ void attn_unit(const int b, const int h, const int qb, const bf16* __restrict__ Q, const bf16* __restrict__ K, const bf16* __restrict__ V,
                                          const unsigned long long* __restrict__ MASK, bf16* __restrict__ O, LAS unsigned char* shm, const int wid) {
    const int lane = lane_now(), r32 = lane & 31, hi = lane >> 5;
    const size_t rowbase = (size_t)b * SEQ; const int q0 = qb * 256;
    const bf16* Qw = Q + (rowbase + q0 + wid * 32) * 512 + h * 64;
    const bf16* Kh = K + rowbase * 512 + h * 64; const bf16* Vh = V + rowbase * 512 + h * 64;
    const unsigned lds0 = (unsigned)(uintptr_t)shm;
    LAS float* wsf = (LAS float*)(shm + LDS_WS) + wid * 64;
    const bf16* ksrc = Kh + (size_t)lane * 512 + wid * 8;
    const bf16* vsrc = Vh + (size_t)(16 * (wid & 3) + (lane >> 2)) * 512 + (wid >> 2) * 32 + (lane & 3) * 8;
    const unsigned* msrc = (const unsigned*)(MASK + ((size_t)b * 64 * SEQ + q0 + wid * 32)) + lane;
    const unsigned kdst = lds0 + LDS_K + wid * 1024, vdst = lds0 + LDS_V + wid * 1024, mdst = lds0 + LDS_M + wid * 256;
#define ATT_DMA(t, slot) do { glds4(msrc + (size_t)(t) * (SEQ * 2), (unsigned)__builtin_amdgcn_readfirstlane(mdst + (slot) * MSLOTB)); \
        glds16(ksrc + (size_t)(t) * 64 * 512, (unsigned)__builtin_amdgcn_readfirstlane(kdst + (slot) * SLOTB)); \
        glds16(vsrc + (size_t)(t) * 64 * 512, (unsigned)__builtin_amdgcn_readfirstlane(vdst + (slot) * SLOTB)); } while (0)
    const int vb0 = (int)(lds0 + LDS_V) + ((lane >> 4) & 1) * 32 + (lane & 3) * 8 + (4 * hi + ((lane & 15) >> 2)) * 64;
    const int NT = (q0 + 256) / 64;
    bf16x8 qr[4];
#pragma unroll
    for (int d0 = 0; d0 < 4; ++d0) qr[d0] = *(const bf16x8*)(Qw + (size_t)r32 * 512 + d0 * 16 + hi * 8);
    asm volatile("s_waitcnt vmcnt(0)" : "+v"(qr[0]), "+v"(qr[1]), "+v"(qr[2]), "+v"(qr[3]) :: "memory");
    ATT_DMA(0, 0); ATT_DMA(1, 1);
    float m_run = -1e30f, l_run = 0.f; f32x16 o[2]; o[0] = f32x16{}; o[1] = f32x16{};
    int slot = 0;
#pragma unroll 1
    for (int t = 0; t < NT; ++t) {
        if (t + 1 < NT) ATT_WAIT_BAR(3); else ATT_WAIT_BAR(0);
        if (t + 2 < NT) { const int s2 = (slot == 0) ? 2 : slot - 1; ATT_DMA(t + 2, s2); }
        f32x16 p0, p1;
        { const LAS unsigned char* kb = shm + LDS_K + slot * SLOTB + hi * 1024 + r32 * 16;
#pragma unroll
          for (int d0 = 0; d0 < 4; ++d0) {
              const bf16x8 b0 = *(const LAS bf16x8*)(kb + d0 * 2048), b1 = *(const LAS bf16x8*)(kb + d0 * 2048 + 512);
              if (d0 == 0) { p0 = __builtin_amdgcn_mfma_f32_32x32x16_bf16(b0, qr[0], f32x16{}, 0, 0, 0); p1 = __builtin_amdgcn_mfma_f32_32x32x16_bf16(b1, qr[0], f32x16{}, 0, 0, 0); }
              else { p0 = __builtin_amdgcn_mfma_f32_32x32x16_bf16(b0, qr[d0], p0, 0, 0, 0); p1 = __builtin_amdgcn_mfma_f32_32x32x16_bf16(b1, qr[d0], p1, 0, 0, 0); } } }
        const unsigned long long mw = *(const LAS unsigned long long*)(shm + LDS_M + slot * MSLOTB + wid * 256 + r32 * 8);
        const unsigned mlo = (unsigned)mw >> (4 * hi), mhi = (unsigned)(mw >> 32) >> (4 * hi);
#pragma unroll
        for (int r = 0; r < 16; ++r) { const int pos = (r & 3) + 8 * (r >> 2);
            p0[r] = ((mlo >> pos) & 1u) ? p0[r] : -INFINITY; p1[r] = ((mhi >> pos) & 1u) ? p1[r] : -INFINITY; }
        float rm = fmaxf(p0[0], p1[0]);
#pragma unroll
        for (int r = 1; r < 16; ++r) rm = fmaxf(rm, fmaxf(p0[r], p1[r]));
        { auto rr = __builtin_amdgcn_permlane32_swap(__float_as_uint(rm), __float_as_uint(rm), false, false); rm = fmaxf(__uint_as_float(rr[0]), __uint_as_float(rr[1])); }
        const float m_new = fmaxf(m_run, rm);
        const float alpha = __builtin_amdgcn_exp2f(m_run - m_new);
        m_run = m_new;
        float sacc = 0.f;
#pragma unroll
        for (int r = 0; r < 16; ++r) { p0[r] = __builtin_amdgcn_exp2f(p0[r] - m_new); p1[r] = __builtin_amdgcn_exp2f(p1[r] - m_new); sacc += p0[r] + p1[r]; }
        l_run = l_run * alpha + sacc;
        if (!__all(alpha == 1.0f)) {
            if (hi == 0) wsf[r32] = alpha;
            asm volatile("s_waitcnt lgkmcnt(0)" ::: "memory");
#pragma unroll
            for (int r = 0; r < 16; ++r) { const float a = wsf[crow(r, hi)]; o[0][r] *= a; o[1][r] *= a; }
        }
        u32x4 pw0, pw1, pw2, pw3;
        pw0 = (u32x4){cvtpk(p0[0], p0[1]), cvtpk(p0[2], p0[3]), cvtpk(p0[4], p0[5]), cvtpk(p0[6], p0[7])};
        pw1 = (u32x4){cvtpk(p0[8], p0[9]), cvtpk(p0[10], p0[11]), cvtpk(p0[12], p0[13]), cvtpk(p0[14], p0[15])};
        pw2 = (u32x4){cvtpk(p1[0], p1[1]), cvtpk(p1[2], p1[3]), cvtpk(p1[4], p1[5]), cvtpk(p1[6], p1[7])};
        pw3 = (u32x4){cvtpk(p1[8], p1[9]), cvtpk(p1[10], p1[11]), cvtpk(p1[12], p1[13]), cvtpk(p1[14], p1[15])};
        ATT_SBAR();
        pv(o, vb0 + slot * SLOTB, __builtin_bit_cast(bf16x8, pw0), __builtin_bit_cast(bf16x8, pw1), __builtin_bit_cast(bf16x8, pw2), __builtin_bit_cast(bf16x8, pw3));
        slot = (slot == NSLOT - 1) ? 0 : slot + 1;
    }
    { auto rr = __builtin_amdgcn_permlane32_swap(__float_as_uint(l_run), __float_as_uint(l_run), false, false); l_run = __uint_as_float(rr[0]) + __uint_as_float(rr[1]); }
    if (hi == 0) wsf[32 + r32] = l_run;
    asm volatile("s_waitcnt lgkmcnt(0)" ::: "memory");
    float rli[16];
#pragma unroll
    for (int r = 0; r < 16; ++r) rli[r] = 1.0f / wsf[32 + crow(r, hi)];
    bf16* Ow = O + (rowbase + q0 + wid * 32) * 1024 + h * 64;
    { LAS bf16* stg = (LAS bf16*)(shm + LDS_OST) + wid * 2048;
#pragma unroll
      for (int r = 0; r < 16; ++r) { const int orow = crow(r, hi);
#pragma unroll
          for (int d0 = 0; d0 < 2; ++d0) stg[orow * 64 + d0 * 32 + r32] = (bf16)f2bf(o[d0][r] * rli[r]); }
      asm volatile("s_waitcnt lgkmcnt(0)" ::: "memory");
#pragma unroll
      for (int i = 0; i < 4; ++i) { const int row = i * 8 + (lane >> 3), ch = lane & 7; const u32x4 v = *(const LAS u32x4*)(stg + row * 64 + ch * 8); *(u32x4*)(Ow + (size_t)row * 1024 + ch * 8) = v; } }
    asm volatile("s_waitcnt vmcnt(0) lgkmcnt(0)\n\ts_barrier" ::: "memory");
#undef ATT_DMA
}
#undef ATT_WAIT_BAR
#undef ATT_SBAR
}
struct Args { const float* in[11]; float* out; unsigned char* ws; int ph_lo, ph_hi, layer, pad; };

__device__ __forceinline__ void p0_prologue(const Args& a, LAS unsigned char* lds, int wave, int lane, int vcu, int G) {
    unsigned char* ws = a.ws;
    LAS float* scr = (LAS float*)(lds + RING_OFF + wave * 16384);
    const int gw = vcu * NWAVES + wave, NGW = G * NWAVES;
    constexpr int I_IN = 16 * (NPALL / 32), I_AO = 8 * 32, I_CO = 8 * 32, I_MX = 16 * 32, I_UP = 16 * 128, I_DN = 64 * 32;
    constexpr int I_LAYER = I_IN + I_AO + I_CO + I_MX + I_UP + I_DN;
    for (int it = gw; it < DEPTH * I_LAYER; it += NGW) {
        const int l = it / I_LAYER; int r = it % I_LAYER;
        if (r < I_IN) { const int nb = r % (NPALL / 32), kb = r / (NPALL / 32);
            transpose_item<true>(a.in[2] + (size_t)l * D_MODEL * IN_COLS, IN_COLS, (bf16*)(ws + WS_WIN) + (size_t)l * NPALL * 1024, 1024, 0, kb * 64, nb * 32, scr, lane); continue; } r -= I_IN;
        if (r < I_AO) { const int nb = r % 32, kb = r / 32;
            transpose_item<false>(a.in[4] + (size_t)l * 512 * 1024, 1024, (bf16*)(ws + WS_WOC) + (size_t)l * 1024 * 1024, 1024, 0, kb * 64, nb * 32, scr, lane); continue; } r -= I_AO;
        if (r < I_CO) { const int nb = r % 32, kb = r / 32;
            transpose_item<false>(a.in[5] + (size_t)l * 512 * 1024, 1024, (bf16*)(ws + WS_WOC) + (size_t)l * 1024 * 1024, 1024, 512, kb * 64, nb * 32, scr, lane); continue; } r -= I_CO;
        if (r < I_MX) { const int nb = r % 32, kb = r / 32;
            transpose_item<false>(a.in[6] + (size_t)l * 1024 * 1024, 1024, (bf16*)(ws + WS_WMIX) + (size_t)l * 1024 * 1024, 1024, 0, kb * 64, nb * 32, scr, lane); continue; } r -= I_MX;
        if (r < I_UP) { const int nb = r % 128, kb = r / 128;
            transpose_item<false>(a.in[8] + (size_t)l * 1024 * 4096, 4096, (bf16*)(ws + WS_WUP) + (size_t)l * 4096 * 1024, 1024, 0, kb * 64, nb * 32, scr, lane); continue; } r -= I_UP;
        { const int nb = r % 32, kb = r / 32;
            transpose_item<false>(a.in[9] + (size_t)l * 4096 * 1024, 1024, (bf16*)(ws + WS_WDN) + (size_t)l * 1024 * 4096, 4096, 0, kb * 64, nb * 32, scr, lane); }
    }
    float* cs = (float*)(ws + WS_CS);
    for (int i = gw * 64 + lane; i < SEQ * 8; i += NGW * 64) { const int t = i >> 3, j = i & 7; float s, c; sincos_acc((float)t * rope_inv(j), s, c); cs[i] = c; cs[SEQ * 8 + i] = s; }
    for (int m = gw; m < MROWS; m += NGW) xg_row(a.in[0] + (size_t)m * D_MODEL, a.in[1], (bf16*)(ws + WS_XG) + (size_t)m * D_MODEL, (float*)(ws + WS_ROWSQ), m, lane);
}

__global__ void __launch_bounds__(NWAVES * 64, 2) mk_fwd(Args args) {
    extern __shared__ __attribute__((aligned(16))) unsigned char lds_raw[];
    LAS unsigned char* lds = (LAS unsigned char*)lds_raw;
    const int wave = __builtin_amdgcn_readfirstlane(threadIdx.x >> 6);
#define lane (pg8::lane_now())
    const int G = gridDim.x; const int bx = blockIdx.x; const int vcu = (G % 8 == 0) ? (bx % 8) * (G / 8) + bx / 8 : bx;
    unsigned char* ws = args.ws;
    const int lo = args.ph_lo, hi = args.ph_hi, L = args.layer;
#define IN(k) (lo <= (k) && (k) < hi)
    if (IN(0)) { p0_prologue(args, lds, wave, lane, vcu, G); }
    if (IN(1)) {
        pg8::Gemm g{(const bf16*)(ws + WS_XG), (const bf16*)(ws + WS_WIN) + (size_t)L * NPALL * 1024, MROWS, NP1, D_MODEL};
        pg8::StaticOrder S; S.init(MROWS, NP1, G, (int)blockIdx.x);
        pg8::EpiProj E{(const float*)(ws + WS_ROWSQ), (const float*)(ws + WS_CS), (bf16*)(ws + WS_Q), (bf16*)(ws + WS_K), (bf16*)(ws + WS_V), (bf16*)(ws + WS_IQ), (bf16*)(ws + WS_IK),
                       (bf16*)(ws + WS_CB), (bf16*)(ws + WS_P), (float*)(ws + WS_IW)};
        pg8::gemm_phase<pg8::EpiProj, pg8::StaticOrder, true, true>(lds + RING_OFF, g, S, E, wave);
    }
    if (IN(2)) {
        for (int id = vcu; id < 512; id += G) { const int b = id >> 7, p = id & 127;
            sel::sel_unit(lds, b, 255 - p, (const bf16*)(ws + WS_IQ), (const bf16*)(ws + WS_IK), (const float*)(ws + WS_IW), (unsigned long long*)(ws + WS_MASK), wave);
            sel::sel_unit(lds, b, p, (const bf16*)(ws + WS_IQ), (const bf16*)(ws + WS_IK), (const float*)(ws + WS_IW), (unsigned long long*)(ws + WS_MASK), wave); }
        for (int rb = vcu * 64; rb < MROWS; rb += G * 64)
            sel::convmid_rows((const bf16*)(ws + WS_CB), (const bf16*)(ws + WS_P), args.in[3] + (size_t)L * 3 * 512, (bf16*)(ws + WS_A2), rb, wave);
    }
    if (IN(3)) {
        for (int u = vcu; u < 512; u += G) { const int bh = (u & 255) >> 3, s = u & 7, qb = (u >> 8) ? s : 15 - s;
            att::attn_unit(bh >> 3, bh & 7, qb, (const bf16*)(ws + WS_Q), (const bf16*)(ws + WS_K), (const bf16*)(ws + WS_V), (const unsigned long long*)(ws + WS_MASK), (bf16*)(ws + WS_A2), lds, wave); }
    }
    if (IN(4)) {
        pg8::Gemm g{(const bf16*)(ws + WS_XG), (const bf16*)(ws + WS_WIN) + (size_t)L * NPALL * 1024 + (size_t)NP1 * 1024, MROWS, NPG, D_MODEL};
        pg8::StaticOrder S; S.init(MROWS, NPG, G, (int)blockIdx.x);
        pg8::EpiSig E{(const float*)(ws + WS_ROWSQ), (bf16*)(ws + WS_SG)};
        pg8::gemm_phase<pg8::EpiSig, pg8::StaticOrder, true, true>(lds + RING_OFF, g, S, E, wave);
    }
    if (IN(5)) {
        pg8::Gemm g{(const bf16*)(ws + WS_A2), (const bf16*)(ws + WS_WOC) + (size_t)L * 1024 * 1024, MROWS, D_MODEL, 1024};
        pg8::StaticOrder S; S.init(MROWS, D_MODEL, G, (int)blockIdx.x);
        pg8::EpiMerged E{(const bf16*)(ws + WS_SG), (bf16*)(ws + WS_MERGED)};
        pg8::gemm_phase<pg8::EpiMerged, pg8::StaticOrder, true, true>(lds + RING_OFF, g, S, E, wave);
    }
    if (IN(6)) {
        pg8::Gemm g{(const bf16*)(ws + WS_MERGED), (const bf16*)(ws + WS_WMIX) + (size_t)L * 1024 * 1024, MROWS, D_MODEL, 1024};
        pg8::StaticOrder S; S.init(MROWS, D_MODEL, G, (int)blockIdx.x);
        pg8::EpiResid E{L == 0 ? args.in[0] : args.out, args.out, (bf16*)(ws + WS_XG), args.in[7] + L * D_MODEL, (float*)(ws + WS_ROWSQ)};
        pg8::gemm_phase<pg8::EpiResid, pg8::StaticOrder, false, true>(lds + RING_OFF, g, S, E, wave);
    }
    if (IN(7)) {
        pg8::Gemm g{(const bf16*)(ws + WS_XG), (const bf16*)(ws + WS_WUP) + (size_t)L * 4096 * 1024, MROWS, MLP_H, D_MODEL};
        pg8::StaticOrder S; S.init(MROWS, MLP_H, G, (int)blockIdx.x);
        pg8::EpiRelu2 E{(const float*)(ws + WS_ROWSQ), (bf16*)(ws + WS_H)};
        pg8::gemm_phase<pg8::EpiRelu2, pg8::StaticOrder, true, true>(lds + RING_OFF, g, S, E, wave);
    }
    if (IN(8)) {
        pg8::Gemm g{(const bf16*)(ws + WS_H), (const bf16*)(ws + WS_WDN) + (size_t)L * 1024 * 4096, MROWS, D_MODEL, MLP_H};
        pg8::StaticOrder S; S.init(MROWS, D_MODEL, G, (int)blockIdx.x);
        pg8::EpiResid E{args.out, args.out, (bf16*)(ws + WS_XG), (L + 1 < DEPTH) ? args.in[1] + (L + 1) * D_MODEL : (const float*)nullptr, (float*)(ws + WS_ROWSQ)};
        pg8::gemm_phase<pg8::EpiResid, pg8::StaticOrder, false, true>(lds + RING_OFF, g, S, E, wave);
    }
    if (IN(9)) {
        const float* rowsq = (const float*)(ws + WS_ROWSQ); const float* gf = args.in[10];
        const int gw = vcu * NWAVES + wave, NGW = G * NWAVES;
        for (int m = gw; m < MROWS; m += NGW) {
            const float rs = pg8::row_rstd(rowsq, m);
            GAS f32x4* xr = (GAS f32x4*)(args.out + (size_t)m * D_MODEL) + lane; const GAS f32x4* gr = (const GAS f32x4*)gf + lane;
#pragma unroll
            for (int j = 0; j < 4; ++j) { const f32x4 v = xr[64 * j], gg = gr[64 * j]; xr[64 * j] = v * rs * gg; }
        }
    }
#undef IN
#undef lane
}
__device__ __forceinline__ float n_wave_sum_f(float v) {
#pragma unroll
    for (int o = 32; o >= 1; o >>= 1) v += __shfl_xor(v, o);
    return v; }
__device__ __forceinline__ float n_wave_max_f(float v) {
#pragma unroll
    for (int o = 32; o >= 1; o >>= 1) v = fmaxf(v, __shfl_xor(v, o));
    return v; }
__device__ __forceinline__ int n_wave_sum_i(int v) {
#pragma unroll
    for (int o = 32; o >= 1; o >>= 1) v += __shfl_xor(v, o);
    return v; }
__device__ __forceinline__ float n_block_sum_f(float v, float* red) { v = n_wave_sum_f(v); __syncthreads(); if ((threadIdx.x & 63) == 0) red[threadIdx.x >> 6] = v; __syncthreads(); return (red[0] + red[1]) + (red[2] + red[3]); }
__device__ __forceinline__ float n_block_max_f(float v, float* red) { v = n_wave_max_f(v); __syncthreads(); if ((threadIdx.x & 63) == 0) red[threadIdx.x >> 6] = v; __syncthreads(); return fmaxf(fmaxf(red[0], red[1]), fmaxf(red[2], red[3])); }
__device__ __forceinline__ int n_block_sum_i(int v, int* red) { v = n_wave_sum_i(v); __syncthreads(); if ((threadIdx.x & 63) == 0) red[threadIdx.x >> 6] = v; __syncthreads(); return (red[0] + red[1]) + (red[2] + red[3]); }

__global__ __launch_bounds__(256) void n_rmsnorm_k(const float* x, const float* __restrict__ g, float* y) {
    __shared__ float red[4];
    const int row = blockIdx.x, tid = threadIdx.x;
    const float4 v = ((const float4*)(x + (size_t)row * D_MODEL))[tid];
    float s = (v.x * v.x + v.y * v.y) + (v.z * v.z + v.w * v.w);
    s = n_block_sum_f(s, red);
    const float r = 1.0f / sqrtf(s * (1.0f / D_MODEL) + 1e-6f);
    const float4 gg = ((const float4*)g)[tid];
    float4 o; o.x = v.x * r * gg.x; o.y = v.y * r * gg.y; o.z = v.z * r * gg.z; o.w = v.w * r * gg.w;
    ((float4*)(y + (size_t)row * D_MODEL))[tid] = o;
}
__global__ __launch_bounds__(64) void n_xg_k(const float* x, const float* g, bf16* xg, float* rowsq) {
    xg_row(x + (size_t)blockIdx.x * D_MODEL, g, xg + (size_t)blockIdx.x * D_MODEL, rowsq, blockIdx.x, threadIdx.x);
}
__device__ __forceinline__ float4 ld4(const float* p) { return *(const float4*)p; }
__device__ __forceinline__ float4 ld4(const bf16* p) { const uint2 u = *(const uint2*)p; float4 r; r.x = bf2f(u.x & 0xffff); r.y = bf2f(u.x >> 16); r.z = bf2f(u.y & 0xffff); r.w = bf2f(u.y >> 16); return r; }
template <int EPI, typename TA>
__global__ __launch_bounds__(256) void n_gemm(const TA* __restrict__ A, int lda, const float* __restrict__ B, int ldb, float* C, int ldc, int M, int N, int K) {
    __shared__ float As[16][68];
    __shared__ float Bs[16][68];
    const int tid = threadIdx.x, tx = tid & 15, ty = tid >> 4;
    const int m0 = blockIdx.y * 64, n0 = blockIdx.x * 64;
    float acc[4][4];
#pragma unroll
    for (int i = 0; i < 4; ++i)
#pragma unroll
        for (int j = 0; j < 4; ++j) acc[i][j] = 0.f;
    const int ar = tid >> 2, ak = (tid & 3) * 4, bk = tid >> 4, bn = (tid & 15) * 4;
    const bool bok = (n0 + bn) < N;
    for (int k0 = 0; k0 < K; k0 += 16) {
        const float4 a = ld4(A + (size_t)(m0 + ar) * lda + k0 + ak);
        float4 b = make_float4(0.f, 0.f, 0.f, 0.f);
        if (bok) b = *(const float4*)(B + (size_t)(k0 + bk) * ldb + n0 + bn);
        __syncthreads();
        As[ak + 0][ar] = a.x; As[ak + 1][ar] = a.y; As[ak + 2][ar] = a.z; As[ak + 3][ar] = a.w;
        *(float4*)&Bs[bk][bn] = b;
        __syncthreads();
#pragma unroll
        for (int kk = 0; kk < 16; ++kk) {
            const float4 av = *(const float4*)&As[kk][ty * 4];
            const float4 bv = *(const float4*)&Bs[kk][tx * 4];
            const float aa[4] = {av.x, av.y, av.z, av.w};
            const float bb[4] = {bv.x, bv.y, bv.z, bv.w};
#pragma unroll
            for (int i = 0; i < 4; ++i)
#pragma unroll
                for (int j = 0; j < 4; ++j) acc[i][j] = fmaf(aa[i], bb[j], acc[i][j]);
        }
    }
    const int col = n0 + tx * 4;
    if (col < N) {
#pragma unroll
        for (int i = 0; i < 4; ++i) {
            float* cp = C + (size_t)(m0 + ty * 4 + i) * ldc + col;
            float4 o;
            if (EPI == 0) { o.x = acc[i][0]; o.y = acc[i][1]; o.z = acc[i][2]; o.w = acc[i][3]; }
            if (EPI == 1) { const float4 c = *(const float4*)cp; o.x = c.x + acc[i][0]; o.y = c.y + acc[i][1]; o.z = c.z + acc[i][2]; o.w = c.w + acc[i][3]; }
            if (EPI == 2) { float r0 = fmaxf(acc[i][0], 0.f), r1 = fmaxf(acc[i][1], 0.f), r2 = fmaxf(acc[i][2], 0.f), r3 = fmaxf(acc[i][3], 0.f); o.x = r0 * r0; o.y = r1 * r1; o.z = r2 * r2; o.w = r3 * r3; }
            *(float4*)cp = o;
        }
    }
}
__global__ __launch_bounds__(256) void n_dsa_k(const bf16* __restrict__ Q, const bf16* __restrict__ Kt, const bf16* __restrict__ V, const bf16* __restrict__ IQ, const bf16* __restrict__ IK, const float* __restrict__ IW, bf16* __restrict__ A2) {
    __shared__ unsigned keys[4096];
    __shared__ float qs[512];
    __shared__ float iqs[256];
    __shared__ int sel[256];
    __shared__ float pw[256];
    __shared__ float red4[4][64];
    __shared__ float redf[4];
    __shared__ int redi[4];
    __shared__ int scan[256];
    const int row = blockIdx.x, tid = threadIdx.x, t = row & (SEQ - 1);
    const size_t b0 = (size_t)(row - t);
    const int N = ((t >> 6) + 1) << 6;
    iqs[tid] = bf2f(IQ[(size_t)row * 256 + tid]);
    qs[tid] = bf2f(Q[(size_t)row * 512 + tid]); qs[256 + tid] = bf2f(Q[(size_t)row * 512 + 256 + tid]);
    const float w0 = IW[(size_t)row * 4], w1 = IW[(size_t)row * 4 + 1], w2 = IW[(size_t)row * 4 + 2], w3 = IW[(size_t)row * 4 + 3];
    __syncthreads();
    for (int s = tid; s < N; s += 256) {
        const bf16* ik = IK + (b0 + s) * 64;
        float d0 = 0.f, d1 = 0.f, d2 = 0.f, d3 = 0.f;
#pragma unroll 4
        for (int d = 0; d < 16; ++d) {
            const float4 kv = ld4(ik + 4 * d);
            d0 = fmaf(iqs[4 * d], kv.x, d0); d0 = fmaf(iqs[4 * d + 1], kv.y, d0); d0 = fmaf(iqs[4 * d + 2], kv.z, d0); d0 = fmaf(iqs[4 * d + 3], kv.w, d0);
            d1 = fmaf(iqs[64 + 4 * d], kv.x, d1); d1 = fmaf(iqs[64 + 4 * d + 1], kv.y, d1); d1 = fmaf(iqs[64 + 4 * d + 2], kv.z, d1); d1 = fmaf(iqs[64 + 4 * d + 3], kv.w, d1);
            d2 = fmaf(iqs[128 + 4 * d], kv.x, d2); d2 = fmaf(iqs[128 + 4 * d + 1], kv.y, d2); d2 = fmaf(iqs[128 + 4 * d + 2], kv.z, d2); d2 = fmaf(iqs[128 + 4 * d + 3], kv.w, d2);
            d3 = fmaf(iqs[192 + 4 * d], kv.x, d3); d3 = fmaf(iqs[192 + 4 * d + 1], kv.y, d3); d3 = fmaf(iqs[192 + 4 * d + 2], kv.z, d3); d3 = fmaf(iqs[192 + 4 * d + 3], kv.w, d3);
        }
        float sc = 0.f;
        sc += fmaxf(d0, 0.f) * w0; sc += fmaxf(d1, 0.f) * w1; sc += fmaxf(d2, 0.f) * w2; sc += fmaxf(d3, 0.f) * w3;
        const unsigned b = __float_as_uint(sc);
        keys[s] = (b & 0x80000000u) ? ~b : (b | 0x80000000u);
    }
    __syncthreads();
    int nsel;
    if (N <= 256) { nsel = N; if (tid < N) sel[tid] = tid; }
    else {
        nsel = 256;
        unsigned T = 0u;
        for (int bit = 31; bit >= 0; --bit) {
            const unsigned cand = T | (1u << bit);
            int c = 0;
            for (int s = tid; s < N; s += 256) c += (keys[s] >= cand) ? 1 : 0;
            c = n_block_sum_i(c, redi);
            if (c >= 256) T = cand;
        }
        const int base = tid * 16;
        int ng = 0, nt = 0;
#pragma unroll
        for (int i = 0; i < 16; ++i) { const int s = base + i; if (s < N) { const unsigned k = keys[s]; ng += (k > T) ? 1 : 0; nt += (k == T) ? 1 : 0; } }
        const int cg = n_block_sum_i(ng, redi);
        const int r = 256 - cg;
        int v = ng | (nt << 16);
        __syncthreads();
        scan[tid] = v;
        __syncthreads();
        for (int o = 1; o < 256; o <<= 1) { const int add = (tid >= o) ? scan[tid - o] : 0; __syncthreads(); scan[tid] += add; __syncthreads(); }
        const int ex = scan[tid] - v;
        int pg = ex & 0xffff, pt = ex >> 16;
#pragma unroll
        for (int i = 0; i < 16; ++i) { const int s = base + i;
            if (s < N) { const unsigned k = keys[s]; if (k > T) { sel[pg] = s; ++pg; } else if (k == T) { if (pt < r) sel[cg + pt] = s; ++pt; } } }
    }
    __syncthreads();
    for (int h = 0; h < 8; ++h) {
        float sl = -INFINITY;
        if (tid < nsel) {
            const bf16* kr = Kt + (b0 + sel[tid]) * 512 + h * 64;
            float d = 0.f;
#pragma unroll 4
            for (int i = 0; i < 16; ++i) { const float4 kv = ld4(kr + 4 * i); d = fmaf(qs[h * 64 + 4 * i], kv.x, d); d = fmaf(qs[h * 64 + 4 * i + 1], kv.y, d); d = fmaf(qs[h * 64 + 4 * i + 2], kv.z, d); d = fmaf(qs[h * 64 + 4 * i + 3], kv.w, d); }
            sl = d;
        }
        const float mx = n_block_max_f(sl, redf);
        const float e = (tid < nsel) ? exp2f(sl - mx) : 0.f;
        const float sum = n_block_sum_f(e, redf);
        pw[tid] = e / sum;
        __syncthreads();
        const int d = tid & 63, part = tid >> 6;
        float acc = 0.f;
        for (int j = part; j < nsel; j += 4) acc = fmaf(pw[j], bf2f(V[(b0 + sel[j]) * 512 + h * 64 + d]), acc);
        red4[part][d] = acc;
        __syncthreads();
        if (tid < 64) A2[(size_t)row * 1024 + h * 64 + tid] = (bf16)f2bf((red4[0][tid] + red4[1][tid]) + (red4[2][tid] + red4[3][tid]));
        __syncthreads();
    }
}
__global__ __launch_bounds__(256) void n_attm_k(const bf16* __restrict__ Q, const bf16* __restrict__ Kt, const bf16* __restrict__ V, const unsigned long long* __restrict__ MASK, bf16* __restrict__ A2) {
    __shared__ float qs[512];
    __shared__ int sel[512];
    __shared__ float pw[256];
    __shared__ float red4[4][64];
    __shared__ float redf[4];
    __shared__ int scan[256];
    const int row = blockIdx.x, tid = threadIdx.x, t = row & (SEQ - 1), b = row >> 12;
    const size_t b0 = (size_t)(row - t);
    const int N = ((t >> 6) + 1) << 6;
    qs[tid] = bf2f(Q[(size_t)row * 512 + tid]); qs[256 + tid] = bf2f(Q[(size_t)row * 512 + 256 + tid]);
    const int tile = tid >> 2, sh = (tid & 3) * 16;
    const unsigned long long mw = MASK[((size_t)(b * 64 + tile)) * SEQ + t];
    const unsigned bits = (unsigned)(mw >> sh) & 0xffffu;
    const int v = __popc(bits);
    __syncthreads();
    scan[tid] = v;
    __syncthreads();
    for (int o = 1; o < 256; o <<= 1) { const int add = (tid >= o) ? scan[tid - o] : 0; __syncthreads(); scan[tid] += add; __syncthreads(); }
    const int total = scan[255];
    int pos = scan[tid] - v;
    for (int i = 0; i < 16; ++i) if ((bits >> i) & 1u) { if (pos < 512) sel[pos] = tid * 16 + i; ++pos; }
    __syncthreads();
    const int want = N < 256 ? N : 256;
    bool bad = (total != want);
    const int nsel = total < 256 ? total : 256;
    if (tid < nsel && sel[tid] >= N) bad = true;
    bad = __syncthreads_or(bad);
    for (int h = 0; h < 8; ++h) {
        float sl = -INFINITY;
        if (tid < nsel) {
            const bf16* kr = Kt + (b0 + sel[tid]) * 512 + h * 64;
            float d = 0.f;
#pragma unroll 4
            for (int i = 0; i < 16; ++i) { const float4 kv = ld4(kr + 4 * i); d = fmaf(qs[h * 64 + 4 * i], kv.x, d); d = fmaf(qs[h * 64 + 4 * i + 1], kv.y, d); d = fmaf(qs[h * 64 + 4 * i + 2], kv.z, d); d = fmaf(qs[h * 64 + 4 * i + 3], kv.w, d); }
            sl = d;
        }
        const float mx = n_block_max_f(sl, redf);
        const float e = (tid < nsel) ? exp2f(sl - mx) : 0.f;
        const float sum = n_block_sum_f(e, redf);
        pw[tid] = e / sum;
        __syncthreads();
        const int d = tid & 63, part = tid >> 6;
        float acc = 0.f;
        for (int j = part; j < nsel; j += 4) acc = fmaf(pw[j], bf2f(V[(b0 + sel[j]) * 512 + h * 64 + d]), acc);
        red4[part][d] = acc;
        __syncthreads();
        if (tid < 64) A2[(size_t)row * 1024 + h * 64 + tid] = bad ? (bf16)0x7fc0 : (bf16)f2bf((red4[0][tid] + red4[1][tid]) + (red4[2][tid] + red4[3][tid]));
        __syncthreads();
    }
}
__global__ __launch_bounds__(256) void n_conv_k(const bf16* __restrict__ CB, const bf16* __restrict__ P, const float* __restrict__ cw, bf16* __restrict__ A2) {
    const int idx = blockIdx.x * 256 + threadIdx.x;
    const int row = idx >> 9, c = idx & 511, t = row & (SEQ - 1);
    const float p0 = bf2f(P[(size_t)row * 512 + c]);
    const float p1 = (t >= 1) ? bf2f(P[(size_t)(row - 1) * 512 + c]) : 0.f;
    const float p2 = (t >= 2) ? bf2f(P[(size_t)(row - 2) * 512 + c]) : 0.f;
    const float o = cw[c] * p2 + cw[512 + c] * p1 + cw[1024 + c] * p0;
    A2[(size_t)row * 1024 + 512 + c] = (bf16)f2bf(bf2f(CB[(size_t)row * 512 + c]) * o);
}
__global__ __launch_bounds__(256) void n_merge_k(const bf16* __restrict__ SG, float* ya, const float* __restrict__ yc) {
    const int idx = blockIdx.x * 256 + threadIdx.x;
    const int r = idx >> 10, n = idx & 1023;
    ya[idx] = ya[idx] * bf2f(SG[(size_t)r * NPG + n]) + yc[idx] * bf2f(SG[(size_t)r * NPG + 1024 + n]);
}

extern "C" void kernel_launch(void* const* d_in, const int* in_sizes, int n_in, void* d_out, int out_size, void* d_ws, size_t ws_size, hipStream_t stream) {
    static int grid = 0;
    if (grid == 0) {
        int dev = 0, cus = 0, per_cu = 0;
        if (n_in != 11 || out_size != MROWS * D_MODEL || ws_size < WS_END) { fprintf(stderr, "kernel_launch: unexpected problem shape / workspace (%d inputs, out %d, ws %zu)\n", n_in, out_size, ws_size); grid = -1; return; }
        hipGetDevice(&dev); hipDeviceGetAttribute(&cus, hipDeviceAttributeMultiprocessorCount, dev);
        if (hipFuncSetAttribute((const void*)mk_fwd, hipFuncAttributeMaxDynamicSharedMemorySize, LDS_BYTES) != hipSuccess) { fprintf(stderr, "kernel_launch: hipFuncSetAttribute failed\n"); grid = -1; return; }
        if (hipOccupancyMaxActiveBlocksPerMultiprocessor(&per_cu, (const void*)mk_fwd, NWAVES * 64, LDS_BYTES) != hipSuccess || per_cu < 1) { fprintf(stderr, "kernel_launch: occupancy query says %d blocks per CU\n", per_cu); per_cu = 1; }
        (void)hipGetLastError();
        grid = cus;
    }
    if (grid < 0) return;
    const float* x_in = (const float*)d_in[0];
    float* x = (float*)d_out;
    unsigned char* ws = (unsigned char*)d_ws;
    Args a{};
    for (int i = 0; i < 11; ++i) a.in[i] = (const float*)d_in[i];
    a.out = x; a.ws = ws;
    bf16 *Q = (bf16*)(ws + WS_Q), *K = (bf16*)(ws + WS_K), *V = (bf16*)(ws + WS_V), *IQ = (bf16*)(ws + WS_IQ), *IK = (bf16*)(ws + WS_IK), *CB = (bf16*)(ws + WS_CB), *P = (bf16*)(ws + WS_P), *A2 = (bf16*)(ws + WS_A2), *SG = (bf16*)(ws + WS_SG);
    float* IW = (float*)(ws + WS_IW);
#define MK(P0, P1, LL) do { a.ph_lo = (P0); a.ph_hi = (P1); a.layer = (LL); hipLaunchKernelGGL(mk_fwd, dim3(grid), dim3(NWAVES * 64), LDS_BYTES, stream, a); } while (0)
    MK(0, 1, 0);
    for (int l = 0; l < DEPTH; ++l) {
        MK(1, 2, l);
        MK(2, 3, l);
        MK(3, 4, l);
        MK(4, 5, l); MK(5, 6, l); MK(6, 7, l); MK(7, 8, l); MK(8, 9, l);
    }
    MK(9, 10, 0);
}
```

```cpp
#include <hip/hip_runtime.h>
#include <stdint.h>
#include <math.h>
#include <cstdio>

#define D_MODEL 1024
#define BATCH 4
#define SEQ 4096
#define MROWS 16384
#define DEPTH 2
#define IN_COLS 5444
#define MLP_H 4096
#define OFF_Q 0
#define OFF_K 512
#define OFF_V 1024
#define OFF_IQ 1536
#define OFF_IK 1792
#define OFF_IW 1856
#define OFF_CB 1860
#define OFF_CC 2372
#define OFF_CH 2884
#define OFF_G 3396
#define NP1 3584
#define NPG 2048
#define NPALL 5632
#define C2F 0.18033688011112042f

typedef unsigned short bf16;
#define LAS __attribute__((address_space(3)))
#define GAS __attribute__((address_space(1)))
__device__ __forceinline__ unsigned f2bf(float f) { unsigned u = __builtin_bit_cast(unsigned, f); return (u + 0x7fffu + ((u >> 16) & 1u)) >> 16; }
__device__ __forceinline__ unsigned pk2(float lo, float hi) { return f2bf(lo) | (f2bf(hi) << 16); }
__device__ __forceinline__ float bf2f(unsigned short b) { return __builtin_bit_cast(float, ((unsigned)b) << 16); }

constexpr size_t MiB = 1u << 20;
constexpr size_t WS_CTL = 0, CTL_ZERO_BYTES = 1 * MiB;
constexpr size_t WS_CS = 1 * MiB;
constexpr size_t WS_ROWSQ = 1 * MiB + 512 * 1024;
constexpr size_t WS_IW = 1 * MiB + 768 * 1024;
constexpr size_t WS_WIN = 2 * MiB;
constexpr size_t WS_WOC = 24 * MiB;
constexpr size_t WS_WMIX = 28 * MiB;
constexpr size_t WS_WUP = 32 * MiB;
constexpr size_t WS_WDN = 48 * MiB;
constexpr size_t WS_XG = 64 * MiB;
constexpr size_t WS_Q = 96 * MiB, WS_K = 112 * MiB, WS_V = 128 * MiB;
constexpr size_t WS_IQ = 144 * MiB;
constexpr size_t WS_IK = 152 * MiB;
constexpr size_t WS_MASK = 154 * MiB;
constexpr size_t WS_CB = 162 * MiB, WS_P = 178 * MiB;
constexpr size_t WS_A2 = 194 * MiB;
constexpr size_t WS_SG = 96 * MiB;
constexpr size_t WS_MERGED = 160 * MiB;
constexpr size_t WS_H = 96 * MiB;
constexpr size_t WS_END = 256 * MiB;
namespace pg8 {
#define PG8_LAS __attribute__((address_space(3)))
typedef unsigned short bf16_t;
typedef short bf16x8 __attribute__((ext_vector_type(8)));
typedef float f32x4 __attribute__((ext_vector_type(4)));
typedef unsigned u32x4 __attribute__((ext_vector_type(4)));
constexpr int BM = 256, BK = 64, HALF = 128, HTB = HALF * BK * 2  , STAGE_BYTES = 8 * HTB, NXCD = 8, WGM = 8;

__host__ __device__ __forceinline__ int lds_byte(int r, int c) { const int st = (r >> 4) * 2 + (c >> 5), rr = r & 15, cc = c & 31, ob = rr * 64 + cc * 2; return st * 1024 + (ob ^ (((ob >> 9) & 1) << 5)); }
__host__ __device__ __forceinline__ void stage_rc(int b, int& R, int& C) { const int st = b / 1024, sb = b % 1024, swz = sb ^ (((sb >> 9) & 1) << 5); R = (st >> 1) * 16 + swz / 64; C = (st & 1) * 32 + (swz % 64) / 2; }
__host__ __device__ __forceinline__ int perm32(int rho) { const int n = rho >> 4, i = rho & 15; return 8 * (i >> 2) + 4 * n + (i & 3); }

struct Unit { int pm, pn; };
struct Gemm { const bf16_t* A; const bf16_t* Bt; int M, N, K; };

struct StaticOrder {
    int nM, nN, nwg, G, c;
    __host__ __device__ void init(int M, int N, int G_, int c_) { nM = M / BM; nN = N / BM; nwg = nM * nN; G = G_; c = c_; }
    __host__ __device__ bool next(int i, Unit& u) const {
        const long L = (long)i * G + c; if (L >= nwg) return false;
        int wgid = (int)L; { const int q = nwg / NXCD, r = nwg % NXCD, xcd = wgid % NXCD, off = wgid / NXCD; wgid = (xcd < r ? xcd * (q + 1) : r * (q + 1) + (xcd - r) * q) + off; }
        const int nig = WGM * nN, gid = wgid / nig, fm = gid * WGM, gsz = (nM - fm) < WGM ? (nM - fm) : WGM;
        u.pm = fm + ((wgid % nig) % gsz); u.pn = (wgid % nig) / gsz; return true;
    }
    __device__ __forceinline__ void a_ready(const Unit&) const {}
    __device__ __forceinline__ void done(const Unit&) const {}
};
typedef float cvt_f32x2_t __attribute__((ext_vector_type(2))); typedef __bf16 cvt_bf16x2_t __attribute__((ext_vector_type(2)));
__device__ __forceinline__ unsigned cvt_pk_bf16(float lo, float hi) { cvt_f32x2_t v = {lo, hi}; cvt_bf16x2_t b = __builtin_convertvector(v, cvt_bf16x2_t); return __builtin_bit_cast(unsigned, b); }
typedef float f32x2 __attribute__((ext_vector_type(2)));
__device__ __forceinline__ int lane_now() { int l; asm volatile("v_mbcnt_lo_u32_b32 %0, -1, 0\n\tv_mbcnt_hi_u32_b32 %0, -1, %0" : "=v"(l)); return l; }
__device__ __forceinline__ float row_rstd(const float* rowsq, int row) {
    const float s = (rowsq[row] + rowsq[MROWS + row]) + (rowsq[2 * MROWS + row] + rowsq[3 * MROWS + row]);
    return 1.0f / sqrtf(s * (1.0f / 1024.0f) + 1e-6f);
}
struct EpiProj {
    static constexpr bool PERM = true, AFTER_DRAIN = false, HAS_MID = false;
    const float* rowsq; const float* cs; bf16_t *Q, *K, *V, *IQ, *IK, *CB, *P; float* IW;
    __device__ __forceinline__ void operator()(const f32x4 (&acc)[2][2][4][2], const Unit& u, int wr, int wc, int, int) const {
        const int ln_ = lane_now(), fr = ln_ & 15, fq = ln_ >> 4;
        const int pn = u.pn, row0 = u.pm * BM + wr * 64 + fr;
        if (pn == 7) {
            if (wc >= 3) return;
            const bool ropeL = (wc == 0) && (fq < 2);
#pragma unroll
            for (int ai = 0; ai < 2; ++ai)
#pragma unroll
                for (int m = 0; m < 4; ++m) {
                    const int row = row0 + ai * HALF + m * 16; const float rs = row_rstd(rowsq, row); const int t = row & (SEQ - 1);
                    const f32x4 v0 = acc[ai][0][m][0] * rs, v1 = acc[ai][0][m][1] * rs;
                    if (wc < 2) {
                        f32x4 c4 = (f32x4){1.f, 1.f, 1.f, 1.f}, s4 = (f32x4){0.f, 0.f, 0.f, 0.f};
                        if (ropeL) { c4 = *(const f32x4*)(cs + t * 8 + 4 * fq); s4 = *(const f32x4*)(cs + SEQ * 8 + t * 8 + 4 * fq); }
                        const f32x4 o0 = v0 * c4 - v1 * s4, o1 = v1 * c4 + v0 * s4;
                        u32x4 w; w.x = cvt_pk_bf16(o0[0], o0[1]); w.y = cvt_pk_bf16(o0[2], o0[3]); w.z = cvt_pk_bf16(o1[0], o1[1]); w.w = cvt_pk_bf16(o1[2], o1[3]);
                        *(u32x4*)(IK + (size_t)row * 64 + wc * 32 + 8 * fq) = w;
                    } else if (fq == 0) {
                        *(f32x4*)(IW + (size_t)row * 4) = v0;
                    }
                }
            return;
        }
        if (pn >= 10) {
#pragma unroll
            for (int ai = 0; ai < 2; ++ai)
#pragma unroll
                for (int m = 0; m < 4; ++m) {
                    const int row = row0 + ai * HALF + m * 16; const float rs = row_rstd(rowsq, row); const float rs2 = rs * rs;
#pragma unroll
                    for (int bj = 0; bj < 2; ++bj) {
                        const f32x4 p = acc[ai][bj][m][0] * acc[ai][bj][m][1] * rs2;
                        unsigned long long w = (unsigned long long)cvt_pk_bf16(p[0], p[1]) | ((unsigned long long)cvt_pk_bf16(p[2], p[3]) << 32);
                        *(unsigned long long*)(P + (size_t)row * 512 + (((pn - 10) * 256 + bj * HALF + wc * 32 + 8 * fq) >> 1)) = w;
                    }
                }
            return;
        }
        bf16_t* dst; int pitch, colb; float sc = 1.f; bool rope = false;
        if (pn < 2) { dst = Q; pitch = 512; colb = pn * 256; sc = C2F; rope = true; }
        else if (pn < 4) { dst = K; pitch = 512; colb = (pn - 2) * 256; rope = true; }
        else if (pn < 6) { dst = V; pitch = 512; colb = (pn - 4) * 256; }
        else if (pn == 6) { dst = IQ; pitch = 256; colb = 0; rope = true; }
        else { dst = CB; pitch = 512; colb = (pn - 8) * 256; }
        const bool ropeL = rope && ((wc & 1) == 0) && (fq < 2);
#pragma unroll
        for (int ai = 0; ai < 2; ++ai)
#pragma unroll
            for (int m = 0; m < 4; ++m) {
                const int row = row0 + ai * HALF + m * 16; const float rs = row_rstd(rowsq, row) * sc; const int t = row & (SEQ - 1);
                f32x4 c4 = (f32x4){1.f, 1.f, 1.f, 1.f}, s4 = (f32x4){0.f, 0.f, 0.f, 0.f};
                if (ropeL) { c4 = *(const f32x4*)(cs + t * 8 + 4 * fq); s4 = *(const f32x4*)(cs + SEQ * 8 + t * 8 + 4 * fq); }
                bf16_t* rowp = dst + (size_t)row * pitch + colb + wc * 32 + 8 * fq;
#pragma unroll
                for (int bj = 0; bj < 2; ++bj) {
                    const f32x4 v0 = acc[ai][bj][m][0] * rs, v1 = acc[ai][bj][m][1] * rs;
                    const f32x4 o0 = v0 * c4 - v1 * s4, o1 = v1 * c4 + v0 * s4;
                    u32x4 w; w.x = cvt_pk_bf16(o0[0], o0[1]); w.y = cvt_pk_bf16(o0[2], o0[3]); w.z = cvt_pk_bf16(o1[0], o1[1]); w.w = cvt_pk_bf16(o1[2], o1[3]);
                    *(u32x4*)(rowp + bj * HALF) = w;
                }
            }
    }
};
struct EpiSig {
    static constexpr bool PERM = true, AFTER_DRAIN = false, HAS_MID = false;
    const float* rowsq; bf16_t* SG;
    __device__ __forceinline__ void operator()(const f32x4 (&acc)[2][2][4][2], const Unit& u, int wr, int wc, int, int) const {
        const int ln_ = lane_now(), fr = ln_ & 15, fq = ln_ >> 4;
        const int row0 = u.pm * BM + wr * 64 + fr, col0 = u.pn * BM + wc * 32 + 8 * fq;
#pragma unroll
        for (int ai = 0; ai < 2; ++ai)
#pragma unroll
            for (int m = 0; m < 4; ++m) {
                const int row = row0 + ai * HALF + m * 16; const float rs = row_rstd(rowsq, row) * (-1.4426950408889634f);
                bf16_t* rowp = SG + (size_t)row * NPG + col0;
#pragma unroll
                for (int bj = 0; bj < 2; ++bj) {
                    f32x4 v0 = acc[ai][bj][m][0] * rs, v1 = acc[ai][bj][m][1] * rs;
#pragma unroll
                    for (int j = 0; j < 4; ++j) { v0[j] = __builtin_amdgcn_rcpf(1.0f + __builtin_amdgcn_exp2f(v0[j])); v1[j] = __builtin_amdgcn_rcpf(1.0f + __builtin_amdgcn_exp2f(v1[j])); }
                    u32x4 w; w.x = cvt_pk_bf16(v0[0], v0[1]); w.y = cvt_pk_bf16(v0[2], v0[3]); w.z = cvt_pk_bf16(v1[0], v1[1]); w.w = cvt_pk_bf16(v1[2], v1[3]);
                    *(u32x4*)(rowp + bj * HALF) = w;
                }
            }
    }
};
struct EpiMerged {
    static constexpr bool PERM = true, AFTER_DRAIN = false, HAS_MID = true;
    const bf16_t* SG; bf16_t* O;
    __device__ __forceinline__ void mid(f32x4 (&acc)[2][2][4][2], const Unit& u, int wr, int wc, int, int) const {
        const int ln_ = lane_now(), fr = ln_ & 15, fq = ln_ >> 4;
        const int row0 = u.pm * BM + wr * 64 + fr, col0 = u.pn * BM + wc * 32 + 8 * fq;
#pragma unroll
        for (int ai = 0; ai < 2; ++ai)
#pragma unroll
            for (int m = 0; m < 4; ++m) {
                const bf16_t* sp = SG + (size_t)(row0 + ai * HALF + m * 16) * NPG + col0;
#pragma unroll
                for (int bj = 0; bj < 2; ++bj) {
                    const u32x4 a = *(const u32x4*)(sp + bj * HALF), c = *(const u32x4*)(sp + 1024 + bj * HALF);
#pragma unroll
                    for (int j = 0; j < 4; ++j) {
                        const float a0 = __builtin_bit_cast(float, a[j] << 16), a1 = __builtin_bit_cast(float, a[j] & 0xffff0000u);
                        const float c0 = __builtin_bit_cast(float, c[j] << 16), c1 = __builtin_bit_cast(float, c[j] & 0xffff0000u);
                        const float r0 = a0 * __builtin_amdgcn_rcpf(c0), r1 = a1 * __builtin_amdgcn_rcpf(c1);
                        acc[ai][bj][m][j >> 1][(j & 1) * 2] *= r0; acc[ai][bj][m][j >> 1][(j & 1) * 2 + 1] *= r1;
                    }
                }
            }
    }
    __device__ __forceinline__ void operator()(const f32x4 (&acc)[2][2][4][2], const Unit& u, int wr, int wc, int, int) const {
        const int ln_ = lane_now(), fr = ln_ & 15, fq = ln_ >> 4;
        const int row0 = u.pm * BM + wr * 64 + fr, col0 = u.pn * BM + wc * 32 + 8 * fq;
#pragma unroll
        for (int ai = 0; ai < 2; ++ai)
#pragma unroll
            for (int m = 0; m < 4; ++m) {
                const int row = row0 + ai * HALF + m * 16;
                const bf16_t* sp = SG + (size_t)row * NPG + 1024 + col0;
                bf16_t* rowp = O + (size_t)row * 1024 + col0;
#pragma unroll
                for (int bj = 0; bj < 2; ++bj) {
                    const u32x4 c = *(const u32x4*)(sp + bj * HALF);
                    float o[8];
#pragma unroll
                    for (int j = 0; j < 4; ++j) {
                        const float c0 = __builtin_bit_cast(float, c[j] << 16), c1 = __builtin_bit_cast(float, c[j] & 0xffff0000u);
                        o[2 * j] = acc[ai][bj][m][j >> 1][(j & 1) * 2] * c0; o[2 * j + 1] = acc[ai][bj][m][j >> 1][(j & 1) * 2 + 1] * c1;
                    }
                    u32x4 w; w.x = cvt_pk_bf16(o[0], o[1]); w.y = cvt_pk_bf16(o[2], o[3]); w.z = cvt_pk_bf16(o[4], o[5]); w.w = cvt_pk_bf16(o[6], o[7]);
                    *(u32x4*)(rowp + bj * HALF) = w;
                }
            }
    }
};
struct EpiRelu2 {
    static constexpr bool PERM = true, AFTER_DRAIN = false, HAS_MID = false;
    const float* rowsq; bf16_t* O;
    __device__ __forceinline__ void operator()(const f32x4 (&acc)[2][2][4][2], const Unit& u, int wr, int wc, int, int) const {
        const int ln_ = lane_now(), fr = ln_ & 15, fq = ln_ >> 4;
        const int row0 = u.pm * BM + wr * 64 + fr, col0 = u.pn * BM + wc * 32 + 8 * fq;
#pragma unroll
        for (int ai = 0; ai < 2; ++ai)
#pragma unroll
            for (int m = 0; m < 4; ++m) {
                const int row = row0 + ai * HALF + m * 16; const float rs = row_rstd(rowsq, row);
                bf16_t* rowp = O + (size_t)row * MLP_H + col0;
#pragma unroll
                for (int bj = 0; bj < 2; ++bj) {
                    f32x4 v0 = acc[ai][bj][m][0] * rs, v1 = acc[ai][bj][m][1] * rs;
#pragma unroll
                    for (int j = 0; j < 4; ++j) { const float a = fmaxf(v0[j], 0.f), b = fmaxf(v1[j], 0.f); v0[j] = a * a; v1[j] = b * b; }
                    u32x4 w; w.x = cvt_pk_bf16(v0[0], v0[1]); w.y = cvt_pk_bf16(v0[2], v0[3]); w.z = cvt_pk_bf16(v1[0], v1[1]); w.w = cvt_pk_bf16(v1[2], v1[3]);
                    *(u32x4*)(rowp + bj * HALF) = w;
                }
            }
    }
};
struct EpiResid {
    static constexpr bool PERM = false, AFTER_DRAIN = true, HAS_MID = false;
    const float* base; float* out; bf16_t* xg; const float* gnext; float* rowsq;
    __device__ __forceinline__ void fused(f32x4 (&acc)[2][2][4][2], const Unit& u, int wr, int wc, int, int, PG8_LAS unsigned char* lds, int wid, int) const {
        const int lane = lane_now(), fr = lane & 15, fq = lane >> 4;
        PG8_LAS float* Pt = (PG8_LAS float*)lds;
        const int col0 = u.pn * BM + wc * 32 + 4 * fq;
        f32x4 gv[2][2];
#pragma unroll
        for (int bj = 0; bj < 2; ++bj)
#pragma unroll
            for (int n = 0; n < 2; ++n) gv[bj][n] = gnext ? *(const f32x4*)(gnext + col0 + bj * HALF + n * 16) : (f32x4){0.f, 0.f, 0.f, 0.f};
#pragma unroll
        for (int ai = 0; ai < 2; ++ai)
#pragma unroll
            for (int m = 0; m < 4; ++m) {
                const int r = ai * HALF + wr * 64 + m * 16 + fr; const size_t off = (size_t)(u.pm * BM + r) * D_MODEL + col0; float s = 0.f;
#pragma unroll
                for (int bj = 0; bj < 2; ++bj)
#pragma unroll
                    for (int n = 0; n < 2; ++n) {
                        const f32x4 bs = *(const f32x4*)(base + off + bj * HALF + n * 16); const f32x4 xn = bs + acc[ai][bj][m][n];
                        *(f32x4*)(out + off + bj * HALF + n * 16) = xn;
                        s += (xn[0] * xn[0] + xn[1] * xn[1]) + (xn[2] * xn[2] + xn[3] * xn[3]);
                        if (gnext) { const f32x4 y = xn * gv[bj][n];
                            *(unsigned long long*)(xg + off + bj * HALF + n * 16) = (unsigned long long)cvt_pk_bf16(y[0], y[1]) | ((unsigned long long)cvt_pk_bf16(y[2], y[3]) << 32); }
                    }
                s += __shfl_xor(s, 16); s += __shfl_xor(s, 32);
                if (fq == 0) Pt[r * 4 + wc] = s;
                asm volatile("" ::: "memory");
            }
        asm volatile("s_waitcnt lgkmcnt(0)" ::: "memory"); __builtin_amdgcn_s_barrier(); asm volatile("" ::: "memory");
        const int tid = wid * 64 + lane;
        if (tid < 256) rowsq[(size_t)u.pn * MROWS + u.pm * BM + tid] = (Pt[tid * 4] + Pt[tid * 4 + 1]) + (Pt[tid * 4 + 2] + Pt[tid * 4 + 3]);
    }
};
template <class Epi, class Sched, bool ALIGN_EPI = false, bool SP2 = false>
__device__ __forceinline__ void gemm_phase(PG8_LAS unsigned char* lds, const Gemm g, const Sched& S, const Epi& E, const int wid) {
    const int lane = lane_now(), tid = wid * 64 + lane, wr = wid >> 2, wc = wid & 3, fr = lane & 15, fq = lane >> 4;
    const int K = g.K, nt = K / BK;
    unsigned voffA[2], voffB[2];
#pragma unroll
    for (int i = 0; i < 2; ++i) { int R, C; stage_rc(tid * 16 + i * 8192, R, C); const int Rb = Epi::PERM ? ((R & ~31) + perm32(R & 31)) : R;
        voffA[i] = (unsigned)(R * K + C) * 2u; voffB[i] = (unsigned)(Rb * K + C) * 2u; }
    const size_t kstep = (size_t)(BK * 2);
    const size_t hstep = (size_t)HALF * K * 2;
    const size_t tstep = 2 * hstep;
    const unsigned ldsw = (unsigned)wid * 1024u;
    const int aoff = lds_byte(wr * 64 + fr, fq * 8), boff = lds_byte(wc * 32 + fr, fq * 8);
#define PG8_SA(b, h) (((b) * 2 + (h)) * HTB)
#define PG8_SB(b, h) ((4 + (b) * 2 + (h)) * HTB)
#define PG8_STAGE(bufoff, gbase, voff) do { _Pragma("unroll") for (int _i = 0; _i < 2; ++_i) \
        __builtin_amdgcn_global_load_lds((const unsigned*)((const char*)(gbase) + (voff)[_i]), (PG8_LAS unsigned*)(lds + (bufoff) + ldsw + _i * 8192), 16, 0, 0); } while (0)
#define PG8_LDA(dst, b, h) do { _Pragma("unroll") for (int m = 0; m < 4; ++m) _Pragma("unroll") for (int k = 0; k < 2; ++k) dst[m][k] = *(const PG8_LAS bf16x8*)(lds + PG8_SA(b, h) + aoff + m * 2048 + k * 1024); } while (0)
#define PG8_LDB(dst, b, h) do { _Pragma("unroll") for (int n = 0; n < 2; ++n) _Pragma("unroll") for (int k = 0; k < 2; ++k) dst[n][k] = *(const PG8_LAS bf16x8*)(lds + PG8_SB(b, h) + boff + n * 2048 + k * 1024); } while (0)
#define PG8_MMA(ai, bj, At, Bt) do { __builtin_amdgcn_s_setprio(1); _Pragma("unroll") for (int m = 0; m < 4; ++m) _Pragma("unroll") for (int n = 0; n < 2; ++n) _Pragma("unroll") for (int k = 0; k < 2; ++k) \
        acc[ai][bj][m][n] = __builtin_amdgcn_mfma_f32_16x16x32_bf16(Bt[n][k], At[m][k], acc[ai][bj][m][n], 0, 0, 0); __builtin_amdgcn_s_setprio(0); } while (0)
#define PG8_WAIT_V(n) asm volatile("s_waitcnt vmcnt(" #n ")" ::: "memory")
#define PG8_WAIT_L(n) asm volatile("s_waitcnt lgkmcnt(" #n ")" ::: "memory")
#define PG8_BAR __builtin_amdgcn_s_barrier()
#define PG8_SCHED __builtin_amdgcn_sched_barrier(0)
    Unit cur, nxt; int ui = 0;
    if (!S.next(0, cur)) return;
    f32x4 acc[2][2][4][2];
#pragma unroll
    for (int a = 0; a < 2; ++a)
#pragma unroll
        for (int b = 0; b < 2; ++b)
#pragma unroll
            for (int m = 0; m < 4; ++m)
#pragma unroll
                for (int n = 0; n < 2; ++n) acc[a][b][m][n] = (f32x4){0.f, 0.f, 0.f, 0.f};
    bf16x8 At[4][2], B0[2][2], B1[2][2];
    const char* cA = (const char*)g.A + (size_t)cur.pm * tstep; const char* cB = (const char*)g.Bt + (size_t)cur.pn * tstep;
    S.a_ready(cur);
    if constexpr (SP2) {
        PG8_STAGE(PG8_SB(0, 0), cB, voffB); PG8_STAGE(PG8_SB(0, 1), cB + hstep, voffB); PG8_STAGE(PG8_SA(0, 0), cA, voffA); PG8_STAGE(PG8_SA(0, 1), cA + hstep, voffA);
        if (wr == 1) PG8_BAR;
        PG8_WAIT_V(2); PG8_BAR;
        PG8_STAGE(PG8_SB(1, 0), cB + kstep, voffB); PG8_STAGE(PG8_SA(1, 0), cA + kstep, voffA); PG8_STAGE(PG8_SB(1, 1), cB + hstep + kstep, voffB);
        PG8_WAIT_V(6); PG8_BAR;
    } else {
        PG8_STAGE(PG8_SB(0, 0), cB, voffB); PG8_STAGE(PG8_SA(0, 0), cA, voffA); PG8_STAGE(PG8_SB(0, 1), cB + hstep, voffB); PG8_STAGE(PG8_SA(0, 1), cA + hstep, voffA);
        if (wr == 1) PG8_BAR;
        PG8_WAIT_V(4); PG8_BAR;
        PG8_STAGE(PG8_SB(1, 0), cB + kstep, voffB); PG8_STAGE(PG8_SA(1, 0), cA + kstep, voffA); PG8_STAGE(PG8_SB(1, 1), cB + hstep + kstep, voffB);
        PG8_WAIT_V(6); PG8_BAR;
    }
    for (;;) {
        const bool has_next = S.next(ui + 1, nxt);
        const char* nA = has_next ? (const char*)g.A + (size_t)nxt.pm * tstep : cA; const char* nB = has_next ? (const char*)g.Bt + (size_t)nxt.pn * tstep : cB;
        for (int t = 0; t < nt; t += 2) {
            const bool last = (t == nt - 2);
            const char* a1 = cA + (size_t)(t + 1) * kstep;
            const char* a2 = last ? nA : cA + (size_t)(t + 2) * kstep; const char* b2 = last ? nB : cB + (size_t)(t + 2) * kstep;
            const char* a3 = a2 + kstep; const char* b3 = b2 + kstep;
            if (last && has_next) S.a_ready(nxt);
            if constexpr (Epi::HAS_MID) { if (t == (nt >> 1)) E.mid(acc, cur, wr, wc, fr, fq); }
            if constexpr (SP2) {
            PG8_LDB(B0, 0, 0); PG8_LDB(B1, 0, 1); PG8_SCHED; PG8_LDA(At, 0, 0); PG8_STAGE(PG8_SA(1, 1), a1 + hstep, voffA);
            PG8_WAIT_V(8); PG8_WAIT_L(0); PG8_BAR; PG8_MMA(0, 0, At, B0); PG8_MMA(0, 1, At, B1); PG8_BAR; PG8_SCHED;
            PG8_LDA(At, 0, 1); PG8_STAGE(PG8_SB(0, 0), b2, voffB); PG8_STAGE(PG8_SB(0, 1), b2 + hstep, voffB); PG8_STAGE(PG8_SA(0, 0), a2, voffA);
            PG8_WAIT_V(8); PG8_WAIT_L(0); PG8_BAR; PG8_MMA(1, 0, At, B0); PG8_MMA(1, 1, At, B1); PG8_BAR; PG8_SCHED;
            PG8_LDB(B0, 1, 0); PG8_LDB(B1, 1, 1); PG8_SCHED; PG8_LDA(At, 1, 0); PG8_STAGE(PG8_SA(0, 1), a2 + hstep, voffA);
            PG8_WAIT_V(8); PG8_WAIT_L(0); PG8_BAR; PG8_MMA(0, 0, At, B0); PG8_MMA(0, 1, At, B1); PG8_BAR; PG8_SCHED;
            PG8_LDA(At, 1, 1); PG8_STAGE(PG8_SB(1, 0), b3, voffB); PG8_STAGE(PG8_SB(1, 1), b3 + hstep, voffB); PG8_STAGE(PG8_SA(1, 0), a3, voffA);
            PG8_WAIT_V(8); PG8_WAIT_L(0); PG8_BAR; PG8_MMA(1, 0, At, B0); PG8_MMA(1, 1, At, B1); PG8_BAR; PG8_SCHED;
            } else {
            PG8_LDB(B0, 0, 0); PG8_SCHED; PG8_LDA(At, 0, 0); PG8_STAGE(PG8_SA(1, 1), a1 + hstep, voffA);
            PG8_WAIT_L(8); PG8_BAR; PG8_WAIT_L(0); PG8_MMA(0, 0, At, B0); PG8_BAR; PG8_SCHED;
            PG8_LDB(B1, 0, 1); PG8_STAGE(PG8_SB(0, 0), b2, voffB);
            PG8_BAR; PG8_WAIT_L(0); PG8_MMA(0, 1, At, B1); PG8_BAR;
            PG8_LDA(At, 0, 1); PG8_STAGE(PG8_SA(0, 0), a2, voffA);
            PG8_BAR; PG8_WAIT_L(0); PG8_MMA(1, 0, At, B0); PG8_BAR; PG8_SCHED;
            PG8_STAGE(PG8_SB(0, 1), b2 + hstep, voffB);
            PG8_WAIT_V(6); PG8_BAR; PG8_MMA(1, 1, At, B1); PG8_BAR;
            PG8_LDB(B0, 1, 0); PG8_SCHED; PG8_LDA(At, 1, 0); PG8_STAGE(PG8_SA(0, 1), a2 + hstep, voffA);
            PG8_WAIT_L(8); PG8_BAR; PG8_WAIT_L(0); PG8_MMA(0, 0, At, B0); PG8_BAR; PG8_SCHED;
            PG8_LDB(B1, 1, 1); PG8_STAGE(PG8_SB(1, 0), b3, voffB);
            PG8_BAR; PG8_WAIT_L(0); PG8_MMA(0, 1, At, B1); PG8_BAR;
            PG8_LDA(At, 1, 1); PG8_STAGE(PG8_SA(1, 0), a3, voffA);
            PG8_BAR; PG8_WAIT_L(0); PG8_MMA(1, 0, At, B0); PG8_BAR; PG8_SCHED;
            PG8_STAGE(PG8_SB(1, 1), b3 + hstep, voffB);
            PG8_WAIT_V(6); PG8_BAR; PG8_MMA(1, 1, At, B1); PG8_BAR;
            }
        }
        if constexpr (ALIGN_EPI) { if (wr == 0) PG8_BAR; }
        if constexpr (!Epi::AFTER_DRAIN) { E(acc, cur, wr, wc, fr, fq); S.done(cur); }
        if (!has_next) break;
#pragma unroll
        for (int a = 0; a < 2; ++a)
#pragma unroll
            for (int b = 0; b < 2; ++b)
#pragma unroll
                for (int m = 0; m < 4; ++m)
#pragma unroll
                    for (int n = 0; n < 2; ++n) acc[a][b][m][n] = (f32x4){0.f, 0.f, 0.f, 0.f};
        cur = nxt; cA = nA; cB = nB; ++ui;
        if constexpr (ALIGN_EPI) { if (wr == 1) PG8_BAR; }
    }
    PG8_WAIT_V(0);
    if constexpr (!ALIGN_EPI) { if (wr == 0) PG8_BAR; }
    PG8_BAR;
    if constexpr (Epi::AFTER_DRAIN) { E.fused(acc, cur, wr, wc, fr, fq, lds, wid, lane); S.done(cur); }
#undef PG8_SA
#undef PG8_SB
#undef PG8_STAGE
#undef PG8_LDA
#undef PG8_LDB
#undef PG8_MMA
#undef PG8_WAIT_V
#undef PG8_WAIT_L
#undef PG8_BAR
#undef PG8_SCHED
}
}
constexpr int NWAVES = 8;
constexpr int RING_OFF = 0, RING_BYTES = 131072;
constexpr int LDS_BYTES = 147456;
constexpr int MISC_OFF = 140000;
static_assert(MISC_OFF % 16 == 0 && MISC_OFF + 256 <= LDS_BYTES, "LDS map");

typedef unsigned v4u __attribute__((ext_vector_type(4)));
typedef float f32x4 __attribute__((ext_vector_type(4)));
#define LDS_WAIT() asm volatile("s_waitcnt lgkmcnt(0)" ::: "memory")
#define VM_WAIT() asm volatile("s_waitcnt vmcnt(0)" ::: "memory")

__device__ __forceinline__ float wave_sum(float v) {
#pragma unroll
    for (int o = 1; o < 64; o <<= 1) v += __shfl_xor(v, o);
    return v;
}

__device__ __forceinline__ int rperm(int p) { return p < 16 ? ((p & 3) | ((p & 4) << 1) | ((p & 8) >> 1)) : p; }
__device__ __forceinline__ int win_src_col(int n) {
    if (n < 512) return OFF_Q + (n & ~63) + rperm(n & 63);
    if (n < 1024) { const int m = n - 512; return OFF_K + (m & ~63) + rperm(m & 63); }
    if (n < 1536) return OFF_V + (n - 1024);
    if (n < 1792) { const int m = n - 1536; return OFF_IQ + (m & ~63) + rperm(m & 63); }
    if (n < 1856) return OFF_IK + rperm(n - 1792);
    if (n < 1860) return OFF_IW + (n - 1856);
    if (n < 2048) return -1;
    if (n < 2560) return OFF_CB + (n - 2048);
    if (n < 3584) { const int m = n - 2560, G = m >> 3, i = m & 7; return i < 4 ? OFF_CC + 4 * G + i : OFF_CH + 4 * G + (i - 4); }
    return OFF_G + (n - 3584);
}
template <bool MAPPED>
__device__ __forceinline__ void transpose_item(const float* __restrict__ W, int Nsrc, bf16* WT, int dst_ld, int dst_col0, int k0, int n0, LAS float* scr, int lane) {
    const int nn = n0 + (lane & 31);
    const int sc = MAPPED ? win_src_col(nn) : nn;
#pragma unroll 8
    for (int i = 0; i < 32; ++i) { const int kk = 2 * i + (lane >> 5); scr[kk * 33 + (lane & 31)] = (sc >= 0) ? W[(size_t)(k0 + kk) * Nsrc + sc] : 0.f; }
    LDS_WAIT(); asm volatile("" ::: "memory");
    const int c = lane & 7;
#pragma unroll
    for (int j = 0; j < 4; ++j) { const int n = (lane >> 3) + 8 * j; const LAS float* s = scr + (8 * c) * 33 + n;
        v4u o; o.x = pk2(s[0 * 33], s[1 * 33]); o.y = pk2(s[2 * 33], s[3 * 33]); o.z = pk2(s[4 * 33], s[5 * 33]); o.w = pk2(s[6 * 33], s[7 * 33]);
        *(GAS v4u*)(WT + (size_t)(n0 + n) * dst_ld + dst_col0 + k0 + 8 * c) = o; }
    LDS_WAIT(); asm volatile("" ::: "memory");
}
__device__ __forceinline__ void sincos_acc(float ang_f, float& s_out, float& c_out) {
    const double a = (double)ang_f;
    const double q = rint(a * 0.63661977236758134308);
    double r = fma(-q, 1.57079632679489655800e+00, a);
    r = fma(-q, 6.12323399573676603587e-17, r);
    const double r2 = r * r;
    double sp = 1.0 / 6227020800.0; sp = fma(sp, r2, -1.0 / 39916800.0); sp = fma(sp, r2, 1.0 / 362880.0); sp = fma(sp, r2, -1.0 / 5040.0);
    sp = fma(sp, r2, 1.0 / 120.0); sp = fma(sp, r2, -1.0 / 6.0); sp = fma(sp, r2, 1.0);
    const double sn = sp * r;
    double cp = 1.0 / 87178291200.0; cp = fma(cp, r2, -1.0 / 479001600.0); cp = fma(cp, r2, 1.0 / 3628800.0); cp = fma(cp, r2, -1.0 / 40320.0);
    cp = fma(cp, r2, 1.0 / 720.0); cp = fma(cp, r2, -1.0 / 24.0); cp = fma(cp, r2, 0.5); cp = fma(-cp, r2, 1.0);
    const int qi = ((int)q) & 3;
    double s, c;
    if (qi == 0) { s = sn; c = cp; } else if (qi == 1) { s = cp; c = -sn; } else if (qi == 2) { s = -sn; c = -cp; } else { s = -cp; c = sn; }
    s_out = (float)s; c_out = (float)c;
}
__device__ __forceinline__ float rope_inv(int j) {
    return j == 0 ? 1.0f : j == 1 ? 0.193922758102417f : j == 2 ? 0.03760603070259094f : j == 3 ? 0.00729266507551074f : j == 4 ? 0.001414213445968926f
         : j == 5 ? 0.00027424818836152554f : j == 6 ? 5.318296462064609e-05f : 1.0313385246263351e-05f;
}
__device__ __forceinline__ void xg_row(const float* xrow, const float* g, bf16* orow, float* rowsq, int row, int lane) {
    const GAS f32x4* xr = (const GAS f32x4*)xrow + lane; const GAS f32x4* gr = (const GAS f32x4*)g + lane;
    f32x4 v[4]; float s = 0.f;
#pragma unroll
    for (int j = 0; j < 4; ++j) { v[j] = xr[64 * j]; s += (v[j].x * v[j].x + v[j].y * v[j].y) + (v[j].z * v[j].z + v[j].w * v[j].w); }
    s = wave_sum(s);
    GAS unsigned long long* o8 = (GAS unsigned long long*)orow + lane;
#pragma unroll
    for (int j = 0; j < 4; ++j) { const f32x4 gg = gr[64 * j]; o8[64 * j] = (unsigned long long)pk2(v[j].x * gg.x, v[j].y * gg.y) | ((unsigned long long)pk2(v[j].z * gg.z, v[j].w * gg.w) << 32); }
    if (lane < 4) rowsq[lane * MROWS + row] = (lane == 0) ? s : 0.f;
}

namespace sel {
typedef short bf16x8 __attribute__((ext_vector_type(8)));
typedef float f32x4 __attribute__((ext_vector_type(4)));
typedef unsigned u32x4 __attribute__((ext_vector_type(4)));
constexpr int ROWB = 8208;
constexpr int K16_BYTES = 16 * ROWB;
constexpr int MSK_OFF = K16_BYTES;
static_assert(MSK_OFF + 8192 <= MISC_OFF, "selection LDS map");
__device__ __forceinline__ int lane_now() { int l; asm volatile("v_mbcnt_lo_u32_b32 %0, -1, 0\n\tv_mbcnt_hi_u32_b32 %0, -1, %0" : "=v"(l)); return l; }
__device__ __forceinline__ void wg_barrier() { asm volatile("s_waitcnt vmcnt(0) lgkmcnt(0)\n\ts_barrier" ::: "memory"); }
__device__ __forceinline__ unsigned long long low_n_bits(unsigned long long m, int n) { unsigned long long a = 0ull; for (int i = 0; i < n; ++i) { const unsigned long long lb = m & (0ull - m); a |= lb; m ^= lb; } return a; }
__device__ __forceinline__ unsigned key_pair(float a, float b) {
    const unsigned x = __builtin_bit_cast(unsigned, __builtin_amdgcn_cvt_pkrtz(a, b));
    const unsigned neg = (x >> 15) & 0x00010001u;
    return x ^ (0x80008000u | (neg * 0x7fffu));
}
__device__ __forceinline__ void sel_unit(LAS unsigned char* lds, const int b, const int qb16, const bf16* __restrict__ IQ, const bf16* __restrict__ IK, const float* __restrict__ IW,
                                         unsigned long long* __restrict__ MASK, const int wid) {
    const int lane = lane_now();
    const int q = lane & 15, g = lane >> 4;
    const int t0 = qb16 * 16;
    const int N = ((t0 >> 6) + 1) << 6;
    const int NST = (N + 127) >> 7;
    const size_t rb = (size_t)b * SEQ;
    {
        bf16x8 bq[4][2];
#pragma unroll
        for (int h = 0; h < 4; ++h)
#pragma unroll
            for (int ks = 0; ks < 2; ++ks) bq[h][ks] = *(const bf16x8*)(IQ + (rb + t0 + q) * 256 + h * 64 + ks * 32 + 8 * g);
        const f32x4 w4 = *(const f32x4*)(IW + (rb + t0 + q) * 4);
        for (int st = wid; st < NST; st += 8) {
            const int k0 = st * 128;
            const bool hiok = (k0 + 64) < N;
#pragma unroll
            for (int kt = 0; kt < 4; ++kt) {
                const bf16* ikA = IK + (rb + k0 + 16 * kt + q) * 64 + 8 * g;
                const bf16* ikB = ikA + 64 * 64;
                const bf16x8 aA0 = *(const bf16x8*)ikA, aA1 = *(const bf16x8*)(ikA + 32), aB0 = *(const bf16x8*)ikB, aB1 = *(const bf16x8*)(ikB + 32);
                f32x4 sA = (f32x4){0.f, 0.f, 0.f, 0.f}, sB = (f32x4){0.f, 0.f, 0.f, 0.f};
#pragma unroll
                for (int h = 0; h < 4; ++h) {
                    f32x4 cA = __builtin_amdgcn_mfma_f32_16x16x32_bf16(aA0, bq[h][0], (f32x4){0.f, 0.f, 0.f, 0.f}, 0, 0, 0);
                    cA = __builtin_amdgcn_mfma_f32_16x16x32_bf16(aA1, bq[h][1], cA, 0, 0, 0);
                    f32x4 cB = __builtin_amdgcn_mfma_f32_16x16x32_bf16(aB0, bq[h][0], (f32x4){0.f, 0.f, 0.f, 0.f}, 0, 0, 0);
                    cB = __builtin_amdgcn_mfma_f32_16x16x32_bf16(aB1, bq[h][1], cB, 0, 0, 0);
#pragma unroll
                    for (int r = 0; r < 4; ++r) { sA[r] = fmaf(fmaxf(cA[r], 0.f), w4[h], sA[r]); sB[r] = fmaf(fmaxf(cB[r], 0.f), w4[h], sB[r]); }
                }
                u32x4 d;
#pragma unroll
                for (int r = 0; r < 4; ++r) { const unsigned k = key_pair(sA[r], sB[r]); d[r] = hiok ? k : (k & 0xffffu); }
                *(LAS u32x4*)(lds + q * ROWB + (st * 64 + 16 * kt + 4 * g) * 4) = d;
            }
        }
    }
    wg_barrier();
#pragma unroll 1
    for (int qq = 0; qq < 2; ++qq) {
        const int ql = 2 * wid + qq;
        const LAS unsigned* rowp = (const LAS unsigned*)(lds + ql * ROWB);
        unsigned xh[32], xl[32];
#pragma unroll
        for (int j = 0; j < 32; ++j) { xh[j] = (j < NST) ? rowp[j * 64 + lane] : 0u; xl[j] = xh[j] << 16; }
        unsigned T = 0u; int rem = 0;
        if (N > 256) {
#pragma unroll 1
            for (int bit = 15; bit >= 0; --bit) {
                const unsigned cand = (T | (1u << bit)) << 16;
                int c = 0;
#pragma unroll
                for (int g8 = 0; g8 < 4; ++g8) if (g8 * 8 < NST) {
#pragma unroll
                    for (int jj = 0; jj < 8; ++jj) { const int j = g8 * 8 + jj;
                        c += __builtin_popcountll(__builtin_amdgcn_ballot_w64(xh[j] >= cand)) + __builtin_popcountll(__builtin_amdgcn_ballot_w64(xl[j] >= cand)); }
                }
                if (c >= 256) T |= (1u << bit);
            }
            const unsigned tg = (T + 1u) << 16;
            int cg = 0;
#pragma unroll
            for (int j = 0; j < 32; ++j) cg += __builtin_popcountll(__builtin_amdgcn_ballot_w64(xh[j] >= tg)) + __builtin_popcountll(__builtin_amdgcn_ballot_w64(xl[j] >= tg));
            rem = 256 - cg;
        }
        const unsigned te = T << 16, tg2 = (T + 1u) << 16;
        unsigned mlo = 0u, mhi = 0u;
#pragma unroll
        for (int j = 0; j < 32; ++j) {
#pragma unroll
            for (int hf = 0; hf < 2; ++hf) {
                const int tile = 2 * j + hf;
                unsigned long long m;
                if (N <= 256) m = (tile * 64 < N) ? ~0ull : 0ull;
                else {
                    const unsigned v = hf ? (xh[j] & 0xffff0000u) : xl[j];
                    m = __builtin_amdgcn_ballot_w64(v >= tg2);
                    const unsigned long long eq = __builtin_amdgcn_ballot_w64(v == te);
                    const int ce = __builtin_popcountll(eq);
                    if (ce <= rem) { m |= eq; rem -= ce; } else { m |= low_n_bits(eq, rem); rem = 0; }
                }
                { const unsigned ml_ = __builtin_amdgcn_readfirstlane((unsigned)m), mh_ = __builtin_amdgcn_readfirstlane((unsigned)(m >> 32));
                  asm volatile("v_writelane_b32 %0, %1, %2" : "+v"(mlo) : "s"(ml_), "n"(tile));
                  asm volatile("v_writelane_b32 %0, %1, %2" : "+v"(mhi) : "s"(mh_), "n"(tile)); }
            }
        }
        *(LAS unsigned long long*)(lds + MSK_OFF + ql * 512 + lane * 8) = (unsigned long long)mlo | ((unsigned long long)mhi << 32);
    }
    wg_barrier();
    {
        const int tid = wid * 64 + lane, tile = tid >> 3, pr = tid & 7;
        const unsigned long long m0 = *(const LAS unsigned long long*)(lds + MSK_OFF + (2 * pr) * 512 + tile * 8);
        const unsigned long long m1 = *(const LAS unsigned long long*)(lds + MSK_OFF + (2 * pr + 1) * 512 + tile * 8);
        u32x4 o; o.x = (unsigned)m0; o.y = (unsigned)(m0 >> 32); o.z = (unsigned)m1; o.w = (unsigned)(m1 >> 32);
        *(u32x4*)(MASK + ((size_t)(b * 64 + tile) * SEQ + t0 + 2 * pr)) = o;
    }
    wg_barrier();
}
__device__ __forceinline__ void convmid_rows(const bf16* __restrict__ CB, const bf16* __restrict__ P, const float* __restrict__ cw, bf16* __restrict__ A2, const int row_base, const int wid) {
    const int lane = lane_now(); const int c8 = lane * 8;
    f32x4 w[3][2];
#pragma unroll
    for (int k = 0; k < 3; ++k) { w[k][0] = *(const f32x4*)(cw + k * 512 + c8); w[k][1] = *(const f32x4*)(cw + k * 512 + c8 + 4); }
#pragma unroll 1
    for (int pass = 0; pass < 8; ++pass) {
        const int row = row_base + pass * 8 + wid, t = row & (SEQ - 1);
        const u32x4 zero = (u32x4){0u, 0u, 0u, 0u};
        const u32x4 p0 = *(const u32x4*)(P + (size_t)row * 512 + c8);
        const u32x4 p1 = (t >= 1) ? *(const u32x4*)(P + (size_t)(row - 1) * 512 + c8) : zero;
        const u32x4 p2 = (t >= 2) ? *(const u32x4*)(P + (size_t)(row - 2) * 512 + c8) : zero;
        const u32x4 cb = *(const u32x4*)(CB + (size_t)row * 512 + c8);
        float o[8];
#pragma unroll
        for (int j = 0; j < 4; ++j) {
            const float a0 = __builtin_bit_cast(float, p0[j] << 16), a1 = __builtin_bit_cast(float, p0[j] & 0xffff0000u);
            const float b0 = __builtin_bit_cast(float, p1[j] << 16), b1 = __builtin_bit_cast(float, p1[j] & 0xffff0000u);
            const float c0 = __builtin_bit_cast(float, p2[j] << 16), c1 = __builtin_bit_cast(float, p2[j] & 0xffff0000u);
            const float g0 = __builtin_bit_cast(float, cb[j] << 16), g1 = __builtin_bit_cast(float, cb[j] & 0xffff0000u);
            const int e0 = 2 * j, e1 = 2 * j + 1;
            o[e0] = g0 * (w[0][e0 >> 2][e0 & 3] * c0 + w[1][e0 >> 2][e0 & 3] * b0 + w[2][e0 >> 2][e0 & 3] * a0);
            o[e1] = g1 * (w[0][e1 >> 2][e1 & 3] * c1 + w[1][e1 >> 2][e1 & 3] * b1 + w[2][e1 >> 2][e1 & 3] * a1);
        }
        u32x4 r; r.x = pk2(o[0], o[1]); r.y = pk2(o[2], o[3]); r.z = pk2(o[4], o[5]); r.w = pk2(o[6], o[7]);
        *(u32x4*)(A2 + (size_t)row * 1024 + 512 + c8) = r;
    }
}
}
namespace att {
typedef short bf16x8 __attribute__((ext_vector_type(8)));
typedef short s16x4 __attribute__((ext_vector_type(4)));
typedef float f32x16 __attribute__((ext_vector_type(16)));
typedef unsigned u32x4 __attribute__((ext_vector_type(4)));
typedef float f32x2_t __attribute__((ext_vector_type(2))); typedef __bf16 bf16x2_t __attribute__((ext_vector_type(2)));
constexpr int NSLOT = 3, SLOTB = 8192, MSLOTB = 2048;
constexpr int LDS_K = 0, LDS_V = NSLOT * SLOTB, LDS_M = 2 * NSLOT * SLOTB, LDS_WS = LDS_M + NSLOT * MSLOTB, LDS_OST = LDS_WS + 8 * 64 * 4, LDS_END = LDS_OST + 8 * 4096;
static_assert(LDS_END <= RING_BYTES, "attention LDS map");
__device__ __forceinline__ int lane_now() { int l; asm volatile("v_mbcnt_lo_u32_b32 %0, -1, 0\n\tv_mbcnt_hi_u32_b32 %0, -1, %0" : "=v"(l)); return l; }
__device__ __forceinline__ int crow(int r, int hi) { return (r & 3) + 8 * (r >> 2) + 4 * hi; }
__device__ __forceinline__ void glds16(const void* gsrc, unsigned lds_dst) { unsigned keep;
    asm volatile("s_mov_b32 %0, m0\n\ts_mov_b32 m0, %2\n\ts_nop 0\n\tglobal_load_lds_dwordx4 %1, off\n\ts_mov_b32 m0, %0" : "=&s"(keep) : "v"(gsrc), "s"(lds_dst) : "memory"); }
__device__ __forceinline__ void glds4(const void* gsrc, unsigned lds_dst) { unsigned keep;
    asm volatile("s_mov_b32 %0, m0\n\ts_mov_b32 m0, %2\n\ts_nop 0\n\tglobal_load_lds_dword %1, off\n\ts_mov_b32 m0, %0" : "=&s"(keep) : "v"(gsrc), "s"(lds_dst) : "memory"); }
__device__ __forceinline__ unsigned cvtpk(float lo, float hi) { f32x2_t v = {lo, hi}; bf16x2_t b = __builtin_convertvector(v, bf16x2_t); return __builtin_bit_cast(unsigned, b); }
#define ATT_WAIT_BAR(N) asm volatile("s_waitcnt vmcnt(" #N ") lgkmcnt(0)\n\ts_barrier" ::: "memory")
#define ATT_SBAR() __builtin_amdgcn_sched_barrier(0)
__device__ __forceinline__ void pv(f32x16* o, int vb, bf16x8 pa0, bf16x8 pa1, bf16x8 pa2, bf16x8 pa3) {
#pragma unroll
    for (int d0 = 0; d0 < 2; ++d0) { s16x4 lo[4], hi[4];
#pragma unroll
        for (int ks = 0; ks < 4; ++ks) {
            asm volatile("ds_read_b64_tr_b16 %0,%1 offset:%c2" : "=&v"(lo[ks]) : "v"(vb), "i"(d0 * 4096 + ks * 1024) : "memory");
            asm volatile("ds_read_b64_tr_b16 %0,%1 offset:%c2" : "=&v"(hi[ks]) : "v"(vb), "i"(d0 * 4096 + ks * 1024 + 512) : "memory"); }
        asm volatile("s_waitcnt lgkmcnt(0)" ::: "memory"); ATT_SBAR();
#define ATT_PK(k) (bf16x8){lo[k][0], lo[k][1], lo[k][2], lo[k][3], hi[k][0], hi[k][1], hi[k][2], hi[k][3]}
        o[d0] = __builtin_amdgcn_mfma_f32_32x32x16_bf16(pa0, ATT_PK(0), o[d0], 0, 0, 0);
        o[d0] = __builtin_amdgcn_mfma_f32_32x32x16_bf16(pa1, ATT_PK(1), o[d0], 0, 0, 0);
        o[d0] = __builtin_amdgcn_mfma_f32_32x32x16_bf16(pa2, ATT_PK(2), o[d0], 0, 0, 0);
        o[d0] = __builtin_amdgcn_mfma_f32_32x32x16_bf16(pa3, ATT_PK(3), o[d0], 0, 0, 0);
#undef ATT_PK
    }
}
__device__ __forceinline__ void attn_unit(const int b, const int h, const int qb, const bf16* __restrict__ Q, const bf16* __restrict__ K, const bf16* __restrict__ V,
                                          const unsigned long long* __restrict__ MASK, bf16* __restrict__ O, LAS unsigned char* shm, const int wid) {
    const int lane = lane_now(), r32 = lane & 31, hi = lane >> 5;
    const size_t rowbase = (size_t)b * SEQ; const int q0 = qb * 256;
    const bf16* Qw = Q + (rowbase + q0 + wid * 32) * 512 + h * 64;
    const bf16* Kh = K + rowbase * 512 + h * 64; const bf16* Vh = V + rowbase * 512 + h * 64;
    const unsigned lds0 = (unsigned)(uintptr_t)shm;
    LAS float* wsf = (LAS float*)(shm + LDS_WS) + wid * 64;
    const bf16* ksrc = Kh + (size_t)lane * 512 + wid * 8;
    const bf16* vsrc = Vh + (size_t)(16 * (wid & 3) + (lane >> 2)) * 512 + (wid >> 2) * 32 + (lane & 3) * 8;
    const unsigned* msrc = (const unsigned*)(MASK + ((size_t)b * 64 * SEQ + q0 + wid * 32)) + lane;
    const unsigned kdst = lds0 + LDS_K + wid * 1024, vdst = lds0 + LDS_V + wid * 1024, mdst = lds0 + LDS_M + wid * 256;
#define ATT_DMA(t, slot) do { glds4(msrc + (size_t)(t) * (SEQ * 2), (unsigned)__builtin_amdgcn_readfirstlane(mdst + (slot) * MSLOTB)); \
        glds16(ksrc + (size_t)(t) * 64 * 512, (unsigned)__builtin_amdgcn_readfirstlane(kdst + (slot) * SLOTB)); \
        glds16(vsrc + (size_t)(t) * 64 * 512, (unsigned)__builtin_amdgcn_readfirstlane(vdst + (slot) * SLOTB)); } while (0)
    const int vb0 = (int)(lds0 + LDS_V) + ((lane >> 4) & 1) * 32 + (lane & 3) * 8 + (4 * hi + ((lane & 15) >> 2)) * 64;
    const int NT = (q0 + 256) / 64;
    bf16x8 qr[4];
#pragma unroll
    for (int d0 = 0; d0 < 4; ++d0) qr[d0] = *(const bf16x8*)(Qw + (size_t)r32 * 512 + d0 * 16 + hi * 8);
    asm volatile("s_waitcnt vmcnt(0)" : "+v"(qr[0]), "+v"(qr[1]), "+v"(qr[2]), "+v"(qr[3]) :: "memory");
    ATT_DMA(0, 0); ATT_DMA(1, 1);
    float m_run = -1e30f, l_run = 0.f; f32x16 o[2]; o[0] = f32x16{}; o[1] = f32x16{};
    int slot = 0;
#pragma unroll 1
    for (int t = 0; t < NT; ++t) {
        if (t + 1 < NT) ATT_WAIT_BAR(3); else ATT_WAIT_BAR(0);
        if (t + 2 < NT) { const int s2 = (slot == 0) ? 2 : slot - 1; ATT_DMA(t + 2, s2); }
        f32x16 p0, p1;
        { const LAS unsigned char* kb = shm + LDS_K + slot * SLOTB + hi * 1024 + r32 * 16;
#pragma unroll
          for (int d0 = 0; d0 < 4; ++d0) {
              const bf16x8 b0 = *(const LAS bf16x8*)(kb + d0 * 2048), b1 = *(const LAS bf16x8*)(kb + d0 * 2048 + 512);
              if (d0 == 0) { p0 = __builtin_amdgcn_mfma_f32_32x32x16_bf16(b0, qr[0], f32x16{}, 0, 0, 0); p1 = __builtin_amdgcn_mfma_f32_32x32x16_bf16(b1, qr[0], f32x16{}, 0, 0, 0); }
              else { p0 = __builtin_amdgcn_mfma_f32_32x32x16_bf16(b0, qr[d0], p0, 0, 0, 0); p1 = __builtin_amdgcn_mfma_f32_32x32x16_bf16(b1, qr[d0], p1, 0, 0, 0); } } }
        const unsigned long long mw = *(const LAS unsigned long long*)(shm + LDS_M + slot * MSLOTB + wid * 256 + r32 * 8);
        const unsigned mlo = (unsigned)mw >> (4 * hi), mhi = (unsigned)(mw >> 32) >> (4 * hi);
#pragma unroll
        for (int r = 0; r < 16; ++r) { const int pos = (r & 3) + 8 * (r >> 2);
            p0[r] = ((mlo >> pos) & 1u) ? p0[r] : -INFINITY; p1[r] = ((mhi >> pos) & 1u) ? p1[r] : -INFINITY; }
        float rm = fmaxf(p0[0], p1[0]);
#pragma unroll
        for (int r = 1; r < 16; ++r) rm = fmaxf(rm, fmaxf(p0[r], p1[r]));
        { auto rr = __builtin_amdgcn_permlane32_swap(__float_as_uint(rm), __float_as_uint(rm), false, false); rm = fmaxf(__uint_as_float(rr[0]), __uint_as_float(rr[1])); }
        const float m_new = fmaxf(m_run, rm);
        const float alpha = __builtin_amdgcn_exp2f(m_run - m_new);
        m_run = m_new;
        float sacc = 0.f;
#pragma unroll
        for (int r = 0; r < 16; ++r) { p0[r] = __builtin_amdgcn_exp2f(p0[r] - m_new); p1[r] = __builtin_amdgcn_exp2f(p1[r] - m_new); sacc += p0[r] + p1[r]; }
        l_run = l_run * alpha + sacc;
        if (!__all(alpha == 1.0f)) {
            if (hi == 0) wsf[r32] = alpha;
            asm volatile("s_waitcnt lgkmcnt(0)" ::: "memory");
#pragma unroll
            for (int r = 0; r < 16; ++r) { const float a = wsf[crow(r, hi)]; o[0][r] *= a; o[1][r] *= a; }
        }
        u32x4 pw0, pw1, pw2, pw3;
        pw0 = (u32x4){cvtpk(p0[0], p0[1]), cvtpk(p0[2], p0[3]), cvtpk(p0[4], p0[5]), cvtpk(p0[6], p0[7])};
        pw1 = (u32x4){cvtpk(p0[8], p0[9]), cvtpk(p0[10], p0[11]), cvtpk(p0[12], p0[13]), cvtpk(p0[14], p0[15])};
        pw2 = (u32x4){cvtpk(p1[0], p1[1]), cvtpk(p1[2], p1[3]), cvtpk(p1[4], p1[5]), cvtpk(p1[6], p1[7])};
        pw3 = (u32x4){cvtpk(p1[8], p1[9]), cvtpk(p1[10], p1[11]), cvtpk(p1[12], p1[13]), cvtpk(p1[14], p1[15])};
        ATT_SBAR();
        pv(o, vb0 + slot * SLOTB, __builtin_bit_cast(bf16x8, pw0), __builtin_bit_cast(bf16x8, pw1), __builtin_bit_cast(bf16x8, pw2), __builtin_bit_cast(bf16x8, pw3));
        slot = (slot == NSLOT - 1) ? 0 : slot + 1;
    }
    { auto rr = __builtin_amdgcn_permlane32_swap(__float_as_uint(l_run), __float_as_uint(l_run), false, false); l_run = __uint_as_float(rr[0]) + __uint_as_float(rr[1]); }
    if (hi == 0) wsf[32 + r32] = l_run;
    asm volatile("s_waitcnt lgkmcnt(0)" ::: "memory");
    float rli[16];
#pragma unroll
    for (int r = 0; r < 16; ++r) rli[r] = 1.0f / wsf[32 + crow(r, hi)];
    bf16* Ow = O + (rowbase + q0 + wid * 32) * 1024 + h * 64;
    { LAS bf16* stg = (LAS bf16*)(shm + LDS_OST) + wid * 2048;
#pragma unroll
      for (int r = 0; r < 16; ++r) { const int orow = crow(r, hi);
#pragma unroll
          for (int d0 = 0; d0 < 2; ++d0) stg[orow * 64 + d0 * 32 + r32] = (bf16)f2bf(o[d0][r] * rli[r]); }
      asm volatile("s_waitcnt lgkmcnt(0)" ::: "memory");
#pragma unroll
      for (int i = 0; i < 4; ++i) { const int row = i * 8 + (lane >> 3), ch = lane & 7; const u32x4 v = *(const LAS u32x4*)(stg + row * 64 + ch * 8); *(u32x4*)(Ow + (size_t)row * 1024 + ch * 8) = v; } }
    asm volatile("s_waitcnt vmcnt(0) lgkmcnt(0)\n\ts_barrier" ::: "memory");
#undef ATT_DMA
}
#undef ATT_WAIT_BAR
#undef ATT_SBAR
}
struct Args { const float* in[11]; float* out; unsigned char* ws; };

#define XB_TMO      128
#define XB_XCNT(j)  (256  + 64 * (j))
#define XB_XSUB(j)  (1280 + 64 * (j))
#define XB_XGEN(j)  (2304 + 64 * (j))
#define XB_TOP      3328
#define XB_TOPGEN   3392
#define XCD_BAR_WORDS 3456
#define XB_SPIN_CAP (1u << 18)

__device__ __forceinline__ unsigned xb_ld(unsigned* p)              { return __hip_atomic_load(p, __ATOMIC_RELAXED, __HIP_MEMORY_SCOPE_AGENT); }
__device__ __forceinline__ unsigned xb_add(unsigned* p, unsigned v) { return __hip_atomic_fetch_add(p, v, __ATOMIC_RELAXED, __HIP_MEMORY_SCOPE_AGENT); }
__device__ __forceinline__ unsigned xb_xcc_id() { return (unsigned)__builtin_amdgcn_s_getreg((3 << 11) | 20) & 0xFu; }
#define XB_SPIN(cond, bar) do { unsigned _sp = 0; while (cond) { __builtin_amdgcn_s_sleep(1); \
    if ((++_sp & 255u) == 0u) { if (xb_ld(&(bar)[XB_TMO])) break; if (_sp > XB_SPIN_CAP) { atomicAdd(&(bar)[XB_TMO], 1u); break; } } } } while (0)

struct XcdBarrier {
    unsigned* bar; unsigned x;
    volatile LAS unsigned* st;
};

__device__ __forceinline__ XcdBarrier xcd_barrier_post(unsigned* bar, volatile LAS unsigned* st, const int wave) {
    XcdBarrier b; b.bar = bar; b.x = xb_xcc_id(); b.st = st;
    if (wave == 0 && pg8::lane_now() == 0) (void)xb_add(&bar[XB_XCNT(b.x)], 1u);
    return b;
}
__device__ __forceinline__ void xcd_barrier_complete(unsigned* bar, unsigned x, unsigned& nloc, unsigned& nx) {
    const unsigned G = gridDim.x * gridDim.y * gridDim.z;
    unsigned sum, cnt, mine, sp = 0u;
    for (;;) {
        sum = 0u; cnt = 0u; mine = 0u;
#pragma unroll
        for (unsigned j = 0; j < 16; ++j) { const unsigned c = xb_ld(&bar[XB_XCNT(j)]); sum += c; cnt += (c > 0u) ? 1u : 0u; mine = (j == x) ? c : mine; }
        if (sum == G) break;
        __builtin_amdgcn_s_sleep(1);
        if ((++sp & 255u) == 0u) { if (xb_ld(&bar[XB_TMO])) break; if (sp > XB_SPIN_CAP) { atomicAdd(&bar[XB_TMO], 1u); break; } }
    }
    nloc = mine > 0u ? mine : 1u; nx = cnt > 0u ? cnt : 1u;
}

__device__ __forceinline__ void xcd_barrier(const XcdBarrier& b, const int wave) {
    asm volatile("s_waitcnt vmcnt(0)" ::: "memory");
    __syncthreads();
    if (wave == 0 && pg8::lane_now() == 0) {
        unsigned* bar = b.bar;
        __builtin_amdgcn_s_waitcnt(0);
        unsigned nloc = b.st[0], nx = b.st[1];
        if (nloc == 0u) { xcd_barrier_complete(bar, b.x, nloc, nx); b.st[0] = nloc; b.st[1] = nx; }
        const unsigned old = xb_add(&bar[XB_XSUB(b.x)], 1u);
        const unsigned gen = old / nloc;
        if (old + 1u == (gen + 1u) * nloc) {
            __builtin_amdgcn_fence(__ATOMIC_RELEASE, "agent");
            asm volatile("s_waitcnt vmcnt(0)" ::: "memory");
            const unsigned og = xb_add(&bar[XB_TOP], 1u);
            const unsigned tg = og / nx;
            if (og + 1u == (tg + 1u) * nx) xb_add(&bar[XB_TOPGEN], 1u);
            else XB_SPIN(xb_ld(&bar[XB_TOPGEN]) == tg, bar);
            __builtin_amdgcn_fence(__ATOMIC_ACQUIRE, "agent");
            xb_add(&bar[XB_XGEN(b.x)], 1u);
            asm volatile("s_waitcnt vmcnt(0)" ::: "memory");
        } else {
            XB_SPIN(xb_ld(&bar[XB_XGEN(b.x)]) == gen, bar);
            __builtin_amdgcn_fence(__ATOMIC_ACQUIRE, "agent");
            asm volatile("s_waitcnt vmcnt(0)" ::: "memory");
        }
    }
    __syncthreads();
}

__device__ __forceinline__ void p0_prologue(const Args& a, LAS unsigned char* lds, int wave, int lane, int vcu, int G) {
    unsigned char* ws = a.ws;
    LAS float* scr = (LAS float*)(lds + RING_OFF + wave * 16384);
    const int gw = vcu * NWAVES + wave, NGW = G * NWAVES;
    constexpr int I_IN = 16 * (NPALL / 32), I_AO = 8 * 32, I_CO = 8 * 32, I_MX = 16 * 32, I_UP = 16 * 128, I_DN = 64 * 32;
    constexpr int I_LAYER = I_IN + I_AO + I_CO + I_MX + I_UP + I_DN;
    for (int it = gw; it < DEPTH * I_LAYER; it += NGW) {
        const int l = it / I_LAYER; int r = it % I_LAYER;
        if (r < I_IN) { const int nb = r % (NPALL / 32), kb = r / (NPALL / 32);
            transpose_item<true>(a.in[2] + (size_t)l * D_MODEL * IN_COLS, IN_COLS, (bf16*)(ws + WS_WIN) + (size_t)l * NPALL * 1024, 1024, 0, kb * 64, nb * 32, scr, lane); continue; } r -= I_IN;
        if (r < I_AO) { const int nb = r % 32, kb = r / 32;
            transpose_item<false>(a.in[4] + (size_t)l * 512 * 1024, 1024, (bf16*)(ws + WS_WOC) + (size_t)l * 1024 * 1024, 1024, 0, kb * 64, nb * 32, scr, lane); continue; } r -= I_AO;
        if (r < I_CO) { const int nb = r % 32, kb = r / 32;
            transpose_item<false>(a.in[5] + (size_t)l * 512 * 1024, 1024, (bf16*)(ws + WS_WOC) + (size_t)l * 1024 * 1024, 1024, 512, kb * 64, nb * 32, scr, lane); continue; } r -= I_CO;
        if (r < I_MX) { const int nb = r % 32, kb = r / 32;
            transpose_item<false>(a.in[6] + (size_t)l * 1024 * 1024, 1024, (bf16*)(ws + WS_WMIX) + (size_t)l * 1024 * 1024, 1024, 0, kb * 64, nb * 32, scr, lane); continue; } r -= I_MX;
        if (r < I_UP) { const int nb = r % 128, kb = r / 128;
            transpose_item<false>(a.in[8] + (size_t)l * 1024 * 4096, 4096, (bf16*)(ws + WS_WUP) + (size_t)l * 4096 * 1024, 1024, 0, kb * 64, nb * 32, scr, lane); continue; } r -= I_UP;
        { const int nb = r % 32, kb = r / 32;
            transpose_item<false>(a.in[9] + (size_t)l * 4096 * 1024, 1024, (bf16*)(ws + WS_WDN) + (size_t)l * 1024 * 4096, 4096, 0, kb * 64, nb * 32, scr, lane); }
    }
    float* cs = (float*)(ws + WS_CS);
    for (int i = gw * 64 + lane; i < SEQ * 8; i += NGW * 64) { const int t = i >> 3, j = i & 7; float s, c; sincos_acc((float)t * rope_inv(j), s, c); cs[i] = c; cs[SEQ * 8 + i] = s; }
    for (int m = gw; m < MROWS; m += NGW) xg_row(a.in[0] + (size_t)m * D_MODEL, a.in[1], (bf16*)(ws + WS_XG) + (size_t)m * D_MODEL, (float*)(ws + WS_ROWSQ), m, lane);
}

constexpr int CW_BAR = 4096;
static_assert((CW_BAR + XCD_BAR_WORDS) * 4 <= 65536, "barrier words inside the per-call memset");
__global__ void __launch_bounds__(NWAVES * 64, 2) mk_fwd(Args args) {
    extern __shared__ __attribute__((aligned(16))) unsigned char lds_raw[];
    LAS unsigned char* lds = (LAS unsigned char*)lds_raw;
    const int wave = __builtin_amdgcn_readfirstlane(threadIdx.x >> 6);
#define lane (pg8::lane_now())
    const int G = gridDim.x; const int bx = blockIdx.x; const int vcu = (G % 8 == 0) ? (bx % 8) * (G / 8) + bx / 8 : bx;
    unsigned char* ws = args.ws;
    if (wave == 0) ((LAS unsigned*)(lds + MISC_OFF))[lane] = 0u;
    __syncthreads();
    const XcdBarrier bar = xcd_barrier_post((unsigned*)(ws + WS_CTL) + CW_BAR, (volatile LAS unsigned*)(lds + MISC_OFF) + 8, wave);
#define GRID_BAR() xcd_barrier(bar, wave)
    p0_prologue(args, lds, wave, lane, vcu, G);
    GRID_BAR();
#pragma unroll 1
    for (int L = 0; L < DEPTH; ++L) {
    {
        pg8::Gemm g{(const bf16*)(ws + WS_XG), (const bf16*)(ws + WS_WIN) + (size_t)L * NPALL * 1024, MROWS, NP1, D_MODEL};
        pg8::StaticOrder S; S.init(MROWS, NP1, G, (int)blockIdx.x);
        pg8::EpiProj E{(const float*)(ws + WS_ROWSQ), (const float*)(ws + WS_CS), (bf16*)(ws + WS_Q), (bf16*)(ws + WS_K), (bf16*)(ws + WS_V), (bf16*)(ws + WS_IQ), (bf16*)(ws + WS_IK),
                       (bf16*)(ws + WS_CB), (bf16*)(ws + WS_P), (float*)(ws + WS_IW)};
        pg8::gemm_phase<pg8::EpiProj, pg8::StaticOrder, true, true>(lds + RING_OFF, g, S, E, wave);
    }
    GRID_BAR();
    {
        for (int id = vcu; id < 512; id += G) { const int b = id >> 7, p = id & 127;
            sel::sel_unit(lds, b, 255 - p, (const bf16*)(ws + WS_IQ), (const bf16*)(ws + WS_IK), (const float*)(ws + WS_IW), (unsigned long long*)(ws + WS_MASK), wave);
            sel::sel_unit(lds, b, p, (const bf16*)(ws + WS_IQ), (const bf16*)(ws + WS_IK), (const float*)(ws + WS_IW), (unsigned long long*)(ws + WS_MASK), wave); }
        for (int rb = vcu * 64; rb < MROWS; rb += G * 64)
            sel::convmid_rows((const bf16*)(ws + WS_CB), (const bf16*)(ws + WS_P), args.in[3] + (size_t)L * 3 * 512, (bf16*)(ws + WS_A2), rb, wave);
    }
    GRID_BAR();
    {
        for (int u = vcu; u < 512; u += G) { const int bh = (u & 255) >> 3, s = u & 7, qb = (u >> 8) ? s : 15 - s;
            att::attn_unit(bh >> 3, bh & 7, qb, (const bf16*)(ws + WS_Q), (const bf16*)(ws + WS_K), (const bf16*)(ws + WS_V), (const unsigned long long*)(ws + WS_MASK), (bf16*)(ws + WS_A2), lds, wave); }
    }
    GRID_BAR();
    {
        pg8::Gemm g{(const bf16*)(ws + WS_XG), (const bf16*)(ws + WS_WIN) + (size_t)L * NPALL * 1024 + (size_t)NP1 * 1024, MROWS, NPG, D_MODEL};
        pg8::StaticOrder S; S.init(MROWS, NPG, G, (int)blockIdx.x);
        pg8::EpiSig E{(const float*)(ws + WS_ROWSQ), (bf16*)(ws + WS_SG)};
        pg8::gemm_phase<pg8::EpiSig, pg8::StaticOrder, true, true>(lds + RING_OFF, g, S, E, wave);
    }
    GRID_BAR();
    {
        pg8::Gemm g{(const bf16*)(ws + WS_A2), (const bf16*)(ws + WS_WOC) + (size_t)L * 1024 * 1024, MROWS, D_MODEL, 1024};
        pg8::StaticOrder S; S.init(MROWS, D_MODEL, G, (int)blockIdx.x);
        pg8::EpiMerged E{(const bf16*)(ws + WS_SG), (bf16*)(ws + WS_MERGED)};
        pg8::gemm_phase<pg8::EpiMerged, pg8::StaticOrder, true, true>(lds + RING_OFF, g, S, E, wave);
    }
    GRID_BAR();
    {
        pg8::Gemm g{(const bf16*)(ws + WS_MERGED), (const bf16*)(ws + WS_WMIX) + (size_t)L * 1024 * 1024, MROWS, D_MODEL, 1024};
        pg8::StaticOrder S; S.init(MROWS, D_MODEL, G, (int)blockIdx.x);
        pg8::EpiResid E{L == 0 ? args.in[0] : args.out, args.out, (bf16*)(ws + WS_XG), args.in[7] + L * D_MODEL, (float*)(ws + WS_ROWSQ)};
        pg8::gemm_phase<pg8::EpiResid, pg8::StaticOrder, false, true>(lds + RING_OFF, g, S, E, wave);
    }
    GRID_BAR();
    {
        pg8::Gemm g{(const bf16*)(ws + WS_XG), (const bf16*)(ws + WS_WUP) + (size_t)L * 4096 * 1024, MROWS, MLP_H, D_MODEL};
        pg8::StaticOrder S; S.init(MROWS, MLP_H, G, (int)blockIdx.x);
        pg8::EpiRelu2 E{(const float*)(ws + WS_ROWSQ), (bf16*)(ws + WS_H)};
        pg8::gemm_phase<pg8::EpiRelu2, pg8::StaticOrder, true, true>(lds + RING_OFF, g, S, E, wave);
    }
    GRID_BAR();
    {
        pg8::Gemm g{(const bf16*)(ws + WS_H), (const bf16*)(ws + WS_WDN) + (size_t)L * 1024 * 4096, MROWS, D_MODEL, MLP_H};
        pg8::StaticOrder S; S.init(MROWS, D_MODEL, G, (int)blockIdx.x);
        pg8::EpiResid E{args.out, args.out, (bf16*)(ws + WS_XG), (L + 1 < DEPTH) ? args.in[1] + (L + 1) * D_MODEL : (const float*)nullptr, (float*)(ws + WS_ROWSQ)};
        pg8::gemm_phase<pg8::EpiResid, pg8::StaticOrder, false, true>(lds + RING_OFF, g, S, E, wave);
    }
    GRID_BAR();
    }
    {
        const float* rowsq = (const float*)(ws + WS_ROWSQ); const float* gf = args.in[10];
        const int gw = vcu * NWAVES + wave, NGW = G * NWAVES;
        for (int m = gw; m < MROWS; m += NGW) {
            const float rs = pg8::row_rstd(rowsq, m);
            GAS f32x4* xr = (GAS f32x4*)(args.out + (size_t)m * D_MODEL) + lane; const GAS f32x4* gr = (const GAS f32x4*)gf + lane;
#pragma unroll
            for (int j = 0; j < 4; ++j) { const f32x4 v = xr[64 * j], gg = gr[64 * j]; xr[64 * j] = v * rs * gg; }
        }
    }
#undef GRID_BAR
#undef lane
}

extern "C" void kernel_launch(void* const* d_in, const int* in_sizes, int n_in, void* d_out, int out_size, void* d_ws, size_t ws_size, hipStream_t stream) {
    static int grid = 0;
    if (grid == 0) {
        int dev = 0, cus = 0, per_cu = 0;
        if (n_in != 11 || out_size != MROWS * D_MODEL || ws_size < WS_END) { fprintf(stderr, "kernel_launch: unexpected problem shape / workspace (%d inputs, out %d, ws %zu)\n", n_in, out_size, ws_size); grid = -1; return; }
        if (hipGetDevice(&dev) != hipSuccess || hipDeviceGetAttribute(&cus, hipDeviceAttributeMultiprocessorCount, dev) != hipSuccess) { grid = -1; return; }
        if (hipFuncSetAttribute((const void*)mk_fwd, hipFuncAttributeMaxDynamicSharedMemorySize, LDS_BYTES) != hipSuccess) { fprintf(stderr, "kernel_launch: hipFuncSetAttribute failed\n"); grid = -1; return; }
        if (hipOccupancyMaxActiveBlocksPerMultiprocessor(&per_cu, (const void*)mk_fwd, NWAVES * 64, LDS_BYTES) != hipSuccess || per_cu < 1) { fprintf(stderr, "kernel_launch: the occupancy query admits %d workgroups per CU; nothing launched\n", per_cu); grid = -1; return; }
        (void)hipGetLastError();
        grid = cus;
    }
    if (grid < 0) return;
    if (hipMemsetAsync((char*)d_ws + WS_CTL, 0, 65536, stream) != hipSuccess) { fprintf(stderr, "kernel_launch: hipMemsetAsync failed\n"); return; }
    Args a{};
    for (int i = 0; i < 11; ++i) a.in[i] = (const float*)d_in[i];
    a.out = (float*)d_out; a.ws = (unsigned char*)d_ws;
    hipLaunchKernelGGL(mk_fwd, dim3(grid), dim3(NWAVES * 64), LDS_BYTES, stream, a);
}
```

```cpp
#include <hip/hip_runtime.h>
#include <stdint.h>
#include <math.h>
#include <cstdio>

#define D_MODEL 1024
#define BATCH 4
#define SEQ 4096
#define MROWS 16384
#define DEPTH 2
#define IN_COLS 5444
#define MLP_H 4096
#define OFF_Q 0
#define OFF_K 512
#define OFF_V 1024
#define OFF_IQ 1536
#define OFF_IK 1792
#define OFF_IW 1856
#define OFF_CB 1860
#define OFF_CC 2372
#define OFF_CH 2884
#define OFF_G 3396
#define NP1 3584
#define NPG 2048
#define NPALL 5632
#define C2F 0.18033688011112042f

typedef unsigned short bf16;
#define LAS __attribute__((address_space(3)))
#define GAS __attribute__((address_space(1)))
__device__ __forceinline__ unsigned f2bf(float f) { unsigned u = __builtin_bit_cast(unsigned, f); return (u + 0x7fffu + ((u >> 16) & 1u)) >> 16; }
__device__ __forceinline__ unsigned pk2(float lo, float hi) { return f2bf(lo) | (f2bf(hi) << 16); }
__device__ __forceinline__ float bf2f(unsigned short b) { return __builtin_bit_cast(float, ((unsigned)b) << 16); }

constexpr size_t MiB = 1u << 20;
constexpr size_t WS_CTL = 0, CTL_ZERO_BYTES = 1 * MiB;
constexpr size_t WS_CS = 1 * MiB;
constexpr size_t WS_ROWSQ = 1 * MiB + 512 * 1024;
constexpr size_t WS_IW = 1 * MiB + 768 * 1024;
constexpr size_t WS_WIN = 2 * MiB;
constexpr size_t WS_WOC = 24 * MiB;
constexpr size_t WS_WMIX = 28 * MiB;
constexpr size_t WS_WUP = 32 * MiB;
constexpr size_t WS_WDN = 48 * MiB;
constexpr size_t WS_XG = 64 * MiB;
constexpr size_t WS_Q = 96 * MiB, WS_K = 112 * MiB, WS_V = 128 * MiB;
constexpr size_t WS_IQ = 144 * MiB;
constexpr size_t WS_IK = 152 * MiB;
constexpr size_t WS_MASK = 154 * MiB;
constexpr size_t WS_CB = 162 * MiB, WS_P = 178 * MiB;
constexpr size_t WS_A2 = 194 * MiB;
constexpr size_t WS_SG = 96 * MiB;
constexpr size_t WS_MERGED = 160 * MiB;
constexpr size_t WS_H = 96 * MiB;
constexpr size_t WS_END = 256 * MiB;

namespace pg8 {
#define PG8_LAS __attribute__((address_space(3)))
typedef unsigned short bf16_t;
typedef short bf16x8 __attribute__((ext_vector_type(8)));
typedef float f32x4 __attribute__((ext_vector_type(4)));
typedef unsigned u32x4 __attribute__((ext_vector_type(4)));
constexpr int BM = 256, BK = 64, HALF = 128, HTB = HALF * BK * 2  , STAGE_BYTES = 8 * HTB, NXCD = 8, WGM = 8;

__host__ __device__ __forceinline__ int lds_byte(int r, int c) { const int st = (r >> 4) * 2 + (c >> 5), rr = r & 15, cc = c & 31, ob = rr * 64 + cc * 2; return st * 1024 + (ob ^ (((ob >> 9) & 1) << 5)); }
__host__ __device__ __forceinline__ void stage_rc(int b, int& R, int& C) { const int st = b / 1024, sb = b % 1024, swz = sb ^ (((sb >> 9) & 1) << 5); R = (st >> 1) * 16 + swz / 64; C = (st & 1) * 32 + (swz % 64) / 2; }
__host__ __device__ __forceinline__ int perm32(int rho) { const int n = rho >> 4, i = rho & 15; return 8 * (i >> 2) + 4 * n + (i & 3); }

struct Unit { int pm, pn; };
struct Gemm { const bf16_t* A; const bf16_t* Bt; int M, N, K; };

struct StaticOrder {
    int nM, nN, nwg, G, c;
    __host__ __device__ __forceinline__ void init(int M, int N, int G_, int c_) { nM = M / BM; nN = N / BM; nwg = nM * nN; G = G_; c = c_; }
    __host__ __device__ __forceinline__ bool next(int i, Unit& u) const {
        const long L = (long)i * G + c; if (L >= nwg) return false;
        int wgid = (int)L; { const int q = nwg / NXCD, r = nwg % NXCD, xcd = wgid % NXCD, off = wgid / NXCD; wgid = (xcd < r ? xcd * (q + 1) : r * (q + 1) + (xcd - r) * q) + off; }
        const int nig = WGM * nN, gid = wgid / nig, fm = gid * WGM, gsz = (nM - fm) < WGM ? (nM - fm) : WGM;
        u.pm = fm + ((wgid % nig) % gsz); u.pn = (wgid % nig) / gsz; return true;
    }
    __device__ __forceinline__ void a_ready(const Unit&) const {}
    __device__ __forceinline__ void done(const Unit&) const {}
};
typedef float cvt_f32x2_t __attribute__((ext_vector_type(2))); typedef __bf16 cvt_bf16x2_t __attribute__((ext_vector_type(2)));
__device__ __forceinline__ unsigned cvt_pk_bf16(float lo, float hi) { cvt_f32x2_t v = {lo, hi}; cvt_bf16x2_t b = __builtin_convertvector(v, cvt_bf16x2_t); return __builtin_bit_cast(unsigned, b); }
typedef float f32x2 __attribute__((ext_vector_type(2)));
__device__ __forceinline__ int lane_now() { int l; asm volatile("v_mbcnt_lo_u32_b32 %0, -1, 0\n\tv_mbcnt_hi_u32_b32 %0, -1, %0" : "=v"(l)); return l; }
__device__ __forceinline__ float row_rstd(const float* rowsq, int row) {
    const float s = (rowsq[row] + rowsq[MROWS + row]) + (rowsq[2 * MROWS + row] + rowsq[3 * MROWS + row]);
    return __builtin_amdgcn_rsqf(s * (1.0f / 1024.0f) + 1e-6f);
}
struct EpiProj {
    static constexpr bool PERM = true, AFTER_DRAIN = false, HAS_MID = false;
    const PG8_LAS float* rst; const float* cs; bf16_t *Q, *K, *V, *IQ, *IK, *CB, *P; float* IW;
    __device__ __forceinline__ void operator()(const f32x4 (&acc)[2][2][4][2], const Unit& u, int wr, int wc, int, int) const {
        const int ln_ = lane_now(), fr = ln_ & 15, fq = ln_ >> 4;
        const int pn = u.pn, row0 = u.pm * BM + wr * 64 + fr;
        if (pn == 7) {
            if (wc >= 3) return;
            const bool ropeL = (wc == 0) && (fq < 2);
#pragma unroll
            for (int ai = 0; ai < 2; ++ai)
#pragma unroll
                for (int m = 0; m < 4; ++m) {
                    const int row = row0 + ai * HALF + m * 16; const float rs = rst[row & 255]; const int t = row & (SEQ - 1);
                    const f32x4 v0 = acc[ai][0][m][0] * rs, v1 = acc[ai][0][m][1] * rs;
                    if (wc < 2) {
                        f32x4 c4 = (f32x4){1.f, 1.f, 1.f, 1.f}, s4 = (f32x4){0.f, 0.f, 0.f, 0.f};
                        if (ropeL) { c4 = *(const f32x4*)(cs + t * 8 + 4 * fq); s4 = *(const f32x4*)(cs + SEQ * 8 + t * 8 + 4 * fq); }
                        const f32x4 o0 = v0 * c4 - v1 * s4, o1 = v1 * c4 + v0 * s4;
                        u32x4 w; w.x = cvt_pk_bf16(o0[0], o0[1]); w.y = cvt_pk_bf16(o0[2], o0[3]); w.z = cvt_pk_bf16(o1[0], o1[1]); w.w = cvt_pk_bf16(o1[2], o1[3]);
                        *(u32x4*)(IK + ((size_t)(row >> 4) * 8 + wc * 4 + fq) * 128 + (row & 15) * 8) = w;
                    } else if (fq == 0) {
                        *(f32x4*)(IW + (size_t)row * 4) = v0;
                    }
                }
            return;
        }
        if (pn >= 10) {
#pragma unroll
            for (int ai = 0; ai < 2; ++ai)
#pragma unroll
                for (int m = 0; m < 4; ++m) {
                    const int row = row0 + ai * HALF + m * 16; const float rs = rst[row & 255]; const float rs2 = rs * rs;
#pragma unroll
                    for (int bj = 0; bj < 2; ++bj) {
                        const f32x4 p = acc[ai][bj][m][0] * acc[ai][bj][m][1] * rs2;
                        unsigned long long w = (unsigned long long)cvt_pk_bf16(p[0], p[1]) | ((unsigned long long)cvt_pk_bf16(p[2], p[3]) << 32);
                        *(unsigned long long*)(P + (size_t)row * 512 + (((pn - 10) * 256 + bj * HALF + wc * 32 + 8 * fq) >> 1)) = w;
                    }
                }
            return;
        }
        bf16_t* dst; int pitch, colb; float sc = 1.f; bool rope = false;
        if (pn < 2) { dst = Q; pitch = 512; colb = pn * 256; sc = C2F; rope = true; }
        else if (pn < 4) { dst = K; pitch = 512; colb = (pn - 2) * 256; rope = true; }
        else if (pn < 6) { dst = V; pitch = 512; colb = (pn - 4) * 256; }
        else if (pn == 6) { dst = IQ; pitch = 256; colb = 0; rope = true; }
        else { dst = CB; pitch = 512; colb = (pn - 8) * 256; }
        const bool ropeL = rope && ((wc & 1) == 0) && (fq < 2);
#pragma unroll
        for (int ai = 0; ai < 2; ++ai) {
            f32x4 c4[4], s4[4];
#pragma unroll
            for (int m = 0; m < 4; ++m) { c4[m] = (f32x4){1.f, 1.f, 1.f, 1.f}; s4[m] = (f32x4){0.f, 0.f, 0.f, 0.f}; }
            if (ropeL) {
#pragma unroll
                for (int m = 0; m < 4; ++m) { const int t = (row0 + ai * HALF + m * 16) & (SEQ - 1); c4[m] = *(const f32x4*)(cs + t * 8 + 4 * fq); s4[m] = *(const f32x4*)(cs + SEQ * 8 + t * 8 + 4 * fq); }
            }
            __builtin_amdgcn_sched_barrier(0);
#pragma unroll
            for (int m = 0; m < 4; ++m) {
                const int row = row0 + ai * HALF + m * 16; const float rs = rst[row & 255] * sc;
                bf16_t* rowp = dst + (size_t)row * pitch + colb + wc * 32 + 8 * fq;
#pragma unroll
                for (int bj = 0; bj < 2; ++bj) {
                    const f32x4 v0 = acc[ai][bj][m][0] * rs, v1 = acc[ai][bj][m][1] * rs;
                    const f32x4 o0 = v0 * c4[m] - v1 * s4[m], o1 = v1 * c4[m] + v0 * s4[m];
                    u32x4 w; w.x = cvt_pk_bf16(o0[0], o0[1]); w.y = cvt_pk_bf16(o0[2], o0[3]); w.z = cvt_pk_bf16(o1[0], o1[1]); w.w = cvt_pk_bf16(o1[2], o1[3]);
                    if (pn == 6) *(u32x4*)(IQ + ((size_t)(row >> 4) * 32 + bj * 16 + wc * 4 + fq) * 128 + (row & 15) * 8) = w;
                    else *(u32x4*)(rowp + bj * HALF) = w;
                }
            }
        }
    }
};
struct EpiSig {
    static constexpr bool PERM = true, AFTER_DRAIN = false, HAS_MID = false;
    const PG8_LAS float* rst; bf16_t* SG;
    __device__ __forceinline__ void operator()(const f32x4 (&acc)[2][2][4][2], const Unit& u, int wr, int wc, int, int) const {
        const int ln_ = lane_now(), fr = ln_ & 15, fq = ln_ >> 4;
        const int row0 = u.pm * BM + wr * 64 + fr, col0 = u.pn * HALF + wc * 32 + 8 * fq;
#pragma unroll
        for (int ai = 0; ai < 2; ++ai)
#pragma unroll
            for (int m = 0; m < 4; ++m) {
                const int row = row0 + ai * HALF + m * 16; const float rs = rst[row & 255] * (-1.4426950408889634f);
                bf16_t* rowp = SG + (size_t)row * NPG + col0;
                f32x4 a0 = acc[ai][0][m][0] * rs, a1 = acc[ai][0][m][1] * rs, c0 = acc[ai][1][m][0] * rs, c1 = acc[ai][1][m][1] * rs;
#pragma unroll
                for (int j = 0; j < 4; ++j) {
                    const float ea0 = 1.0f + __builtin_amdgcn_exp2f(a0[j]), ea1 = 1.0f + __builtin_amdgcn_exp2f(a1[j]), ec0 = 1.0f + __builtin_amdgcn_exp2f(c0[j]), ec1 = 1.0f + __builtin_amdgcn_exp2f(c1[j]);
                    a0[j] = ec0 * __builtin_amdgcn_rcpf(ea0); a1[j] = ec1 * __builtin_amdgcn_rcpf(ea1);
                    c0[j] = __builtin_amdgcn_rcpf(ec0); c1[j] = __builtin_amdgcn_rcpf(ec1); }
                u32x4 w; w.x = cvt_pk_bf16(a0[0], a0[1]); w.y = cvt_pk_bf16(a0[2], a0[3]); w.z = cvt_pk_bf16(a1[0], a1[1]); w.w = cvt_pk_bf16(a1[2], a1[3]);
                *(u32x4*)(rowp) = w;
                w.x = cvt_pk_bf16(c0[0], c0[1]); w.y = cvt_pk_bf16(c0[2], c0[3]); w.z = cvt_pk_bf16(c1[0], c1[1]); w.w = cvt_pk_bf16(c1[2], c1[3]);
                *(u32x4*)(rowp + 1024) = w;
            }
    }
};
struct EpiMerged {
    static constexpr bool PERM = true, AFTER_DRAIN = false, HAS_MID = true;
    const bf16_t* SG; bf16_t* O;
    __device__ __forceinline__ void mid(f32x4 (&acc)[2][2][4][2], const Unit& u, int wr, int wc, int, int) const {
        const int ln_ = lane_now(), fr = ln_ & 15, fq = ln_ >> 4;
        const int row0 = u.pm * BM + wr * 64 + fr, col0 = u.pn * BM + wc * 32 + 8 * fq;
#pragma unroll
        for (int ai = 0; ai < 2; ++ai) {
            u32x4 rin[4][2];
#pragma unroll
            for (int m = 0; m < 4; ++m)
#pragma unroll
                for (int bj = 0; bj < 2; ++bj) rin[m][bj] = *(const u32x4*)(SG + (size_t)(row0 + ai * HALF + m * 16) * NPG + col0 + bj * HALF);
            __builtin_amdgcn_sched_barrier(0);
#pragma unroll
            for (int m = 0; m < 4; ++m)
#pragma unroll
                for (int bj = 0; bj < 2; ++bj) {
                    const u32x4 a = rin[m][bj];
#pragma unroll
                    for (int j = 0; j < 4; ++j) {
                        const float r0 = __builtin_bit_cast(float, a[j] << 16), r1 = __builtin_bit_cast(float, a[j] & 0xffff0000u);
                        acc[ai][bj][m][j >> 1][(j & 1) * 2] *= r0; acc[ai][bj][m][j >> 1][(j & 1) * 2 + 1] *= r1;
                    }
                }
        }
    }
    __device__ __forceinline__ void operator()(const f32x4 (&acc)[2][2][4][2], const Unit& u, int wr, int wc, int, int) const {
        const int ln_ = lane_now(), fr = ln_ & 15, fq = ln_ >> 4;
        const int row0 = u.pm * BM + wr * 64 + fr, col0 = u.pn * BM + wc * 32 + 8 * fq;
#pragma unroll
        for (int ai = 0; ai < 2; ++ai) {
            u32x4 cin[4][2];
#pragma unroll
            for (int m = 0; m < 4; ++m)
#pragma unroll
                for (int bj = 0; bj < 2; ++bj) cin[m][bj] = *(const u32x4*)(SG + (size_t)(row0 + ai * HALF + m * 16) * NPG + 1024 + col0 + bj * HALF);
            __builtin_amdgcn_sched_barrier(0);
#pragma unroll
            for (int m = 0; m < 4; ++m) {
                const int row = row0 + ai * HALF + m * 16;
                bf16_t* rowp = O + (size_t)row * 1024 + col0;
#pragma unroll
                for (int bj = 0; bj < 2; ++bj) {
                    const u32x4 c = cin[m][bj];
                    float o[8];
#pragma unroll
                    for (int j = 0; j < 4; ++j) {
                        const float c0 = __builtin_bit_cast(float, c[j] << 16), c1 = __builtin_bit_cast(float, c[j] & 0xffff0000u);
                        o[2 * j] = acc[ai][bj][m][j >> 1][(j & 1) * 2] * c0; o[2 * j + 1] = acc[ai][bj][m][j >> 1][(j & 1) * 2 + 1] * c1;
                    }
                    u32x4 w; w.x = cvt_pk_bf16(o[0], o[1]); w.y = cvt_pk_bf16(o[2], o[3]); w.z = cvt_pk_bf16(o[4], o[5]); w.w = cvt_pk_bf16(o[6], o[7]);
                    *(u32x4*)(rowp + bj * HALF) = w;
                }
            }
        }
    }
};
struct EpiRelu2 {
    static constexpr bool PERM = true, AFTER_DRAIN = false, HAS_MID = false;
    const PG8_LAS float* rst; bf16_t* O;
    __device__ __forceinline__ void operator()(const f32x4 (&acc)[2][2][4][2], const Unit& u, int wr, int wc, int, int) const {
        const int ln_ = lane_now(), fr = ln_ & 15, fq = ln_ >> 4;
        const int row0 = u.pm * BM + wr * 64 + fr, col0 = u.pn * BM + wc * 32 + 8 * fq;
#pragma unroll
        for (int ai = 0; ai < 2; ++ai)
#pragma unroll
            for (int m = 0; m < 4; ++m) {
                const int row = row0 + ai * HALF + m * 16; const float rs = rst[row & 255];
                bf16_t* rowp = O + (size_t)row * MLP_H + col0;
#pragma unroll
                for (int bj = 0; bj < 2; ++bj) {
                    f32x4 v0 = acc[ai][bj][m][0] * rs, v1 = acc[ai][bj][m][1] * rs;
#pragma unroll
                    for (int j = 0; j < 4; ++j) { const float a = fmaxf(v0[j], 0.f), b = fmaxf(v1[j], 0.f); v0[j] = a * a; v1[j] = b * b; }
                    u32x4 w; w.x = cvt_pk_bf16(v0[0], v0[1]); w.y = cvt_pk_bf16(v0[2], v0[3]); w.z = cvt_pk_bf16(v1[0], v1[1]); w.w = cvt_pk_bf16(v1[2], v1[3]);
                    *(u32x4*)(rowp + bj * HALF) = w;
                }
            }
    }
};
struct EpiResid {
    static constexpr bool PERM = true, AFTER_DRAIN = true, HAS_MID = false;
    bf16_t* xb; float* outf; float* rowsq; const float* gfin; unsigned* pcnt; int same_xcc;
    __device__ __forceinline__ void fused(f32x4 (&acc)[2][2][4][2], const Unit& u, int wr, int wc, int, int, PG8_LAS unsigned char* lds, int wid, int) const {
        const int lane = lane_now(), fr = lane & 15, fq = lane >> 4;
        PG8_LAS float* Pt = (PG8_LAS float*)lds;
        const int col0 = u.pn * BM + wc * 32 + 8 * fq;
        const bool last = (outf != nullptr);
#pragma unroll
        for (int ai = 0; ai < 2; ++ai) {
        u32x4 xin[4][2];
#pragma unroll
        for (int m = 0; m < 4; ++m)
#pragma unroll
            for (int bj = 0; bj < 2; ++bj) xin[m][bj] = *(const u32x4*)(xb + (size_t)(u.pm * BM + ai * HALF + wr * 64 + m * 16 + fr) * D_MODEL + col0 + bj * HALF);
        __builtin_amdgcn_sched_barrier(0);
#pragma unroll
            for (int m = 0; m < 4; ++m) {
                const int r = ai * HALF + wr * 64 + m * 16 + fr; const size_t off = (size_t)(u.pm * BM + r) * D_MODEL + col0; float s = 0.f;
#pragma unroll
                for (int bj = 0; bj < 2; ++bj) {
                    const u32x4 b = xin[m][bj];
                    f32x4 x0, x1;
                    x0[0] = __builtin_bit_cast(float, b[0] << 16); x0[1] = __builtin_bit_cast(float, b[0] & 0xffff0000u); x0[2] = __builtin_bit_cast(float, b[1] << 16); x0[3] = __builtin_bit_cast(float, b[1] & 0xffff0000u);
                    x1[0] = __builtin_bit_cast(float, b[2] << 16); x1[1] = __builtin_bit_cast(float, b[2] & 0xffff0000u); x1[2] = __builtin_bit_cast(float, b[3] << 16); x1[3] = __builtin_bit_cast(float, b[3] & 0xffff0000u);
                    x0 = x0 + acc[ai][bj][m][0]; x1 = x1 + acc[ai][bj][m][1];
                    if (last) { acc[ai][bj][m][0] = x0; acc[ai][bj][m][1] = x1; }
                    else { u32x4 w; w[0] = cvt_pk_bf16(x0[0], x0[1]); w[1] = cvt_pk_bf16(x0[2], x0[3]); w[2] = cvt_pk_bf16(x1[0], x1[1]); w[3] = cvt_pk_bf16(x1[2], x1[3]);
                        *(u32x4*)(xb + off + bj * HALF) = w;
                        x0[0] = __builtin_bit_cast(float, w[0] << 16); x0[1] = __builtin_bit_cast(float, w[0] & 0xffff0000u); x0[2] = __builtin_bit_cast(float, w[1] << 16); x0[3] = __builtin_bit_cast(float, w[1] & 0xffff0000u);
                        x1[0] = __builtin_bit_cast(float, w[2] << 16); x1[1] = __builtin_bit_cast(float, w[2] & 0xffff0000u); x1[2] = __builtin_bit_cast(float, w[3] << 16); x1[3] = __builtin_bit_cast(float, w[3] & 0xffff0000u); }
                    s += ((x0[0] * x0[0] + x0[1] * x0[1]) + (x0[2] * x0[2] + x0[3] * x0[3])) + ((x1[0] * x1[0] + x1[1] * x1[1]) + (x1[2] * x1[2] + x1[3] * x1[3]));
                }
                s += __shfl_xor(s, 16); s += __shfl_xor(s, 32);
                if (fq == 0) Pt[r * 4 + wc] = s;
                asm volatile("" ::: "memory");
            }
        }
        asm volatile("s_waitcnt lgkmcnt(0)" ::: "memory"); __builtin_amdgcn_s_barrier(); asm volatile("" ::: "memory");
        const int tid = wid * 64 + lane;
        if (tid < 256) rowsq[(size_t)u.pn * MROWS + u.pm * BM + tid] = (Pt[tid * 4] + Pt[tid * 4 + 1]) + (Pt[tid * 4 + 2] + Pt[tid * 4 + 3]);
        if (!last) return;
        asm volatile("s_waitcnt vmcnt(0)" ::: "memory"); __builtin_amdgcn_s_barrier(); asm volatile("" ::: "memory");
        if (tid == 0) {
            if (!same_xcc) __builtin_amdgcn_fence(__ATOMIC_RELEASE, "agent");
            asm volatile("s_waitcnt vmcnt(0)" ::: "memory");
            unsigned* c = pcnt + 64 * u.pm;
            __hip_atomic_fetch_add(c, 1u, __ATOMIC_RELAXED, __HIP_MEMORY_SCOPE_AGENT);
            unsigned sp = 0u;
            while (__hip_atomic_load(c, __ATOMIC_RELAXED, __HIP_MEMORY_SCOPE_AGENT) < 4u) { __builtin_amdgcn_s_sleep(1); if (++sp > (1u << 20)) break; }
            __builtin_amdgcn_fence(__ATOMIC_ACQUIRE, "agent");
            asm volatile("s_waitcnt vmcnt(0)" ::: "memory");
        }
        asm volatile("" ::: "memory"); __builtin_amdgcn_s_barrier(); asm volatile("" ::: "memory");
        f32x4 gv[2][2];
#pragma unroll
        for (int bj = 0; bj < 2; ++bj)
#pragma unroll
            for (int n = 0; n < 2; ++n) gv[bj][n] = *(const f32x4*)(gfin + col0 + bj * HALF + n * 4);
#pragma unroll
        for (int ai = 0; ai < 2; ++ai)
#pragma unroll
            for (int m = 0; m < 4; ++m) {
                const int row = u.pm * BM + ai * HALF + wr * 64 + m * 16 + fr; const size_t off = (size_t)row * D_MODEL + col0;
                const float rs = row_rstd(rowsq, row);
#pragma unroll
                for (int bj = 0; bj < 2; ++bj)
#pragma unroll
                    for (int n = 0; n < 2; ++n) *(f32x4*)(outf + off + bj * HALF + n * 4) = acc[ai][bj][m][n] * rs * gv[bj][n];
            }
    }
};
template <class Epi, class Sched, bool ALIGN_EPI = false, bool SP2 = false>
__device__ __forceinline__ void gemm_phase(PG8_LAS unsigned char* lds, const Gemm g, const Sched& S, const Epi& E, const int wid) {
    const int lane = lane_now(), tid = wid * 64 + lane, wr = wid >> 2, wc = wid & 3, fr = lane & 15, fq = lane >> 4;
    const int K = g.K, nt = K / BK;
    unsigned voffA[2], voffB[2];
#pragma unroll
    for (int i = 0; i < 2; ++i) { int R, C; stage_rc(tid * 16 + i * 8192, R, C); const int Rb = Epi::PERM ? ((R & ~31) + perm32(R & 31)) : R;
        voffA[i] = (unsigned)(R * K + C) * 2u; voffB[i] = (unsigned)(Rb * K + C) * 2u; }
    const size_t kstep = (size_t)(BK * 2);
    const size_t hstep = (size_t)HALF * K * 2;
    const size_t tstep = 2 * hstep;
    const unsigned ldsw = (unsigned)wid * 1024u;
    const int aoff = lds_byte(wr * 64 + fr, fq * 8), boff = lds_byte(wc * 32 + fr, fq * 8);
#define PG8_SA(b, h) (((b) * 2 + (h)) * HTB)
#define PG8_SB(b, h) ((4 + (b) * 2 + (h)) * HTB)
#define PG8_STAGE(bufoff, gbase, voff) do { _Pragma("unroll") for (int _i = 0; _i < 2; ++_i) \
        __builtin_amdgcn_global_load_lds((const unsigned*)((const char*)(gbase) + (voff)[_i]), (PG8_LAS unsigned*)(lds + (bufoff) + ldsw + _i * 8192), 16, 0, 0); } while (0)
#define PG8_LDA(dst, b, h) do { _Pragma("unroll") for (int m = 0; m < 4; ++m) _Pragma("unroll") for (int k = 0; k < 2; ++k) dst[m][k] = *(const PG8_LAS bf16x8*)(lds + PG8_SA(b, h) + aoff + m * 2048 + k * 1024); } while (0)
#define PG8_LDB(dst, b, h) do { _Pragma("unroll") for (int n = 0; n < 2; ++n) _Pragma("unroll") for (int k = 0; k < 2; ++k) dst[n][k] = *(const PG8_LAS bf16x8*)(lds + PG8_SB(b, h) + boff + n * 2048 + k * 1024); } while (0)
#define PG8_MMA(ai, bj, At, Bt) do { __builtin_amdgcn_s_setprio(1); _Pragma("unroll") for (int m = 0; m < 4; ++m) _Pragma("unroll") for (int n = 0; n < 2; ++n) _Pragma("unroll") for (int k = 0; k < 2; ++k) \
        acc[ai][bj][m][n] = __builtin_amdgcn_mfma_f32_16x16x32_bf16(Bt[n][k], At[m][k], acc[ai][bj][m][n], 0, 0, 0); __builtin_amdgcn_s_setprio(0); } while (0)
#define PG8_WAIT_V(n) asm volatile("s_waitcnt vmcnt(" #n ")" ::: "memory")
#define PG8_WAIT_L(n) asm volatile("s_waitcnt lgkmcnt(" #n ")" ::: "memory")
#define PG8_BAR __builtin_amdgcn_s_barrier()
#define PG8_SCHED __builtin_amdgcn_sched_barrier(0)
    Unit cur, nxt; int ui = 0;
    if (!S.next(0, cur)) return;
    f32x4 acc[2][2][4][2];
#pragma unroll
    for (int a = 0; a < 2; ++a)
#pragma unroll
        for (int b = 0; b < 2; ++b)
#pragma unroll
            for (int m = 0; m < 4; ++m)
#pragma unroll
                for (int n = 0; n < 2; ++n) acc[a][b][m][n] = (f32x4){0.f, 0.f, 0.f, 0.f};
    bf16x8 At[4][2], B0[2][2], B1[2][2];
    const char* cA = (const char*)g.A + (size_t)cur.pm * tstep; const char* cB = (const char*)g.Bt + (size_t)cur.pn * tstep;
    S.a_ready(cur);
    if constexpr (SP2) {
        PG8_STAGE(PG8_SB(0, 0), cB, voffB); PG8_STAGE(PG8_SB(0, 1), cB + hstep, voffB); PG8_STAGE(PG8_SA(0, 0), cA, voffA); PG8_STAGE(PG8_SA(0, 1), cA + hstep, voffA);
        if (wr == 1) PG8_BAR;
        PG8_WAIT_V(2); PG8_BAR;
        PG8_STAGE(PG8_SB(1, 0), cB + kstep, voffB); PG8_STAGE(PG8_SA(1, 0), cA + kstep, voffA); PG8_STAGE(PG8_SB(1, 1), cB + hstep + kstep, voffB);
        PG8_WAIT_V(6); PG8_BAR;
    } else {
        PG8_STAGE(PG8_SB(0, 0), cB, voffB); PG8_STAGE(PG8_SA(0, 0), cA, voffA); PG8_STAGE(PG8_SB(0, 1), cB + hstep, voffB); PG8_STAGE(PG8_SA(0, 1), cA + hstep, voffA);
        if (wr == 1) PG8_BAR;
        PG8_WAIT_V(4); PG8_BAR;
        PG8_STAGE(PG8_SB(1, 0), cB + kstep, voffB); PG8_STAGE(PG8_SA(1, 0), cA + kstep, voffA); PG8_STAGE(PG8_SB(1, 1), cB + hstep + kstep, voffB);
        PG8_WAIT_V(6); PG8_BAR;
    }
    for (;;) {
        const bool has_next = S.next(ui + 1, nxt);
        const char* nA = has_next ? (const char*)g.A + (size_t)nxt.pm * tstep : cA; const char* nB = has_next ? (const char*)g.Bt + (size_t)nxt.pn * tstep : cB;
        for (int t = 0; t < nt; t += 2) {
            const bool last = (t == nt - 2);
            const char* a1 = cA + (size_t)(t + 1) * kstep;
            const char* a2 = last ? nA : cA + (size_t)(t + 2) * kstep; const char* b2 = last ? nB : cB + (size_t)(t + 2) * kstep;
            const char* a3 = a2 + kstep; const char* b3 = b2 + kstep;
            if (last && has_next) S.a_ready(nxt);
            if constexpr (Epi::HAS_MID) { if (t == (nt >> 1)) E.mid(acc, cur, wr, wc, fr, fq); }
            if constexpr (SP2) {
            PG8_LDB(B0, 0, 0); PG8_LDB(B1, 0, 1); PG8_SCHED; PG8_LDA(At, 0, 0); PG8_STAGE(PG8_SA(1, 1), a1 + hstep, voffA);
            PG8_WAIT_V(8); PG8_WAIT_L(0); PG8_BAR; PG8_MMA(0, 0, At, B0); PG8_MMA(0, 1, At, B1); PG8_BAR; PG8_SCHED;
            PG8_LDA(At, 0, 1); PG8_STAGE(PG8_SB(0, 0), b2, voffB); PG8_STAGE(PG8_SB(0, 1), b2 + hstep, voffB); PG8_STAGE(PG8_SA(0, 0), a2, voffA);
            PG8_WAIT_V(8); PG8_WAIT_L(0); PG8_BAR; PG8_MMA(1, 0, At, B0); PG8_MMA(1, 1, At, B1); PG8_BAR; PG8_SCHED;
            PG8_LDB(B0, 1, 0); PG8_LDB(B1, 1, 1); PG8_SCHED; PG8_LDA(At, 1, 0); PG8_STAGE(PG8_SA(0, 1), a2 + hstep, voffA);
            PG8_WAIT_V(8); PG8_WAIT_L(0); PG8_BAR; PG8_MMA(0, 0, At, B0); PG8_MMA(0, 1, At, B1); PG8_BAR; PG8_SCHED;
            PG8_LDA(At, 1, 1); PG8_STAGE(PG8_SB(1, 0), b3, voffB); PG8_STAGE(PG8_SB(1, 1), b3 + hstep, voffB); PG8_STAGE(PG8_SA(1, 0), a3, voffA);
            PG8_WAIT_V(8); PG8_WAIT_L(0); PG8_BAR; PG8_MMA(1, 0, At, B0); PG8_MMA(1, 1, At, B1); PG8_BAR; PG8_SCHED;
            } else {
            PG8_LDB(B0, 0, 0); PG8_SCHED; PG8_LDA(At, 0, 0); PG8_STAGE(PG8_SA(1, 1), a1 + hstep, voffA);
            PG8_WAIT_L(8); PG8_BAR; PG8_WAIT_L(0); PG8_MMA(0, 0, At, B0); PG8_BAR; PG8_SCHED;
            PG8_LDB(B1, 0, 1); PG8_STAGE(PG8_SB(0, 0), b2, voffB);
            PG8_BAR; PG8_WAIT_L(0); PG8_MMA(0, 1, At, B1); PG8_BAR;
            PG8_LDA(At, 0, 1); PG8_STAGE(PG8_SA(0, 0), a2, voffA);
            PG8_BAR; PG8_WAIT_L(0); PG8_MMA(1, 0, At, B0); PG8_BAR; PG8_SCHED;
            PG8_STAGE(PG8_SB(0, 1), b2 + hstep, voffB);
            PG8_WAIT_V(6); PG8_BAR; PG8_MMA(1, 1, At, B1); PG8_BAR;
            PG8_LDB(B0, 1, 0); PG8_SCHED; PG8_LDA(At, 1, 0); PG8_STAGE(PG8_SA(0, 1), a2 + hstep, voffA);
            PG8_WAIT_L(8); PG8_BAR; PG8_WAIT_L(0); PG8_MMA(0, 0, At, B0); PG8_BAR; PG8_SCHED;
            PG8_LDB(B1, 1, 1); PG8_STAGE(PG8_SB(1, 0), b3, voffB);
            PG8_BAR; PG8_WAIT_L(0); PG8_MMA(0, 1, At, B1); PG8_BAR;
            PG8_LDA(At, 1, 1); PG8_STAGE(PG8_SA(1, 0), a3, voffA);
            PG8_BAR; PG8_WAIT_L(0); PG8_MMA(1, 0, At, B0); PG8_BAR; PG8_SCHED;
            PG8_STAGE(PG8_SB(1, 1), b3 + hstep, voffB);
            PG8_WAIT_V(6); PG8_BAR; PG8_MMA(1, 1, At, B1); PG8_BAR;
            }
        }
        if constexpr (ALIGN_EPI) { if (wr == 0) PG8_BAR; }
        if constexpr (!Epi::AFTER_DRAIN) { E(acc, cur, wr, wc, fr, fq); S.done(cur); }
        if (!has_next) break;
#pragma unroll
        for (int a = 0; a < 2; ++a)
#pragma unroll
            for (int b = 0; b < 2; ++b)
#pragma unroll
                for (int m = 0; m < 4; ++m)
#pragma unroll
                    for (int n = 0; n < 2; ++n) acc[a][b][m][n] = (f32x4){0.f, 0.f, 0.f, 0.f};
        cur = nxt; cA = nA; cB = nB; ++ui;
        if constexpr (ALIGN_EPI) { if (wr == 1) PG8_BAR; }
    }
    PG8_WAIT_V(0);
    if constexpr (!ALIGN_EPI) { if (wr == 0) PG8_BAR; }
    PG8_BAR;
    if constexpr (Epi::AFTER_DRAIN) { E.fused(acc, cur, wr, wc, fr, fq, lds, wid, lane); S.done(cur); }
#undef PG8_SA
#undef PG8_SB
#undef PG8_STAGE
#undef PG8_LDA
#undef PG8_LDB
#undef PG8_MMA
#undef PG8_WAIT_V
#undef PG8_WAIT_L
#undef PG8_BAR
#undef PG8_SCHED
}
}
constexpr int NWAVES = 8;
constexpr int RING_OFF = 0, RING_BYTES = 131072;
constexpr int LDS_BYTES = 147456;
constexpr int MISC_OFF = 140000;
static_assert(MISC_OFF % 16 == 0 && MISC_OFF + 256 <= LDS_BYTES, "LDS map");
constexpr int RSTD_OFF = MISC_OFF + 1024;
static_assert(RSTD_OFF + 1024 <= LDS_BYTES, "LDS map");

typedef unsigned v4u __attribute__((ext_vector_type(4)));
typedef float f32x4 __attribute__((ext_vector_type(4)));
#define LDS_WAIT() asm volatile("s_waitcnt lgkmcnt(0)" ::: "memory")
#define VM_WAIT() asm volatile("s_waitcnt vmcnt(0)" ::: "memory")

__device__ __forceinline__ float wave_sum(float v) {
#pragma unroll
    for (int o = 1; o < 64; o <<= 1) v += __shfl_xor(v, o);
    return v;
}

__device__ __forceinline__ int rperm(int p) { return p < 16 ? ((p & 3) | ((p & 4) << 1) | ((p & 8) >> 1)) : p; }
__device__ __forceinline__ int win_src_col(int n) {
    if (n < 512) return OFF_Q + (n & ~63) + rperm(n & 63);
    if (n < 1024) { const int m = n - 512; return OFF_K + (m & ~63) + rperm(m & 63); }
    if (n < 1536) return OFF_V + (n - 1024);
    if (n < 1792) { const int m = n - 1536; return OFF_IQ + (m & ~63) + rperm(m & 63); }
    if (n < 1856) return OFF_IK + rperm(n - 1792);
    if (n < 1860) return OFF_IW + (n - 1856);
    if (n < 2048) return -1;
    if (n < 2560) return OFF_CB + (n - 2048);
    if (n < 3584) { const int m = n - 2560, G = m >> 3, i = m & 7; return i < 4 ? OFF_CC + 4 * G + i : OFF_CH + 4 * G + (i - 4); }
    { const int g = n - 3584, T = g >> 8, c = g & 255;
      return OFF_G + (c < 128 ? T * 128 + c : 1024 + T * 128 + (c - 128)); }
}
template <bool MAPPED>
__device__ __forceinline__ void transpose_item(const float* __restrict__ W, int Nsrc, bf16* WT, int dst_ld, int dst_col0, int k0, int n0, LAS unsigned char* scr, int lane, const float* __restrict__ gk = nullptr) {
    const int c4 = (lane & 15) * 4, r0 = lane >> 4;
    const int sc = MAPPED ? win_src_col(n0 + c4) : (n0 + c4);
    f32x4 v[16];
#pragma unroll
    for (int i = 0; i < 16; ++i) v[i] = (sc >= 0) ? *(const f32x4*)(W + (size_t)(k0 + 8 * (i >> 1) + 2 * r0 + (i & 1)) * Nsrc + sc) : (f32x4){0.f, 0.f, 0.f, 0.f};
    if (gk) {
#pragma unroll
        for (int i = 0; i < 16; ++i) v[i] = v[i] * gk[k0 + 8 * (i >> 1) + 2 * r0 + (i & 1)];
    }
#pragma unroll
    for (int p = 0; p < 8; ++p) {
        const int kk = 8 * p + 2 * r0;
#pragma unroll
        for (int c = 0; c < 4; ++c) *(LAS unsigned*)(scr + (c4 + c) * 144 + kk * 2) = pk2(v[2 * p][c], v[2 * p + 1][c]);
    }
    LDS_WAIT(); asm volatile("" ::: "memory");
    const int ch = lane & 7;
#pragma unroll
    for (int j = 0; j < 8; ++j) { const int n = (lane >> 3) + 8 * j;
        const v4u o = *(const LAS v4u*)(scr + n * 144 + ch * 16);
        *(GAS v4u*)(WT + (size_t)(n0 + n) * dst_ld + dst_col0 + k0 + 8 * ch) = o; }
    LDS_WAIT(); asm volatile("" ::: "memory");
}
__device__ __forceinline__ void sincos_acc(float ang_f, float& s_out, float& c_out) {
    const double a = (double)ang_f;
    const double q = rint(a * 0.63661977236758134308);
    double r = fma(-q, 1.57079632679489655800e+00, a);
    r = fma(-q, 6.12323399573676603587e-17, r);
    const double r2 = r * r;
    double sp = 1.0 / 6227020800.0; sp = fma(sp, r2, -1.0 / 39916800.0); sp = fma(sp, r2, 1.0 / 362880.0); sp = fma(sp, r2, -1.0 / 5040.0);
    sp = fma(sp, r2, 1.0 / 120.0); sp = fma(sp, r2, -1.0 / 6.0); sp = fma(sp, r2, 1.0);
    const double sn = sp * r;
    double cp = 1.0 / 87178291200.0; cp = fma(cp, r2, -1.0 / 479001600.0); cp = fma(cp, r2, 1.0 / 3628800.0); cp = fma(cp, r2, -1.0 / 40320.0);
    cp = fma(cp, r2, 1.0 / 720.0); cp = fma(cp, r2, -1.0 / 24.0); cp = fma(cp, r2, 0.5); cp = fma(-cp, r2, 1.0);
    const int qi = ((int)q) & 3;
    double s, c;
    if (qi == 0) { s = sn; c = cp; } else if (qi == 1) { s = cp; c = -sn; } else if (qi == 2) { s = -sn; c = -cp; } else { s = -cp; c = sn; }
    s_out = (float)s; c_out = (float)c;
}
__device__ __forceinline__ float rope_inv(int j) {
    return j == 0 ? 1.0f : j == 1 ? 0.193922758102417f : j == 2 ? 0.03760603070259094f : j == 3 ? 0.00729266507551074f : j == 4 ? 0.001414213445968926f
         : j == 5 ? 0.00027424818836152554f : j == 6 ? 5.318296462064609e-05f : 1.0313385246263351e-05f;
}
__device__ __forceinline__ void xg_row(const float* xrow, const float* g, bf16* orow, float* rowsq, int row, int lane) {
    const GAS f32x4* xr = (const GAS f32x4*)xrow + lane; (void)g;
    f32x4 v[4]; float s = 0.f;
#pragma unroll
    for (int j = 0; j < 4; ++j) { v[j] = xr[64 * j]; s += (v[j].x * v[j].x + v[j].y * v[j].y) + (v[j].z * v[j].z + v[j].w * v[j].w); }
    s = wave_sum(s);
    GAS unsigned long long* o8 = (GAS unsigned long long*)orow + lane;
#pragma unroll
    for (int j = 0; j < 4; ++j) { o8[64 * j] = (unsigned long long)pk2(v[j].x, v[j].y) | ((unsigned long long)pk2(v[j].z, v[j].w) << 32); }
    if (lane < 4) rowsq[lane * MROWS + row] = (lane == 0) ? s : 0.f;
}

namespace sel {
typedef short bf16x8 __attribute__((ext_vector_type(8)));
typedef float f32x4 __attribute__((ext_vector_type(4)));
typedef unsigned u32x4 __attribute__((ext_vector_type(4)));
constexpr int ROWB = 8208;
constexpr int K16_BYTES = 16 * ROWB;
constexpr int MSK_OFF = K16_BYTES;
static_assert(MSK_OFF + 8192 <= MISC_OFF, "selection LDS map");
__device__ __forceinline__ int lane_now() { int l; asm volatile("v_mbcnt_lo_u32_b32 %0, -1, 0\n\tv_mbcnt_hi_u32_b32 %0, -1, %0" : "=v"(l)); return l; }
__device__ __forceinline__ void wg_barrier() { asm volatile("s_waitcnt vmcnt(0) lgkmcnt(0)\n\ts_barrier" ::: "memory"); }
__device__ __forceinline__ unsigned key_pair(float a, float b) {
    const unsigned x = __builtin_bit_cast(unsigned, __builtin_amdgcn_cvt_pkrtz(a, b));
    unsigned t; asm("v_pk_ashrrev_i16 %0, %2, %1" : "=v"(t) : "v"(x), "s"(0x000f000fu));
    return x ^ (t | 0x80008000u);
}
__device__ __forceinline__ float relu_i(float x) { const int i = __builtin_bit_cast(int, x); return __builtin_bit_cast(float, i > 0 ? i : 0); }
#define SEL_CMP8(OP, m, x0, x1, x2, x3, c) asm( \
    OP " %0, %8, %12 src0_sel:WORD_0 src1_sel:DWORD\n\t" OP " %1, %8, %12 src0_sel:WORD_1 src1_sel:DWORD\n\t" \
    OP " %2, %9, %12 src0_sel:WORD_0 src1_sel:DWORD\n\t" OP " %3, %9, %12 src0_sel:WORD_1 src1_sel:DWORD\n\t" \
    OP " %4, %10, %12 src0_sel:WORD_0 src1_sel:DWORD\n\t" OP " %5, %10, %12 src0_sel:WORD_1 src1_sel:DWORD\n\t" \
    OP " %6, %11, %12 src0_sel:WORD_0 src1_sel:DWORD\n\t" OP " %7, %11, %12 src0_sel:WORD_1 src1_sel:DWORD" \
    : "=&s"(m[0]), "=&s"(m[1]), "=&s"(m[2]), "=&s"(m[3]), "=&s"(m[4]), "=&s"(m[5]), "=&s"(m[6]), "=&s"(m[7]) : "v"(x0), "v"(x1), "v"(x2), "v"(x3), "s"(c))
__device__ __forceinline__ void count_ge2(const unsigned (&xa)[32], const unsigned (&xb)[32], const int nst, const unsigned candA, const unsigned candB, int& ca, int& cb) {
    const unsigned cmA = (candA - 1u) * 0x00010001u, cmB = (candB - 1u) * 0x00010001u, one = 0x00010001u;
    unsigned a0 = 0u, a1 = 0u, a2 = 0u, a3 = 0u, b0 = 0u, b1 = 0u, b2 = 0u, b3 = 0u;
#pragma unroll
    for (int g4 = 0; g4 < 8; ++g4) if (g4 * 4 < nst) {
        unsigned t0, t1, t2, t3, u0, u1, u2, u3;
        asm("v_pk_sub_u16 %0, %1, %2 clamp" : "=v"(t0) : "v"(xa[g4 * 4 + 0]), "s"(cmA));
        asm("v_pk_sub_u16 %0, %1, %2 clamp" : "=v"(t1) : "v"(xa[g4 * 4 + 1]), "s"(cmA));
        asm("v_pk_sub_u16 %0, %1, %2 clamp" : "=v"(t2) : "v"(xa[g4 * 4 + 2]), "s"(cmA));
        asm("v_pk_sub_u16 %0, %1, %2 clamp" : "=v"(t3) : "v"(xa[g4 * 4 + 3]), "s"(cmA));
        asm("v_pk_sub_u16 %0, %1, %2 clamp" : "=v"(u0) : "v"(xb[g4 * 4 + 0]), "s"(cmB));
        asm("v_pk_sub_u16 %0, %1, %2 clamp" : "=v"(u1) : "v"(xb[g4 * 4 + 1]), "s"(cmB));
        asm("v_pk_sub_u16 %0, %1, %2 clamp" : "=v"(u2) : "v"(xb[g4 * 4 + 2]), "s"(cmB));
        asm("v_pk_sub_u16 %0, %1, %2 clamp" : "=v"(u3) : "v"(xb[g4 * 4 + 3]), "s"(cmB));
        asm("v_pk_min_u16 %0, %1, %2" : "=v"(t0) : "v"(t0), "s"(one)); asm("v_pk_min_u16 %0, %1, %2" : "=v"(t1) : "v"(t1), "s"(one));
        asm("v_pk_min_u16 %0, %1, %2" : "=v"(t2) : "v"(t2), "s"(one)); asm("v_pk_min_u16 %0, %1, %2" : "=v"(t3) : "v"(t3), "s"(one));
        asm("v_pk_min_u16 %0, %1, %2" : "=v"(u0) : "v"(u0), "s"(one)); asm("v_pk_min_u16 %0, %1, %2" : "=v"(u1) : "v"(u1), "s"(one));
        asm("v_pk_min_u16 %0, %1, %2" : "=v"(u2) : "v"(u2), "s"(one)); asm("v_pk_min_u16 %0, %1, %2" : "=v"(u3) : "v"(u3), "s"(one));
        asm("v_pk_add_u16 %0, %1, %2" : "=v"(a0) : "v"(a0), "v"(t0)); asm("v_pk_add_u16 %0, %1, %2" : "=v"(a1) : "v"(a1), "v"(t1));
        asm("v_pk_add_u16 %0, %1, %2" : "=v"(a2) : "v"(a2), "v"(t2)); asm("v_pk_add_u16 %0, %1, %2" : "=v"(a3) : "v"(a3), "v"(t3));
        asm("v_pk_add_u16 %0, %1, %2" : "=v"(b0) : "v"(b0), "v"(u0)); asm("v_pk_add_u16 %0, %1, %2" : "=v"(b1) : "v"(b1), "v"(u1));
        asm("v_pk_add_u16 %0, %1, %2" : "=v"(b2) : "v"(b2), "v"(u2)); asm("v_pk_add_u16 %0, %1, %2" : "=v"(b3) : "v"(b3), "v"(u3));
    }
    asm("v_pk_add_u16 %0, %1, %2" : "=v"(a0) : "v"(a0), "v"(a1)); asm("v_pk_add_u16 %0, %1, %2" : "=v"(a2) : "v"(a2), "v"(a3));
    asm("v_pk_add_u16 %0, %1, %2" : "=v"(b0) : "v"(b0), "v"(b1)); asm("v_pk_add_u16 %0, %1, %2" : "=v"(b2) : "v"(b2), "v"(b3));
    asm("v_pk_add_u16 %0, %1, %2" : "=v"(a0) : "v"(a0), "v"(a2)); asm("v_pk_add_u16 %0, %1, %2" : "=v"(b0) : "v"(b0), "v"(b2));
    int va = (int)((a0 & 0xffffu) + (a0 >> 16)), vb = (int)((b0 & 0xffffu) + (b0 >> 16));
    va += __builtin_amdgcn_update_dpp(0, va, 0x111, 0xf, 0xf, true); vb += __builtin_amdgcn_update_dpp(0, vb, 0x111, 0xf, 0xf, true);
    va += __builtin_amdgcn_update_dpp(0, va, 0x112, 0xf, 0xf, true); vb += __builtin_amdgcn_update_dpp(0, vb, 0x112, 0xf, 0xf, true);
    va += __builtin_amdgcn_update_dpp(0, va, 0x114, 0xf, 0xf, true); vb += __builtin_amdgcn_update_dpp(0, vb, 0x114, 0xf, 0xf, true);
    va += __builtin_amdgcn_update_dpp(0, va, 0x118, 0xf, 0xf, true); vb += __builtin_amdgcn_update_dpp(0, vb, 0x118, 0xf, 0xf, true);
    ca = (__builtin_amdgcn_readlane(va, 15) + __builtin_amdgcn_readlane(va, 31)) + (__builtin_amdgcn_readlane(va, 47) + __builtin_amdgcn_readlane(va, 63));
    cb = (__builtin_amdgcn_readlane(vb, 15) + __builtin_amdgcn_readlane(vb, 31)) + (__builtin_amdgcn_readlane(vb, 47) + __builtin_amdgcn_readlane(vb, 63));
}
__device__ __forceinline__ void bit_transpose32(const unsigned (&x)[32], unsigned (&w)[32]) {
#pragma unroll
    for (int k = 0; k < 16; ++k) { w[k] = __builtin_amdgcn_perm(x[k + 16], x[k], 0x05040100u); w[k + 16] = __builtin_amdgcn_perm(x[k + 16], x[k], 0x07060302u); }
#pragma unroll
    for (int k = 0; k < 32; ++k) if (!(k & 8)) { const unsigned a = w[k], b = w[k + 8]; w[k] = __builtin_amdgcn_perm(b, a, 0x06020400u); w[k + 8] = __builtin_amdgcn_perm(b, a, 0x07030501u); }
#define BT_STAGE(s, m) _Pragma("unroll") for (int k = 0; k < 32; ++k) if (!(k & s)) { const unsigned a = w[k], b = w[k + s]; w[k] = (a & m) | ((b << s) & ~m); w[k + s] = ((a >> s) & m) | (b & ~m); }
    BT_STAGE(4, 0x0F0F0F0Fu) BT_STAGE(2, 0x33333333u) BT_STAGE(1, 0x55555555u)
#undef BT_STAGE
}
struct SelU { int b, t0, N, NST; };
__device__ __forceinline__ SelU sel_mk(const int b, const int qb16) { SelU u; u.b = b; u.t0 = qb16 * 16; u.N = ((u.t0 >> 6) + 1) << 6; u.NST = (u.N + 127) >> 7; return u; }
__device__ __forceinline__ void sel_score(LAS unsigned char* lds, const SelU u, const bf16* __restrict__ IQ, const bf16* __restrict__ IK, const float* __restrict__ IW, const int wid) {
    const int lane = lane_now();
    const int q = lane & 15, g = lane >> 4;
    const int t0 = u.t0, N = u.N, NST = u.NST;
    const size_t rb = (size_t)u.b * SEQ;
    bf16x8 bq[4][2];
#pragma unroll
    for (int h = 0; h < 4; ++h)
#pragma unroll
        for (int ks = 0; ks < 2; ++ks) bq[h][ks] = *(const bf16x8*)(IQ + (((rb + t0) >> 4) * 32 + h * 8 + ks * 4 + g) * 128 + q * 8);
    const f32x4 w4 = *(const f32x4*)(IW + (rb + t0 + q) * 4);
    for (int st = wid; st < NST; st += 8) {
        const int k0 = st * 128;
        const unsigned hmask = ((k0 + 64) < N) ? 0xffffffffu : 0x0000ffffu;
        bf16x8 ak[4][4];
#pragma unroll
        for (int kt = 0; kt < 4; ++kt) {
            const bf16* ikA = IK + (((rb + k0) >> 4) + kt) * 1024 + g * 128 + q * 8;
            const bf16* ikB = ikA + 4 * 1024;
            ak[kt][0] = *(const bf16x8*)ikA; ak[kt][1] = *(const bf16x8*)(ikA + 512); ak[kt][2] = *(const bf16x8*)ikB; ak[kt][3] = *(const bf16x8*)(ikB + 512); }
        __builtin_amdgcn_sched_barrier(0);
#pragma unroll
        for (int kt = 0; kt < 4; ++kt) {
            const bf16x8 aA0 = ak[kt][0], aA1 = ak[kt][1], aB0 = ak[kt][2], aB1 = ak[kt][3];
            typedef float f32x2s __attribute__((ext_vector_type(2)));
            f32x2s sA01 = {0.f, 0.f}, sA23 = {0.f, 0.f}, sB01 = {0.f, 0.f}, sB23 = {0.f, 0.f};
#pragma unroll
            for (int h = 0; h < 4; ++h) {
                f32x4 cA = __builtin_amdgcn_mfma_f32_16x16x32_bf16(aA0, bq[h][0], (f32x4){0.f, 0.f, 0.f, 0.f}, 0, 0, 0);
                cA = __builtin_amdgcn_mfma_f32_16x16x32_bf16(aA1, bq[h][1], cA, 0, 0, 0);
                f32x4 cB = __builtin_amdgcn_mfma_f32_16x16x32_bf16(aB0, bq[h][0], (f32x4){0.f, 0.f, 0.f, 0.f}, 0, 0, 0);
                cB = __builtin_amdgcn_mfma_f32_16x16x32_bf16(aB1, bq[h][1], cB, 0, 0, 0);
#pragma unroll
                for (int r = 0; r < 1; ++r) { const f32x2s wv = {w4[h], w4[h]};
                    sA01 = __builtin_elementwise_fma((f32x2s){relu_i(cA[0]), relu_i(cA[1])}, wv, sA01); sA23 = __builtin_elementwise_fma((f32x2s){relu_i(cA[2]), relu_i(cA[3])}, wv, sA23);
                    sB01 = __builtin_elementwise_fma((f32x2s){relu_i(cB[0]), relu_i(cB[1])}, wv, sB01); sB23 = __builtin_elementwise_fma((f32x2s){relu_i(cB[2]), relu_i(cB[3])}, wv, sB23); }
            }
            u32x4 d;
#pragma unroll
            for (int r = 0; r < 4; ++r) d[r] = key_pair((r < 2) ? sA01[r & 1] : sA23[r & 1], (r < 2) ? sB01[r & 1] : sB23[r & 1]) & hmask;
            { const int p0 = 32 * (g >> 1) + 4 * kt + 2 * (g & 1);
              *(LAS unsigned long long*)(lds + q * ROWB + (st * 64 + p0) * 4) = (unsigned long long)d[0] | ((unsigned long long)d[2] << 32);
              *(LAS unsigned long long*)(lds + q * ROWB + (st * 64 + p0 + 16) * 4) = (unsigned long long)d[1] | ((unsigned long long)d[3] << 32); }
        }
    }
}
__device__ __forceinline__ void sel_loadx(LAS unsigned char* lds, const SelU u, unsigned (&xq)[2][32], const int wid) {
    const int lane = lane_now(); const int NST = u.NST;
#pragma unroll
    for (int j = 0; j < 32; ++j) { xq[0][j] = (j < NST) ? ((const LAS unsigned*)(lds + (2 * wid) * ROWB))[j * 64 + lane] : 0u;
                                   xq[1][j] = (j < NST) ? ((const LAS unsigned*)(lds + (2 * wid + 1) * ROWB))[j * 64 + lane] : 0u; }
}
__device__ __forceinline__ void sel_pick(LAS unsigned char* lds, const SelU u, const unsigned (&xq)[2][32], const int wid) {
    const int lane = lane_now(); const int N = u.N, NST = u.NST;
    unsigned Tq[2] = {0u, 0u}; int cTq[2] = {0, 0};
    if (N > 256) {
#pragma unroll
        for (int qq = 0; qq < 2; ++qq) {
            unsigned pl[32];
            bit_transpose32(xq[qq], pl);
            __builtin_amdgcn_sched_barrier(0);
            unsigned m0 = ~0u, m1 = ~0u, T = 0u; int g = 0, cT = 0;
#pragma unroll
            for (int bit = 15; bit >= 0; --bit) {
                const unsigned t0 = m0 & pl[bit], t1 = m1 & pl[16 + bit];
                int v = __builtin_popcount(t0) + __builtin_popcount(t1);
                v += __builtin_amdgcn_update_dpp(0, v, 0x111, 0xf, 0xf, true); v += __builtin_amdgcn_update_dpp(0, v, 0x112, 0xf, 0xf, true);
                v += __builtin_amdgcn_update_dpp(0, v, 0x114, 0xf, 0xf, true); v += __builtin_amdgcn_update_dpp(0, v, 0x118, 0xf, 0xf, true);
                const int n = g + (__builtin_amdgcn_readlane(v, 15) + __builtin_amdgcn_readlane(v, 31)) + (__builtin_amdgcn_readlane(v, 47) + __builtin_amdgcn_readlane(v, 63));
                const bool take = n >= 256;
                if (take) { T |= 1u << bit; cT = n; } else g = n;
                const unsigned f = take ? 0u : ~0u;
                m0 &= pl[bit] ^ f; m1 &= pl[16 + bit] ^ f;
            }
            Tq[qq] = T; cTq[qq] = cT;
            __builtin_amdgcn_sched_barrier(0);
        }
    }
#pragma unroll
    for (int qq = 0; qq < 2; ++qq) {
        const int ql = 2 * wid + qq;
        const unsigned (&xh)[32] = xq[qq];
        const unsigned T = Tq[qq]; const int cT = cTq[qq];
        unsigned mlo = 0u, mhi = 0u;
#define SEL_WL(tile, mm) do { asm volatile("v_writelane_b32 %0, %1, %2" : "+v"(mlo) : "s"(__builtin_amdgcn_readfirstlane((unsigned)(mm))), "n"(tile)); \
                              asm volatile("v_writelane_b32 %0, %1, %2" : "+v"(mhi) : "s"(__builtin_amdgcn_readfirstlane((unsigned)((mm) >> 32))), "n"(tile)); } while (0)
        if (N <= 256) {
#pragma unroll
            for (int tile = 0; tile < 4; ++tile) { const unsigned long long m = (tile * 64 < N) ? ~0ull : 0ull; SEL_WL(tile, m); }
        } else {
#pragma unroll
            for (int g4 = 0; g4 < 8; ++g4) if (g4 * 4 < NST) {
                unsigned long long m[8];
                SEL_CMP8("v_cmp_ge_u16_sdwa", m, xh[g4 * 4], xh[g4 * 4 + 1], xh[g4 * 4 + 2], xh[g4 * 4 + 3], T);
#pragma unroll
                for (int k = 0; k < 8; ++k) {
                    asm volatile("v_writelane_b32 %0, %1, %2" : "+v"(mlo) : "s"((unsigned)m[k]), "n"(g4 * 8 + k));
                    asm volatile("v_writelane_b32 %0, %1, %2" : "+v"(mhi) : "s"((unsigned)(m[k] >> 32)), "n"(g4 * 8 + k)); }
            }
            int d = cT - 256;
            if (d > 0) {
#pragma unroll
                for (int g4 = 7; g4 >= 0; --g4) if (g4 * 4 < NST && d > 0) {
                    unsigned long long e[8];
                    SEL_CMP8("v_cmp_eq_u16_sdwa", e, xh[g4 * 4], xh[g4 * 4 + 1], xh[g4 * 4 + 2], xh[g4 * 4 + 3], T);
#pragma unroll
                    for (int k = 7; k >= 0; --k) {
                        unsigned long long ek = e[k];
                        if (d > 0 && ek != 0ull) {
                            const int pop = __builtin_popcountll(ek);
                            unsigned long long clr = 0ull;
                            if (pop <= d) { clr = ek; d -= pop; }
                            else { for (int i_ = 0; i_ < d; ++i_) { const unsigned long long hb = 1ull << (63 - __builtin_clzll(ek)); clr |= hb; ek ^= hb; } d = 0; }
                            const unsigned lo_ = (unsigned)__builtin_amdgcn_readlane((int)mlo, g4 * 8 + k) & ~(unsigned)clr;
                            const unsigned hi_ = (unsigned)__builtin_amdgcn_readlane((int)mhi, g4 * 8 + k) & ~(unsigned)(clr >> 32);
                            asm volatile("v_writelane_b32 %0, %1, %2" : "+v"(mlo) : "s"(__builtin_amdgcn_readfirstlane(lo_)), "n"(g4 * 8 + k));
                            asm volatile("v_writelane_b32 %0, %1, %2" : "+v"(mhi) : "s"(__builtin_amdgcn_readfirstlane(hi_)), "n"(g4 * 8 + k));
                        }
                    }
                }
            }
        }
#undef SEL_WL
        *(LAS unsigned long long*)(lds + MSK_OFF + ql * 512 + lane * 8) = (unsigned long long)mlo | ((unsigned long long)mhi << 32);
    }
}
__device__ __forceinline__ void sel_write(LAS unsigned char* lds, const SelU u, unsigned long long* __restrict__ MASK, const int wid) {
    const int lane = lane_now();
    const int tid = wid * 64 + lane, tile = tid >> 3, pr = tid & 7;
    const unsigned long long m0 = *(const LAS unsigned long long*)(lds + MSK_OFF + (2 * pr) * 512 + tile * 8);
    const unsigned long long m1 = *(const LAS unsigned long long*)(lds + MSK_OFF + (2 * pr + 1) * 512 + tile * 8);
    u32x4 o; o.x = (unsigned)m0; o.y = (unsigned)(m0 >> 32); o.z = (unsigned)m1; o.w = (unsigned)(m1 >> 32);
    *(u32x4*)(MASK + ((size_t)(u.b * 64 + tile) * SEQ + u.t0 + 2 * pr)) = o;
}
template <class F>
__device__ __forceinline__ void sel_pipeline(LAS unsigned char* lds, const int n, F unit_of, const bf16* __restrict__ IQ, const bf16* __restrict__ IK, const float* __restrict__ IW,
                                             unsigned long long* __restrict__ MASK, const int wid) {
    if (n <= 0) return;
    unsigned xq[2][32];
    SelU cur = unit_of(0);
    sel_score(lds, cur, IQ, IK, IW, wid);
    wg_barrier();
    sel_loadx(lds, cur, xq, wid);
    wg_barrier();
#pragma unroll 1
    for (int i = 0; i < n; ++i) {
        const bool more = (i + 1 < n);
        SelU nxt = cur; if (more) nxt = unit_of(i + 1);
        if (more && !(wid & 1)) sel_score(lds, nxt, IQ, IK, IW, wid);
        sel_pick(lds, cur, xq, wid);
        if (more && (wid & 1)) sel_score(lds, nxt, IQ, IK, IW, wid);
        wg_barrier();
        sel_write(lds, cur, MASK, wid);
        if (more) sel_loadx(lds, nxt, xq, wid);
        asm volatile("s_waitcnt lgkmcnt(0)\n\ts_barrier" ::: "memory");
        cur = nxt;
    }
}
__device__ __forceinline__ void convmid_rows(const bf16* __restrict__ CB, const bf16* __restrict__ P, const float* __restrict__ cw, bf16* __restrict__ A2, const int row_base, const int wid) {
    const int lane = lane_now(); const int c8 = lane * 8;
    f32x4 w[3][2];
#pragma unroll
    for (int k = 0; k < 3; ++k) { w[k][0] = *(const f32x4*)(cw + k * 512 + c8); w[k][1] = *(const f32x4*)(cw + k * 512 + c8 + 4); }
#pragma unroll 1
    for (int pass = 0; pass < 8; ++pass) {
        const int row = row_base + pass * 8 + wid, t = row & (SEQ - 1);
        const u32x4 zero = (u32x4){0u, 0u, 0u, 0u};
        const u32x4 p0 = *(const u32x4*)(P + (size_t)row * 512 + c8);
        const u32x4 p1 = (t >= 1) ? *(const u32x4*)(P + (size_t)(row - 1) * 512 + c8) : zero;
        const u32x4 p2 = (t >= 2) ? *(const u32x4*)(P + (size_t)(row - 2) * 512 + c8) : zero;
        const u32x4 cb = *(const u32x4*)(CB + (size_t)row * 512 + c8);
        float o[8];
#pragma unroll
        for (int j = 0; j < 4; ++j) {
            const float a0 = __builtin_bit_cast(float, p0[j] << 16), a1 = __builtin_bit_cast(float, p0[j] & 0xffff0000u);
            const float b0 = __builtin_bit_cast(float, p1[j] << 16), b1 = __builtin_bit_cast(float, p1[j] & 0xffff0000u);
            const float c0 = __builtin_bit_cast(float, p2[j] << 16), c1 = __builtin_bit_cast(float, p2[j] & 0xffff0000u);
            const float g0 = __builtin_bit_cast(float, cb[j] << 16), g1 = __builtin_bit_cast(float, cb[j] & 0xffff0000u);
            const int e0 = 2 * j, e1 = 2 * j + 1;
            o[e0] = g0 * (w[0][e0 >> 2][e0 & 3] * c0 + w[1][e0 >> 2][e0 & 3] * b0 + w[2][e0 >> 2][e0 & 3] * a0);
            o[e1] = g1 * (w[0][e1 >> 2][e1 & 3] * c1 + w[1][e1 >> 2][e1 & 3] * b1 + w[2][e1 >> 2][e1 & 3] * a1);
        }
        u32x4 r; r.x = pk2(o[0], o[1]); r.y = pk2(o[2], o[3]); r.z = pk2(o[4], o[5]); r.w = pk2(o[6], o[7]);
        *(u32x4*)(A2 + (size_t)row * 1024 + 512 + c8) = r;
    }
}
}
namespace att {
typedef short bf16x8 __attribute__((ext_vector_type(8)));
typedef short s16x4 __attribute__((ext_vector_type(4)));
typedef float f32x16 __attribute__((ext_vector_type(16)));
typedef unsigned u32x4 __attribute__((ext_vector_type(4)));
typedef float f32x2_t __attribute__((ext_vector_type(2))); typedef __bf16 bf16x2_t __attribute__((ext_vector_type(2)));
constexpr int NSLOT = 4, SLOTB = 8192, MSLOTB = 2048;
constexpr int LDS_K = 0, LDS_V = NSLOT * SLOTB, LDS_M = 2 * NSLOT * SLOTB, LDS_WS = LDS_M + NSLOT * MSLOTB, LDS_OST = LDS_WS + 8 * 64 * 4, LDS_FLAG = LDS_OST + 8 * 4096, LDS_END = LDS_FLAG + 64;
static_assert(LDS_END <= RING_BYTES, "attention LDS map");
__device__ __forceinline__ int lane_now() { int l; asm volatile("v_mbcnt_lo_u32_b32 %0, -1, 0\n\tv_mbcnt_hi_u32_b32 %0, -1, %0" : "=v"(l)); return l; }
__device__ __forceinline__ int crow(int r, int hi) { return (r & 3) + 8 * (r >> 2) + 4 * hi; }
__device__ __forceinline__ void glds16(const void* gsrc, unsigned lds_dst) { unsigned keep;
    asm volatile("s_mov_b32 %0, m0\n\ts_mov_b32 m0, %2\n\ts_nop 0\n\tglobal_load_lds_dwordx4 %1, off\n\ts_mov_b32 m0, %0" : "=&s"(keep) : "v"(gsrc), "s"(lds_dst) : "memory"); }
__device__ __forceinline__ void glds4(const void* gsrc, unsigned lds_dst) { unsigned keep;
    asm volatile("s_mov_b32 %0, m0\n\ts_mov_b32 m0, %2\n\ts_nop 0\n\tglobal_load_lds_dword %1, off\n\ts_mov_b32 m0, %0" : "=&s"(keep) : "v"(gsrc), "s"(lds_dst) : "memory"); }
__device__ __forceinline__ unsigned cvtpk(float lo, float hi) { f32x2_t v = {lo, hi}; bf16x2_t b = __builtin_convertvector(v, bf16x2_t); return __builtin_bit_cast(unsigned, b); }
#define ATT_WAIT_BAR(N) asm volatile("s_waitcnt vmcnt(" #N ") lgkmcnt(0)\n\ts_barrier" ::: "memory")
#define ATT_SBAR() __builtin_amdgcn_sched_barrier(0)
__device__ __forceinline__ void pv(f32x16* o, int vb, bf16x8 pa0, bf16x8 pa1, bf16x8 pa2, bf16x8 pa3) {
#pragma unroll
    for (int d0 = 0; d0 < 2; ++d0) { s16x4 lo[4], hi[4];
#pragma unroll
        for (int ks = 0; ks < 4; ++ks) {
            asm volatile("ds_read_b64_tr_b16 %0,%1 offset:%c2" : "=&v"(lo[ks]) : "v"(vb), "i"(d0 * 4096 + ks * 1024) : "memory");
            asm volatile("ds_read_b64_tr_b16 %0,%1 offset:%c2" : "=&v"(hi[ks]) : "v"(vb), "i"(d0 * 4096 + ks * 1024 + 512) : "memory"); }
        asm volatile("s_waitcnt lgkmcnt(0)" ::: "memory"); ATT_SBAR();
#define ATT_PK(k) (bf16x8){lo[k][0], lo[k][1], lo[k][2], lo[k][3], hi[k][0], hi[k][1], hi[k][2], hi[k][3]}
        o[d0] = __builtin_amdgcn_mfma_f32_32x32x16_bf16(pa0, ATT_PK(0), o[d0], 0, 0, 0);
        o[d0] = __builtin_amdgcn_mfma_f32_32x32x16_bf16(pa1, ATT_PK(1), o[d0], 0, 0, 0);
        o[d0] = __builtin_amdgcn_mfma_f32_32x32x16_bf16(pa2, ATT_PK(2), o[d0], 0, 0, 0);
        o[d0] = __builtin_amdgcn_mfma_f32_32x32x16_bf16(pa3, ATT_PK(3), o[d0], 0, 0, 0);
#undef ATT_PK
    }
}
template <bool SAFE>
__device__ __forceinline__ bool attn_unit(const int b, const int h, const int qb, const bf16* __restrict__ Q, const bf16* __restrict__ K, const bf16* __restrict__ V,
                                          const unsigned long long* __restrict__ MASK, bf16* __restrict__ O, LAS unsigned char* shm, const int wid) {
    const int lane = lane_now(), r32 = lane & 31, hi = lane >> 5;
    const size_t rowbase = (size_t)b * SEQ; const int q0 = qb * 256;
    const bf16* Qw = Q + (rowbase + q0 + wid * 32) * 512 + h * 64;
    const bf16* Kh = K + rowbase * 512 + h * 64; const bf16* Vh = V + rowbase * 512 + h * 64;
    const unsigned lds0 = (unsigned)(uintptr_t)shm;
    LAS float* wsf = (LAS float*)(shm + LDS_WS) + wid * 64;
    const bf16* ksrc = Kh + (size_t)lane * 512 + wid * 8;
    const bf16* vsrc = Vh + (size_t)(16 * (wid & 3) + (lane >> 2)) * 512 + (wid >> 2) * 32 + (lane & 3) * 8;
    const unsigned* msrc = (const unsigned*)(MASK + ((size_t)b * 64 * SEQ + q0 + wid * 32)) + lane;
    const unsigned kdst = lds0 + LDS_K + wid * 1024, vdst = lds0 + LDS_V + wid * 1024, mdst = lds0 + LDS_M + wid * 256;
#define ATT_DMA(t, slot) do { glds4(msrc + (size_t)(t) * (SEQ * 2), (unsigned)__builtin_amdgcn_readfirstlane(mdst + (slot) * MSLOTB)); \
        glds16(ksrc + (size_t)(t) * 64 * 512, (unsigned)__builtin_amdgcn_readfirstlane(kdst + (slot) * SLOTB)); \
        glds16(vsrc + (size_t)(t) * 64 * 512, (unsigned)__builtin_amdgcn_readfirstlane(vdst + (slot) * SLOTB)); } while (0)
    const int vb0 = (int)(lds0 + LDS_V) + ((lane >> 4) & 1) * 32 + (lane & 3) * 8 + (4 * hi + ((lane & 15) >> 2)) * 64;
    const int NT = (q0 + 256) / 64;
    bf16x8 qr[4];
#pragma unroll
    for (int d0 = 0; d0 < 4; ++d0) qr[d0] = *(const bf16x8*)(Qw + (size_t)r32 * 512 + d0 * 16 + hi * 8);
    asm volatile("s_waitcnt vmcnt(0)" : "+v"(qr[0]), "+v"(qr[1]), "+v"(qr[2]), "+v"(qr[3]) :: "memory");
    ATT_DMA(0, 0); ATT_DMA(1, 1); ATT_DMA(2, 2);
    bool redo = false;
    if constexpr (SAFE) {
    constexpr float THR = 8.0f, NEGBIG = -1.0e30f;
    float mhat = 0.f, l_run = 0.f; f32x16 o[2]; o[0] = f32x16{}; o[1] = f32x16{};
#define ATT_QKT(C0, C1, slot_) do { \
        const unsigned long long mw_ = *(const LAS unsigned long long*)(shm + LDS_M + (slot_) * MSLOTB + wid * 256 + r32 * 8); \
        const unsigned long long ms_ = mw_ >> (2 * hi);              \
        const int mlo_ = (int)(unsigned)ms_, mhi_ = (int)(unsigned)(ms_ >> 32); \
        const unsigned nm_ = __float_as_uint(-mhat), ng_ = __float_as_uint(NEGBIG); \
        f32x16 i0_, i1_; \
        _Pragma("unroll") for (int r = 0; r < 16; ++r) { const int pos = 16 * (r & 1) + 4 * (r >> 3) + ((r >> 1) & 1); const int wsel = (r >> 2) & 1; \
            const unsigned t0_ = (unsigned)__builtin_amdgcn_sbfe(wsel ? mhi_ : mlo_, pos, 1), t1_ = (unsigned)__builtin_amdgcn_sbfe(wsel ? mhi_ : mlo_, pos + 8, 1); \
            i0_[r] = __uint_as_float((nm_ & t0_) | (ng_ & ~t0_)); i1_[r] = __uint_as_float((nm_ & t1_) | (ng_ & ~t1_)); } \
        const LAS unsigned char* kb_ = shm + LDS_K + (slot_) * SLOTB + hi * 1024 + r32 * 16; \
        _Pragma("unroll") for (int d0 = 0; d0 < 4; ++d0) { \
            const bf16x8 b0_ = *(const LAS bf16x8*)(kb_ + d0 * 2048), b1_ = *(const LAS bf16x8*)(kb_ + d0 * 2048 + 512); \
            if (d0 == 0) { C0 = __builtin_amdgcn_mfma_f32_32x32x16_bf16(b0_, qr[0], i0_, 0, 0, 0); C1 = __builtin_amdgcn_mfma_f32_32x32x16_bf16(b1_, qr[0], i1_, 0, 0, 0); } \
            else { C0 = __builtin_amdgcn_mfma_f32_32x32x16_bf16(b0_, qr[d0], C0, 0, 0, 0); C1 = __builtin_amdgcn_mfma_f32_32x32x16_bf16(b1_, qr[d0], C1, 0, 0, 0); } } } while (0)
    f32x16 p0, p1, c0, c1;
    if (NT > 3) ATT_WAIT_BAR(6); else ATT_WAIT_BAR(0);
    ATT_QKT(p0, p1, 0);
    int slot = 0;
#pragma unroll 1
    for (int t = 0; t < NT; ++t) {
        if (t + 2 < NT) ATT_WAIT_BAR(3); else ATT_WAIT_BAR(0);
        if (t + 3 < NT) { const int s3 = (slot == 0) ? NSLOT - 1 : slot - 1; ATT_DMA(t + 3, s3); }
        const int slot1 = (slot == NSLOT - 1) ? 0 : slot + 1;
        float rm = fmaxf(p0[0], p1[0]);
#pragma unroll
        for (int r = 1; r < 16; ++r) rm = fmaxf(rm, fmaxf(p0[r], p1[r]));
        { auto rr = __builtin_amdgcn_permlane32_swap(__float_as_uint(rm), __float_as_uint(rm), false, false); rm = fmaxf(__uint_as_float(rr[0]), __uint_as_float(rr[1])); }
        if (__builtin_expect(__any(rm > THR), 0)) {
            const float dl = fmaxf(rm, 0.f); mhat += dl;
#pragma unroll
            for (int r = 0; r < 16; ++r) { p0[r] -= dl; p1[r] -= dl; }
            const float f = __builtin_amdgcn_exp2f(-dl); l_run *= f;
            if (hi == 0) wsf[r32] = f;
            asm volatile("s_waitcnt lgkmcnt(0)" ::: "memory");
#pragma unroll
            for (int r = 0; r < 16; ++r) { const float a = wsf[crow(r, hi)]; o[0][r] *= a; o[1][r] *= a; }
        }
        if (t + 1 < NT) ATT_QKT(c0, c1, slot1);
        float sacc = 0.f;
#pragma unroll
        for (int r = 0; r < 16; ++r) { p0[r] = __builtin_amdgcn_exp2f(p0[r]); p1[r] = __builtin_amdgcn_exp2f(p1[r]); sacc += p0[r] + p1[r]; }
        l_run += sacc;
        u32x4 pw0, pw1, pw2, pw3;
        pw0 = (u32x4){cvtpk(p0[0], p0[1]), cvtpk(p0[2], p0[3]), cvtpk(p0[4], p0[5]), cvtpk(p0[6], p0[7])};
        pw1 = (u32x4){cvtpk(p0[8], p0[9]), cvtpk(p0[10], p0[11]), cvtpk(p0[12], p0[13]), cvtpk(p0[14], p0[15])};
        pw2 = (u32x4){cvtpk(p1[0], p1[1]), cvtpk(p1[2], p1[3]), cvtpk(p1[4], p1[5]), cvtpk(p1[6], p1[7])};
        pw3 = (u32x4){cvtpk(p1[8], p1[9]), cvtpk(p1[10], p1[11]), cvtpk(p1[12], p1[13]), cvtpk(p1[14], p1[15])};
        pv(o, vb0 + slot * SLOTB, __builtin_bit_cast(bf16x8, pw0), __builtin_bit_cast(bf16x8, pw1), __builtin_bit_cast(bf16x8, pw2), __builtin_bit_cast(bf16x8, pw3));
        p0 = c0; p1 = c1;
        slot = slot1;
    }
#undef ATT_QKT
    { auto rr = __builtin_amdgcn_permlane32_swap(__float_as_uint(l_run), __float_as_uint(l_run), false, false); l_run = __uint_as_float(rr[0]) + __uint_as_float(rr[1]); }
    if (hi == 0) wsf[32 + r32] = l_run;
    asm volatile("s_waitcnt lgkmcnt(0)" ::: "memory");
    float rli[16];
#pragma unroll
    for (int r = 0; r < 16; ++r) rli[r] = __builtin_amdgcn_rcpf(wsf[32 + crow(r, hi)]);
    bf16* Ow = O + (rowbase + q0 + wid * 32) * 1024 + h * 64;
    { LAS bf16* stg = (LAS bf16*)(shm + LDS_OST) + wid * 2048;
#pragma unroll
      for (int r = 0; r < 16; ++r) { const int orow = crow(r, hi);
#pragma unroll
          for (int d0 = 0; d0 < 2; ++d0) stg[orow * 64 + d0 * 32 + r32] = (bf16)f2bf(o[d0][r] * rli[r]); }
      asm volatile("s_waitcnt lgkmcnt(0)" ::: "memory");
#pragma unroll
      for (int i = 0; i < 4; ++i) { const int row = i * 8 + (lane >> 3), ch = lane & 7; const u32x4 v = *(const LAS u32x4*)(stg + row * 64 + ch * 8); *(u32x4*)(Ow + (size_t)row * 1024 + ch * 8) = v; } }
    asm volatile("s_waitcnt vmcnt(0) lgkmcnt(0)\n\ts_barrier" ::: "memory");
    } else {
    f32x16 o[2]; o[0] = f32x16{}; o[1] = f32x16{}; f32x16 lsum = f32x16{};
    const bf16x8 ones8 = (bf16x8){0x3f80, 0x3f80, 0x3f80, 0x3f80, 0x3f80, 0x3f80, 0x3f80, 0x3f80};
    const unsigned ngb = __float_as_uint(-1.0e30f);
    bf16x8 kf[8]; s16x4 vlo[8], vhi[8];
    const unsigned kaddr0 = lds0 + LDS_K + hi * 1024 + r32 * 16;
#define ATT_KRD(slot_) do { const unsigned ka_ = kaddr0 + (slot_) * SLOTB; \
        _Pragma("unroll") for (int d0 = 0; d0 < 4; ++d0) { \
            asm volatile("ds_read_b128 %0, %1 offset:%c2" : "=v"(kf[2 * d0]) : "v"(ka_), "i"(d0 * 2048) : "memory"); \
            asm volatile("ds_read_b128 %0, %1 offset:%c2" : "=v"(kf[2 * d0 + 1]) : "v"(ka_), "i"(d0 * 2048 + 512) : "memory"); } } while (0)
#define ATT_VRD(slot_) do { const int va_ = vb0 + (slot_) * SLOTB; \
        _Pragma("unroll") for (int i = 0; i < 8; ++i) { \
            asm volatile("ds_read_b64_tr_b16 %0, %1 offset:%c2" : "=v"(vlo[i]) : "v"(va_), "i"((i >> 2) * 4096 + (i & 3) * 1024) : "memory"); \
            asm volatile("ds_read_b64_tr_b16 %0, %1 offset:%c2" : "=v"(vhi[i]) : "v"(va_), "i"((i >> 2) * 4096 + (i & 3) * 1024 + 512) : "memory"); } } while (0)
    bf16x8 ai[2];
#pragma unroll
    for (int s = 0; s < 2; ++s)
#pragma unroll
        for (int e = 0; e < 8; ++e) ai[s][e] = (r32 == 16 * s + 8 * hi + e) ? (short)0xFE80 : (short)0;
#define ATT_MB(MB, slot_) do { \
        const unsigned dw_ = ~*(const LAS unsigned*)(shm + LDS_M + (slot_) * MSLOTB + wid * 256 + r32 * 8 + hi * 4); \
        const unsigned s5_ = dw_ << 5, s10_ = dw_ << 10, s1_ = dw_ >> 1; \
        _Pragma("unroll") for (int i = 0; i < 16; ++i) { \
            const unsigned w_ = (i < 5) ? (s10_ & (0x00010001u << (i + 10))) : (i < 10) ? (s5_ & (0x00010001u << (i + 5))) : (i < 15) ? (dw_ & (0x00010001u << i)) : (s1_ & 0x40004000u); \
            MB[i >> 2][i & 3] = w_; } } while (0)
#define ATT_QK8(C0, C1, MB) do { \
        C0 = __builtin_amdgcn_mfma_f32_32x32x16_bf16(ai[0], __builtin_bit_cast(bf16x8, MB[0]), f32x16{}, 0, 0, 0); C1 = __builtin_amdgcn_mfma_f32_32x32x16_bf16(ai[0], __builtin_bit_cast(bf16x8, MB[2]), f32x16{}, 0, 0, 0); \
        C0 = __builtin_amdgcn_mfma_f32_32x32x16_bf16(ai[1], __builtin_bit_cast(bf16x8, MB[1]), C0, 0, 0, 0); C1 = __builtin_amdgcn_mfma_f32_32x32x16_bf16(ai[1], __builtin_bit_cast(bf16x8, MB[3]), C1, 0, 0, 0); \
        _Pragma("unroll") for (int d0 = 0; d0 < 4; ++d0) { C0 = __builtin_amdgcn_mfma_f32_32x32x16_bf16(kf[2 * d0], qr[d0], C0, 0, 0, 0); C1 = __builtin_amdgcn_mfma_f32_32x32x16_bf16(kf[2 * d0 + 1], qr[d0], C1, 0, 0, 0); } } while (0)
#define ATT_VF(i) (bf16x8){vlo[i][0], vlo[i][1], vlo[i][2], vlo[i][3], vhi[i][0], vhi[i][1], vhi[i][2], vhi[i][3]}
    f32x16 c0, c1;
    const int my_nt = 4 * qb + (wid >> 1) + 1;
    u32x4 mb[4]; u32x4 pw0, pw1, pw2, pw3;
#define ATT_RE(t_, slot_, slot1_) do { if ((t_) < my_nt) { \
        if ((t_) + 1 < my_nt) ATT_KRD(slot1_);                        \
        ATT_VRD(slot_); \
        ATT_SBAR(); \
        _Pragma("unroll") for (int r = 0; r < 16; ++r) { c0[r] = __builtin_amdgcn_exp2f(c0[r]); c1[r] = __builtin_amdgcn_exp2f(c1[r]); } \
        pw0 = (u32x4){cvtpk(c0[0], c0[1]), cvtpk(c0[2], c0[3]), cvtpk(c0[4], c0[5]), cvtpk(c0[6], c0[7])}; \
        pw1 = (u32x4){cvtpk(c0[8], c0[9]), cvtpk(c0[10], c0[11]), cvtpk(c0[12], c0[13]), cvtpk(c0[14], c0[15])}; \
        pw2 = (u32x4){cvtpk(c1[0], c1[1]), cvtpk(c1[2], c1[3]), cvtpk(c1[4], c1[5]), cvtpk(c1[6], c1[7])}; \
        pw3 = (u32x4){cvtpk(c1[8], c1[9]), cvtpk(c1[10], c1[11]), cvtpk(c1[12], c1[13]), cvtpk(c1[14], c1[15])}; \
        if ((t_) + 1 < my_nt) ATT_MB(mb, slot1_); \
        asm volatile("s_waitcnt lgkmcnt(0)" ::: "memory"); ATT_SBAR(); } } while (0)
#define ATT_MM(t_) do { if ((t_) < my_nt) { \
        o[0] = __builtin_amdgcn_mfma_f32_32x32x16_bf16(__builtin_bit_cast(bf16x8, pw0), ATT_VF(0), o[0], 0, 0, 0); \
        o[1] = __builtin_amdgcn_mfma_f32_32x32x16_bf16(__builtin_bit_cast(bf16x8, pw0), ATT_VF(4), o[1], 0, 0, 0); \
        o[0] = __builtin_amdgcn_mfma_f32_32x32x16_bf16(__builtin_bit_cast(bf16x8, pw1), ATT_VF(1), o[0], 0, 0, 0); \
        o[1] = __builtin_amdgcn_mfma_f32_32x32x16_bf16(__builtin_bit_cast(bf16x8, pw1), ATT_VF(5), o[1], 0, 0, 0); \
        o[0] = __builtin_amdgcn_mfma_f32_32x32x16_bf16(__builtin_bit_cast(bf16x8, pw2), ATT_VF(2), o[0], 0, 0, 0); \
        o[1] = __builtin_amdgcn_mfma_f32_32x32x16_bf16(__builtin_bit_cast(bf16x8, pw2), ATT_VF(6), o[1], 0, 0, 0); \
        o[0] = __builtin_amdgcn_mfma_f32_32x32x16_bf16(__builtin_bit_cast(bf16x8, pw3), ATT_VF(3), o[0], 0, 0, 0); \
        o[1] = __builtin_amdgcn_mfma_f32_32x32x16_bf16(__builtin_bit_cast(bf16x8, pw3), ATT_VF(7), o[1], 0, 0, 0); \
          \
        lsum = __builtin_amdgcn_mfma_f32_32x32x16_bf16(__builtin_bit_cast(bf16x8, pw0), ones8, lsum, 0, 0, 0); \
        lsum = __builtin_amdgcn_mfma_f32_32x32x16_bf16(__builtin_bit_cast(bf16x8, pw1), ones8, lsum, 0, 0, 0); \
        lsum = __builtin_amdgcn_mfma_f32_32x32x16_bf16(__builtin_bit_cast(bf16x8, pw2), ones8, lsum, 0, 0, 0); \
        lsum = __builtin_amdgcn_mfma_f32_32x32x16_bf16(__builtin_bit_cast(bf16x8, pw3), ones8, lsum, 0, 0, 0); \
        if ((t_) + 1 < my_nt) ATT_QK8(c0, c1, mb); } } while (0)
    ATT_WAIT_BAR(6);
    { ATT_KRD(0); ATT_MB(mb, 0);
      asm volatile("s_waitcnt lgkmcnt(0)" ::: "memory"); ATT_SBAR();
      ATT_QK8(c0, c1, mb); }
    int slot = 0;
    const bool halfB = (wid >= 4);
#define ATT_STEP_BAR(t_) do { if ((t_) + 2 < NT) ATT_WAIT_BAR(3); else ATT_WAIT_BAR(0);       \
        if ((t_) + 3 < NT) { const int s3 = (slot == 0) ? NSLOT - 1 : slot - 1; ATT_DMA((t_) + 3, s3); } } while (0)
#pragma unroll 1
    for (int t = 0; t < NT; ++t) {
        const int slot1 = (slot == NSLOT - 1) ? 0 : slot + 1;
        if (halfB) ATT_STEP_BAR(t);
        if (t > 0) ATT_MM(t - 1);
        if (!halfB) ATT_STEP_BAR(t);
        ATT_RE(t, slot, slot1);
        slot = slot1;
    }
    ATT_MM(NT - 1);
#undef ATT_STEP_BAR
#undef ATT_RE
#undef ATT_MM
#undef ATT_KRD
#undef ATT_VRD
#undef ATT_MB
#undef ATT_QK8
#undef ATT_VF
    float rli[16]; bool bad = false;
#pragma unroll
    for (int r = 0; r < 16; ++r) { bad = bad || !(lsum[r] > 0.f && lsum[r] < 1.0e37f); rli[r] = __builtin_amdgcn_rcpf(lsum[r]); }
    { const unsigned anyb = __any(bad) ? 1u : 0u; if (lane == 0) ((LAS unsigned*)(shm + LDS_FLAG))[wid] = anyb; }
    bf16* Ow = O + (rowbase + q0 + wid * 32) * 1024 + h * 64;
    { LAS bf16* stg = (LAS bf16*)(shm + LDS_OST) + wid * 2048;
#pragma unroll
      for (int r = 0; r < 16; ++r) { const int orow = crow(r, hi);
#pragma unroll
          for (int d0 = 0; d0 < 2; ++d0) stg[orow * 64 + d0 * 32 + r32] = (bf16)f2bf(o[d0][r] * rli[r]); }
      asm volatile("s_waitcnt lgkmcnt(0)" ::: "memory");
#pragma unroll
      for (int i = 0; i < 4; ++i) { const int row = i * 8 + (lane >> 3), ch = lane & 7; const u32x4 v = *(const LAS u32x4*)(stg + row * 64 + ch * 8); *(u32x4*)(Ow + (size_t)row * 1024 + ch * 8) = v; } }
    asm volatile("s_waitcnt lgkmcnt(0)\n\ts_barrier" ::: "memory");
    { const LAS unsigned* fl = (const LAS unsigned*)(shm + LDS_FLAG); redo = (fl[0] | fl[1] | fl[2] | fl[3] | fl[4] | fl[5] | fl[6] | fl[7]) != 0u; }
    asm volatile("s_waitcnt lgkmcnt(0)\n\ts_barrier" ::: "memory");
    }
#undef ATT_DMA
    return redo;
}
#undef ATT_WAIT_BAR
#undef ATT_SBAR
}
struct Args { const float* in[11]; float* out; unsigned char* ws; };

#define XB_TMO      128
#define XB_XCNT(j)  (256  + 64 * (j))
#define XB_XSUB(j)  (1280 + 64 * (j))
#define XB_XGEN(j)  (2304 + 64 * (j))
#define XB_TOP      3328
#define XB_TOPGEN   3392
#define XCD_BAR_WORDS 3456
#define XB_SPIN_CAP (1u << 18)

__device__ __forceinline__ unsigned xb_ld(unsigned* p)              { return __hip_atomic_load((GAS unsigned*)p, __ATOMIC_RELAXED, __HIP_MEMORY_SCOPE_AGENT); }
__device__ __forceinline__ unsigned xb_add(unsigned* p, unsigned v) { return __hip_atomic_fetch_add((GAS unsigned*)p, v, __ATOMIC_RELAXED, __HIP_MEMORY_SCOPE_AGENT); }
__device__ __forceinline__ unsigned xb_xcc_id() { return (unsigned)__builtin_amdgcn_s_getreg((3 << 11) | 20) & 0xFu; }
#define XB_SPIN(cond, bar) do { unsigned _sp = 0; while (cond) { __builtin_amdgcn_s_sleep(1); \
    if ((++_sp & 255u) == 0u) { if (xb_ld(&(bar)[XB_TMO])) break; if (_sp > XB_SPIN_CAP) { atomicAdd(&(bar)[XB_TMO], 1u); break; } } } } while (0)

struct XcdBarrier {
    unsigned* bar; unsigned x;
    volatile LAS unsigned* st;
};

__device__ __forceinline__ XcdBarrier xcd_barrier_post(unsigned* bar, volatile LAS unsigned* st, const int wave) {
    XcdBarrier b; b.bar = bar; b.x = xb_xcc_id(); b.st = st;
    if (wave == 0 && pg8::lane_now() == 0) (void)xb_add(&bar[XB_XCNT(b.x)], 1u);
    return b;
}
__device__ __forceinline__ void xcd_barrier_complete(unsigned* bar, unsigned x, unsigned& nloc, unsigned& nx) {
    const unsigned G = gridDim.x * gridDim.y * gridDim.z;
    unsigned sum, cnt, mine, sp = 0u;
    for (;;) {
        sum = 0u; cnt = 0u; mine = 0u;
#pragma unroll 1
        for (unsigned j = 0; j < 16; ++j) { const unsigned c = xb_ld(&bar[XB_XCNT(j)]); sum += c; cnt += (c > 0u) ? 1u : 0u; mine = (j == x) ? c : mine; }
        if (sum == G) break;
        __builtin_amdgcn_s_sleep(1);
        if ((++sp & 255u) == 0u) { if (xb_ld(&bar[XB_TMO])) break; if (sp > XB_SPIN_CAP) { atomicAdd(&bar[XB_TMO], 1u); break; } }
    }
    nloc = mine > 0u ? mine : 1u; nx = cnt > 0u ? cnt : 1u;
}

__device__ __forceinline__ void xcd_barrier(const XcdBarrier& b, const int wave) {
    asm volatile("s_waitcnt vmcnt(0)" ::: "memory");
    __syncthreads();
    if (wave == 0 && pg8::lane_now() == 0) {
        unsigned* bar = b.bar;
        __builtin_amdgcn_s_waitcnt(0);
        unsigned nloc = b.st[0], nx = b.st[1];
        if (nloc == 0u) { xcd_barrier_complete(bar, b.x, nloc, nx); b.st[0] = nloc; b.st[1] = nx; }
        const unsigned old = xb_add(&bar[XB_XSUB(b.x)], 1u);
        const unsigned gen = old / nloc;
        if (old + 1u == (gen + 1u) * nloc) {
            __builtin_amdgcn_fence(__ATOMIC_RELEASE, "agent");
            asm volatile("s_waitcnt vmcnt(0)" ::: "memory");
            const unsigned og = xb_add(&bar[XB_TOP], 1u);
            const unsigned tg = og / nx;
            if (og + 1u == (tg + 1u) * nx) xb_add(&bar[XB_TOPGEN], 1u);
            else XB_SPIN(xb_ld(&bar[XB_TOPGEN]) == tg, bar);
            __builtin_amdgcn_fence(__ATOMIC_ACQUIRE, "agent");
            xb_add(&bar[XB_XGEN(b.x)], 1u);
            asm volatile("s_waitcnt vmcnt(0)" ::: "memory");
        } else {
            XB_SPIN(xb_ld(&bar[XB_XGEN(b.x)]) == gen, bar);
            __builtin_amdgcn_fence(__ATOMIC_ACQUIRE, "agent");
            asm volatile("s_waitcnt vmcnt(0)" ::: "memory");
        }
    }
    __syncthreads();
}

constexpr int CW_WIN = 16 * (NPALL / 64), CW_EARLY = CW_WIN + 8 * 16 + 8 * 16 + 16 * 16, CW_LAYER = CW_EARLY + 16 * 64 + 64 * 16;
__device__ __forceinline__ void convert_weights(const Args& a, LAS unsigned char* lds, int wave, int lane, int gw, int NGW, int l, int r_lo, int r_hi) {
    unsigned char* ws = a.ws;
    LAS unsigned char* scr = lds + RING_OFF + wave * 16384;
    constexpr int I_IN = 16 * (NPALL / 64), I_AO = 8 * 16, I_CO = 8 * 16, I_MX = 16 * 16, I_UP = 16 * 64, I_DN = 64 * 16;
    constexpr int I_LAYER = I_IN + I_AO + I_CO + I_MX + I_UP + I_DN;
    static_assert(I_LAYER == CW_LAYER && I_IN + I_AO + I_CO + I_MX == CW_EARLY, "weight item space");
    for (int it = r_lo + gw; it < r_hi; it += NGW) {
        int r = it;
        if (r < I_IN) { const int nb = r % (NPALL / 64), kb = r / (NPALL / 64);
            transpose_item<true>(a.in[2] + (size_t)l * D_MODEL * IN_COLS, IN_COLS, (bf16*)(ws + WS_WIN) + (size_t)l * NPALL * 1024, 1024, 0, kb * 64, nb * 64, scr, lane, a.in[1] + l * D_MODEL); continue; } r -= I_IN;
        if (r < I_AO) { const int nb = r % 16, kb = r / 16;
            transpose_item<false>(a.in[4] + (size_t)l * 512 * 1024, 1024, (bf16*)(ws + WS_WOC) + (size_t)l * 1024 * 1024, 1024, 0, kb * 64, nb * 64, scr, lane); continue; } r -= I_AO;
        if (r < I_CO) { const int nb = r % 16, kb = r / 16;
            transpose_item<false>(a.in[5] + (size_t)l * 512 * 1024, 1024, (bf16*)(ws + WS_WOC) + (size_t)l * 1024 * 1024, 1024, 512, kb * 64, nb * 64, scr, lane); continue; } r -= I_CO;
        if (r < I_MX) { const int nb = r % 16, kb = r / 16;
            transpose_item<false>(a.in[6] + (size_t)l * 1024 * 1024, 1024, (bf16*)(ws + WS_WMIX) + (size_t)l * 1024 * 1024, 1024, 0, kb * 64, nb * 64, scr, lane); continue; } r -= I_MX;
        if (r < I_UP) { const int nb = r % 64, kb = r / 64;
            transpose_item<false>(a.in[8] + (size_t)l * 1024 * 4096, 4096, (bf16*)(ws + WS_WUP) + (size_t)l * 4096 * 1024, 1024, 0, kb * 64, nb * 64, scr, lane, a.in[7] + l * D_MODEL); continue; } r -= I_UP;
        { const int nb = r % 16, kb = r / 16;
            transpose_item<false>(a.in[9] + (size_t)l * 4096 * 1024, 1024, (bf16*)(ws + WS_WDN) + (size_t)l * 1024 * 4096, 4096, 0, kb * 64, nb * 64, scr, lane); }
    }
}
__device__ __forceinline__ void p0_prologue(const Args& a, LAS unsigned char* lds, int wave, int lane, int vcu, int G) {
    unsigned char* ws = a.ws;
    const int gw = vcu * NWAVES + wave, NGW = G * NWAVES;
    convert_weights(a, lds, wave, lane, gw, NGW, 0, 0, CW_WIN);
    float* cs = (float*)(ws + WS_CS);
    for (int i = gw * 64 + lane; i < SEQ * 8; i += NGW * 64) { const int t = i >> 3, j = i & 7; float s, c; sincos_acc((float)t * rope_inv(j), s, c); cs[i] = c; cs[SEQ * 8 + i] = s; }
    for (int m = gw; m < MROWS; m += NGW) xg_row(a.in[0] + (size_t)m * D_MODEL, a.in[1], (bf16*)(ws + WS_XG) + (size_t)m * D_MODEL, (float*)(ws + WS_ROWSQ), m, lane);
}

constexpr int CW_PANEL = 8192;
constexpr int CW_BAR = 4096;
static_assert((CW_BAR + XCD_BAR_WORDS) * 4 <= 65536, "barrier words inside the per-call memset");
constexpr int CW_XTAB = 7680;
constexpr int CW_GROUP = 12288;
static_assert(CW_BAR + XCD_BAR_WORDS <= CW_XTAB && CW_XTAB + 256 <= CW_PANEL && CW_PANEL + 64 * 64 <= CW_GROUP && (CW_GROUP + 64 * 64) * 4 <= 65536, "control words inside the per-call memset");
#define RSTD_TABLE(S_) do { pg8::Unit u0_; if (S_.next(0, u0_)) { const int t_ = wave * 64 + lane; \
        if (t_ < 256) { const float* rq_ = (const float*)(ws + WS_ROWSQ) + (size_t)u0_.pm * 256 + t_; \
            ((LAS float*)(lds + RSTD_OFF))[t_] = __builtin_amdgcn_rsqf(((rq_[0] + rq_[MROWS]) + (rq_[2 * MROWS] + rq_[3 * MROWS])) * (1.0f / 1024.0f) + 1e-6f); } } \
        __syncthreads(); } while (0)
__global__ void __launch_bounds__(NWAVES * 64, 2) mk_fwd(Args args) {
    extern __shared__ __attribute__((aligned(16))) unsigned char lds_raw[];
    LAS unsigned char* lds = (LAS unsigned char*)lds_raw;
    const int wave = __builtin_amdgcn_readfirstlane(threadIdx.x >> 6);
#define lane (pg8::lane_now())
    const int G = gridDim.x; const int bx = blockIdx.x; const int vcu = (G % 8 == 0) ? (bx % 8) * (G / 8) + bx / 8 : bx;
    unsigned char* const ws0 = args.ws;
    unsigned char* ws = ws0;
#define WS_FRESH() size_t wz_ = 0; asm volatile("" : "+s"(wz_)); unsigned char* ws = ws0 + wz_
    if (wave == 0) ((LAS unsigned*)(lds + MISC_OFF))[lane] = 0u;
    __syncthreads();
    const XcdBarrier bar = xcd_barrier_post((unsigned*)(ws + WS_CTL) + CW_BAR, (volatile LAS unsigned*)(lds + MISC_OFF) + 8, wave);
#define GRID_BAR() do { XcdBarrier b_ = bar; size_t bz_ = 0; asm volatile("" : "+s"(bz_)); b_.bar = bar.bar + bz_; xcd_barrier(b_, wave); } while (0)
    if (wave == 0 && lane == 0) __hip_atomic_store((GAS unsigned*)((unsigned*)(ws + WS_CTL) + CW_XTAB) + blockIdx.x, bar.x + 1u, __ATOMIC_RELAXED, __HIP_MEMORY_SCOPE_AGENT);
    p0_prologue(args, lds, wave, lane, vcu, G);
    GRID_BAR();
    bool group_ok = false;
    if (G == 256) { const unsigned* xt_ = (const unsigned*)(ws + WS_CTL) + CW_XTAB; const int l_ = lane;
        const unsigned x0_ = xb_ld((unsigned*)xt_ + l_), x1_ = xb_ld((unsigned*)xt_ + l_ + 64), x2_ = xb_ld((unsigned*)xt_ + l_ + 128), x3_ = xb_ld((unsigned*)xt_ + l_ + 192);
        group_ok = __all((x0_ != 0u) && (x0_ == x1_) && (x0_ == x2_) && (x0_ == x3_)) != 0; }
    unsigned grp_epoch = 0u;
#define GROUP_BAR() do { if (!group_ok) { GRID_BAR(); break; } \
        asm volatile("s_waitcnt vmcnt(0)" ::: "memory"); __syncthreads();                    \
        grp_epoch += 1u; \
        if (wave == 0) { if (lane == 0) { unsigned* c_ = (unsigned*)(ws0 + WS_CTL) + CW_GROUP + 64 * ((int)blockIdx.x & 63); \
                (void)xb_add(c_, 1u); unsigned sp_ = 0u; \
                while (xb_ld(c_) < 4u * grp_epoch) { __builtin_amdgcn_s_sleep(1); if (++sp_ > XB_SPIN_CAP) break; } } \
            __builtin_amdgcn_fence(__ATOMIC_ACQUIRE, "agent"); asm volatile("s_waitcnt vmcnt(0)" ::: "memory"); }     \
        __syncthreads(); } while (0)
#pragma unroll 1
    for (int L = 0; L < DEPTH; ++L) {
    {   WS_FRESH();
        pg8::Gemm g{(const bf16*)(ws + WS_XG), (const bf16*)(ws + WS_WIN) + (size_t)L * NPALL * 1024, MROWS, NP1, D_MODEL};
        pg8::StaticOrder S; S.init(MROWS, NP1, G, (int)blockIdx.x);
        RSTD_TABLE(S);
        pg8::EpiProj E{(const LAS float*)(lds + RSTD_OFF), (const float*)(ws + WS_CS), (bf16*)(ws + WS_Q), (bf16*)(ws + WS_K), (bf16*)(ws + WS_V), (bf16*)(ws + WS_IQ), (bf16*)(ws + WS_IK),
                       (bf16*)(ws + WS_CB), (bf16*)(ws + WS_P), (float*)(ws + WS_IW)};
        pg8::gemm_phase<pg8::EpiProj, pg8::StaticOrder, true, true>(lds + RING_OFF, g, S, E, wave);
        { pg8::Unit ux; if (!S.next(3, ux)) {
            const int nidle = G - (MROWS / 256 * (NP1 / 256) - 3 * G), rank = (int)blockIdx.x - (G - nidle);
            if (nidle > 0 && rank >= 0) {
                convert_weights(args, lds, wave, lane, rank * NWAVES + wave, nidle * NWAVES, L, CW_WIN, CW_LAYER);
                if (L + 1 < DEPTH) convert_weights(args, lds, wave, lane, rank * NWAVES + wave, nidle * NWAVES, L + 1, 0, CW_WIN); } } }
    }
    GRID_BAR();
    {   WS_FRESH();
        {   const int nid = (512 - vcu + G - 1) / G;
            sel::sel_pipeline(lds, 2 * nid, [&](int i) { const int id = vcu + (i >> 1) * G; const int b = id >> 7, pp = id & 127; return sel::sel_mk(b, (i & 1) ? pp : 255 - pp); },
                              (const bf16*)(ws + WS_IQ), (const bf16*)(ws + WS_IK), (const float*)(ws + WS_IW), (unsigned long long*)(ws + WS_MASK), wave); }
        for (int rb = vcu * 64; rb < MROWS; rb += G * 64)
            sel::convmid_rows((const bf16*)(ws + WS_CB), (const bf16*)(ws + WS_P), args.in[3] + (size_t)L * 3 * 512, (bf16*)(ws + WS_A2), rb, wave);
    }
    GRID_BAR();
    {   WS_FRESH();
        for (int u = vcu; u < 512; u += G) { const int bh = (u & 255) >> 3, s = u & 7, qb = (u >> 8) ? s : 15 - s;
            if (att::attn_unit<false>(bh >> 3, bh & 7, qb, (const bf16*)(ws + WS_Q), (const bf16*)(ws + WS_K), (const bf16*)(ws + WS_V), (const unsigned long long*)(ws + WS_MASK), (bf16*)(ws + WS_A2), lds, wave))
                (void)att::attn_unit<true>(bh >> 3, bh & 7, qb, (const bf16*)(ws + WS_Q), (const bf16*)(ws + WS_K), (const bf16*)(ws + WS_V), (const unsigned long long*)(ws + WS_MASK), (bf16*)(ws + WS_A2), lds, wave); }
    }
    GRID_BAR();
    {   WS_FRESH();
        pg8::Gemm g{(const bf16*)(ws + WS_XG), (const bf16*)(ws + WS_WIN) + (size_t)L * NPALL * 1024 + (size_t)NP1 * 1024, MROWS, NPG, D_MODEL};
        pg8::StaticOrder S; S.init(MROWS, NPG, G, (int)blockIdx.x);
        RSTD_TABLE(S);
        pg8::EpiSig E{(const LAS float*)(lds + RSTD_OFF), (bf16*)(ws + WS_SG)};
        pg8::gemm_phase<pg8::EpiSig, pg8::StaticOrder, true, true>(lds + RING_OFF, g, S, E, wave);
    }
    GROUP_BAR();
    {   WS_FRESH();
        pg8::Gemm g{(const bf16*)(ws + WS_A2), (const bf16*)(ws + WS_WOC) + (size_t)L * 1024 * 1024, MROWS, D_MODEL, 1024};
        pg8::StaticOrder S; S.init(MROWS, D_MODEL, G, (int)blockIdx.x);
        pg8::EpiMerged E{(const bf16*)(ws + WS_SG), (bf16*)(ws + WS_MERGED)};
        pg8::gemm_phase<pg8::EpiMerged, pg8::StaticOrder, true, true>(lds + RING_OFF, g, S, E, wave);
    }
    GROUP_BAR();
    {   WS_FRESH();
        pg8::Gemm g{(const bf16*)(ws + WS_MERGED), (const bf16*)(ws + WS_WMIX) + (size_t)L * 1024 * 1024, MROWS, D_MODEL, 1024};
        pg8::StaticOrder S; S.init(MROWS, D_MODEL, G, (int)blockIdx.x);
        pg8::EpiResid E{(bf16*)(ws + WS_XG), (float*)nullptr, (float*)(ws + WS_ROWSQ), (const float*)nullptr, (unsigned*)nullptr, 0};
        pg8::gemm_phase<pg8::EpiResid, pg8::StaticOrder, false, true>(lds + RING_OFF, g, S, E, wave);
    }
    GRID_BAR();
    {   WS_FRESH();
        pg8::Gemm g{(const bf16*)(ws + WS_XG), (const bf16*)(ws + WS_WUP) + (size_t)L * 4096 * 1024, MROWS, MLP_H, D_MODEL};
        pg8::StaticOrder S; S.init(MROWS, MLP_H, G, (int)blockIdx.x);
        RSTD_TABLE(S);
        pg8::EpiRelu2 E{(const LAS float*)(lds + RSTD_OFF), (bf16*)(ws + WS_H)};
        pg8::gemm_phase<pg8::EpiRelu2, pg8::StaticOrder, true, true>(lds + RING_OFF, g, S, E, wave);
    }
    GROUP_BAR();
    {   WS_FRESH();
        pg8::Gemm g{(const bf16*)(ws + WS_H), (const bf16*)(ws + WS_WDN) + (size_t)L * 1024 * 4096, MROWS, D_MODEL, MLP_H};
        pg8::StaticOrder S; S.init(MROWS, D_MODEL, G, (int)blockIdx.x);
        pg8::EpiResid E{(bf16*)(ws + WS_XG), (L + 1 < DEPTH) ? (float*)nullptr : args.out, (float*)(ws + WS_ROWSQ), args.in[10], (unsigned*)(ws + WS_CTL) + CW_PANEL, group_ok ? 1 : 0};
        pg8::gemm_phase<pg8::EpiResid, pg8::StaticOrder, false, true>(lds + RING_OFF, g, S, E, wave);
    }
    if (L + 1 < DEPTH) GRID_BAR();
    }
#undef GROUP_BAR
#undef GRID_BAR
#undef lane
}

extern "C" void kernel_launch(void* const* d_in, const int* in_sizes, int n_in, void* d_out, int out_size, void* d_ws, size_t ws_size, hipStream_t stream) {
    static int grid = 0;
    if (grid == 0) {
        int dev = 0, cus = 0, per_cu = 0;
        if (n_in != 11 || out_size != MROWS * D_MODEL || ws_size < WS_END) { fprintf(stderr, "kernel_launch: unexpected problem shape / workspace (%d inputs, out %d, ws %zu)\n", n_in, out_size, ws_size); grid = -1; return; }
        if (hipGetDevice(&dev) != hipSuccess || hipDeviceGetAttribute(&cus, hipDeviceAttributeMultiprocessorCount, dev) != hipSuccess) { grid = -1; return; }
        if (hipFuncSetAttribute((const void*)mk_fwd, hipFuncAttributeMaxDynamicSharedMemorySize, LDS_BYTES) != hipSuccess) { fprintf(stderr, "kernel_launch: hipFuncSetAttribute failed\n"); grid = -1; return; }
        if (hipOccupancyMaxActiveBlocksPerMultiprocessor(&per_cu, (const void*)mk_fwd, NWAVES * 64, LDS_BYTES) != hipSuccess || per_cu < 1) { fprintf(stderr, "kernel_launch: the occupancy query admits %d workgroups per CU; nothing launched\n", per_cu); grid = -1; return; }
        (void)hipGetLastError();
        grid = cus;
    }
    if (grid < 0) return;
    if (hipMemsetAsync((char*)d_ws + WS_CTL, 0, 65536, stream) != hipSuccess) { fprintf(stderr, "kernel_launch: hipMemsetAsync failed\n"); return; }
    Args a{};
    for (int i = 0; i < 11; ++i) a.in[i] = (const float*)d_in[i];
    a.out = (float*)d_out; a.ws = (unsigned char*)d_ws;
    hipLaunchKernelGGL(mk_fwd, dim3(grid), dim3(NWAVES * 64), LDS_BYTES, stream, a);
}
```

```cpp
#include <hip/hip_runtime.h>
#include <stdint.h>
#include <math.h>
#include <cstdio>

#define D_MODEL 1024
#define BATCH 4
#define SEQ 4096
#define MROWS 16384
#define DEPTH 2
#define IN_COLS 5444
#define MLP_H 4096
#define OFF_Q 0
#define OFF_K 512
#define OFF_V 1024
#define OFF_IQ 1536
#define OFF_IK 1792
#define OFF_IW 1856
#define OFF_CB 1860
#define OFF_CC 2372
#define OFF_CH 2884
#define OFF_G 3396
#define NP1 3584
#define NPG 2048
#define NPALL 5632
#define C2F 0.18033688011112042f

typedef unsigned short bf16;
#define LAS __attribute__((address_space(3)))
#define GAS __attribute__((address_space(1)))
__device__ __forceinline__ unsigned f2bf(float f) { unsigned u = __builtin_bit_cast(unsigned, f); return (u + 0x7fffu + ((u >> 16) & 1u)) >> 16; }
__device__ __forceinline__ unsigned pk2(float lo, float hi) { return f2bf(lo) | (f2bf(hi) << 16); }
__device__ __forceinline__ float bf2f(unsigned short b) { return __builtin_bit_cast(float, ((unsigned)b) << 16); }

constexpr size_t MiB = 1u << 20;
constexpr size_t WS_CTL = 0, CTL_ZERO_BYTES = 1 * MiB;
constexpr size_t WS_CS = 1 * MiB;
constexpr size_t WS_ROWSQ = 1 * MiB + 512 * 1024;
constexpr size_t WS_IW = 1 * MiB + 768 * 1024;
constexpr size_t WS_WIN = 2 * MiB;
constexpr size_t WS_WOC = 24 * MiB;
constexpr size_t WS_WMIX = 28 * MiB;
constexpr size_t WS_WUP = 32 * MiB;
constexpr size_t WS_WDN = 48 * MiB;
constexpr size_t WS_XG = 64 * MiB;
constexpr size_t WS_Q = 96 * MiB, WS_K = 112 * MiB, WS_V = 128 * MiB;
constexpr size_t WS_IQ = 144 * MiB;
constexpr size_t WS_IK = 152 * MiB;
constexpr size_t WS_MASK = 154 * MiB;
constexpr size_t WS_CB = 162 * MiB, WS_P = 178 * MiB;
constexpr size_t WS_A2 = 194 * MiB;
constexpr size_t WS_SG = 96 * MiB;
constexpr size_t WS_MERGED = 160 * MiB;
constexpr size_t WS_H = 96 * MiB;
constexpr size_t WS_END = 256 * MiB;

namespace pg8 {
#define PG8_LAS __attribute__((address_space(3)))
typedef unsigned short bf16_t;
typedef short bf16x8 __attribute__((ext_vector_type(8)));
typedef float f32x4 __attribute__((ext_vector_type(4)));
typedef unsigned u32x4 __attribute__((ext_vector_type(4)));
constexpr int BM = 256, BK = 64, HALF = 128, HTB = HALF * BK * 2  , STAGE_BYTES = 8 * HTB, NXCD = 8, WGM = 8;

__host__ __device__ __forceinline__ int lds_byte(int r, int c) { const int st = (r >> 4) * 2 + (c >> 5), rr = r & 15, cc = c & 31, ob = rr * 64 + cc * 2; return st * 1024 + (ob ^ (((ob >> 9) & 1) << 5)); }
__host__ __device__ __forceinline__ void stage_rc(int b, int& R, int& C) { const int st = b / 1024, sb = b % 1024, swz = sb ^ (((sb >> 9) & 1) << 5); R = (st >> 1) * 16 + swz / 64; C = (st & 1) * 32 + (swz % 64) / 2; }
__host__ __device__ __forceinline__ int perm32(int rho) { const int n = rho >> 4, i = rho & 15; return 8 * (i >> 2) + 4 * n + (i & 3); }

struct Unit { int pm, pn; };
struct Gemm { const bf16_t* A; const bf16_t* Bt; int M, N, K; };

struct StaticOrder {
    int nM, nN, nwg, G, c;
    __host__ __device__ __forceinline__ void init(int M, int N, int G_, int c_) { nM = M / BM; nN = N / BM; nwg = nM * nN; G = G_; c = c_; }
    __host__ __device__ __forceinline__ bool next(int i, Unit& u) const {
        const long L = (long)i * G + c; if (L >= nwg) return false;
        int wgid = (int)L; { const int q = nwg / NXCD, r = nwg % NXCD, xcd = wgid % NXCD, off = wgid / NXCD; wgid = (xcd < r ? xcd * (q + 1) : r * (q + 1) + (xcd - r) * q) + off; }
        const int nig = WGM * nN, gid = wgid / nig, fm = gid * WGM, gsz = (nM - fm) < WGM ? (nM - fm) : WGM;
        u.pm = fm + ((wgid % nig) % gsz); u.pn = (wgid % nig) / gsz; return true;
    }
    __device__ __forceinline__ void a_ready(const Unit&) const {}
    __device__ __forceinline__ void done(const Unit&) const {}
};
typedef float cvt_f32x2_t __attribute__((ext_vector_type(2))); typedef __bf16 cvt_bf16x2_t __attribute__((ext_vector_type(2)));
__device__ __forceinline__ unsigned cvt_pk_bf16(float lo, float hi) { cvt_f32x2_t v = {lo, hi}; cvt_bf16x2_t b = __builtin_convertvector(v, cvt_bf16x2_t); return __builtin_bit_cast(unsigned, b); }
typedef float f32x2 __attribute__((ext_vector_type(2)));
__device__ __forceinline__ int lane_now() { int l; asm volatile("v_mbcnt_lo_u32_b32 %0, -1, 0\n\tv_mbcnt_hi_u32_b32 %0, -1, %0" : "=v"(l)); return l; }
__device__ __forceinline__ float row_rstd(const float* rowsq, int row) {
    const float s = (rowsq[row] + rowsq[MROWS + row]) + (rowsq[2 * MROWS + row] + rowsq[3 * MROWS + row]);
    return __builtin_amdgcn_rsqf(s * (1.0f / 1024.0f) + 1e-6f);
}
struct EpiProj {
    static constexpr bool PERM = true, AFTER_DRAIN = false, HAS_MID = false;
    const PG8_LAS float* rst; const float* cs; bf16_t *Q, *K, *V, *IQ, *IK, *CB, *P; float* IW;
    __device__ __forceinline__ void operator()(const f32x4 (&acc)[2][2][4][2], const Unit& u, int wr, int wc, int, int) const {
        const int ln_ = lane_now(), fr = ln_ & 15, fq = ln_ >> 4;
        const int pn = u.pn, row0 = u.pm * BM + wr * 64 + fr;
        if (pn == 7) {
            if (wc >= 3) return;
            const bool ropeL = (wc == 0) && (fq < 2);
#pragma unroll
            for (int ai = 0; ai < 2; ++ai)
#pragma unroll
                for (int m = 0; m < 4; ++m) {
                    const int row = row0 + ai * HALF + m * 16; const float rs = rst[row & 255]; const int t = row & (SEQ - 1);
                    const f32x4 v0 = acc[ai][0][m][0] * rs, v1 = acc[ai][0][m][1] * rs;
                    if (wc < 2) {
                        f32x4 c4 = (f32x4){1.f, 1.f, 1.f, 1.f}, s4 = (f32x4){0.f, 0.f, 0.f, 0.f};
                        if (ropeL) { c4 = *(const f32x4*)(cs + t * 8 + 4 * fq); s4 = *(const f32x4*)(cs + SEQ * 8 + t * 8 + 4 * fq); }
                        const f32x4 o0 = v0 * c4 - v1 * s4, o1 = v1 * c4 + v0 * s4;
                        u32x4 w; w.x = cvt_pk_bf16(o0[0], o0[1]); w.y = cvt_pk_bf16(o0[2], o0[3]); w.z = cvt_pk_bf16(o1[0], o1[1]); w.w = cvt_pk_bf16(o1[2], o1[3]);
                        *(u32x4*)(IK + ((size_t)(row >> 4) * 8 + wc * 4 + fq) * 128 + (row & 15) * 8) = w;
                    } else if (fq == 0) {
                        *(f32x4*)(IW + (size_t)row * 4) = v0;
                    }
                }
            return;
        }
        if (pn >= 10) {
#pragma unroll
            for (int ai = 0; ai < 2; ++ai)
#pragma unroll
                for (int m = 0; m < 4; ++m) {
                    const int row = row0 + ai * HALF + m * 16; const float rs = rst[row & 255]; const float rs2 = rs * rs;
#pragma unroll
                    for (int bj = 0; bj < 2; ++bj) {
                        const f32x4 p = acc[ai][bj][m][0] * acc[ai][bj][m][1] * rs2;
                        unsigned long long w = (unsigned long long)cvt_pk_bf16(p[0], p[1]) | ((unsigned long long)cvt_pk_bf16(p[2], p[3]) << 32);
                        *(unsigned long long*)(P + (size_t)row * 512 + (((pn - 10) * 256 + bj * HALF + wc * 32 + 8 * fq) >> 1)) = w;
                    }
                }
            return;
        }
        bf16_t* dst; int pitch, colb; float sc = 1.f; bool rope = false;
        if (pn < 2) { dst = Q; pitch = 512; colb = pn * 256; sc = C2F; rope = true; }
        else if (pn < 4) { dst = K; pitch = 512; colb = (pn - 2) * 256; rope = true; }
        else if (pn < 6) { dst = V; pitch = 512; colb = (pn - 4) * 256; }
        else if (pn == 6) { dst = IQ; pitch = 256; colb = 0; rope = true; }
        else { dst = CB; pitch = 512; colb = (pn - 8) * 256; }
        const bool ropeL = rope && ((wc & 1) == 0) && (fq < 2);
#pragma unroll
        for (int ai = 0; ai < 2; ++ai) {
            f32x4 c4[4], s4[4];
#pragma unroll
            for (int m = 0; m < 4; ++m) { c4[m] = (f32x4){1.f, 1.f, 1.f, 1.f}; s4[m] = (f32x4){0.f, 0.f, 0.f, 0.f}; }
            if (ropeL) {
#pragma unroll
                for (int m = 0; m < 4; ++m) { const int t = (row0 + ai * HALF + m * 16) & (SEQ - 1); c4[m] = *(const f32x4*)(cs + t * 8 + 4 * fq); s4[m] = *(const f32x4*)(cs + SEQ * 8 + t * 8 + 4 * fq); }
            }
            __builtin_amdgcn_sched_barrier(0);
#pragma unroll
            for (int m = 0; m < 4; ++m) {
                const int row = row0 + ai * HALF + m * 16; const float rs = rst[row & 255] * sc;
                bf16_t* rowp = dst + (size_t)row * pitch + colb + wc * 32 + 8 * fq;
#pragma unroll
                for (int bj = 0; bj < 2; ++bj) {
                    const f32x4 v0 = acc[ai][bj][m][0] * rs, v1 = acc[ai][bj][m][1] * rs;
                    const f32x4 o0 = v0 * c4[m] - v1 * s4[m], o1 = v1 * c4[m] + v0 * s4[m];
                    u32x4 w; w.x = cvt_pk_bf16(o0[0], o0[1]); w.y = cvt_pk_bf16(o0[2], o0[3]); w.z = cvt_pk_bf16(o1[0], o1[1]); w.w = cvt_pk_bf16(o1[2], o1[3]);
                    if (pn == 6) *(u32x4*)(IQ + ((size_t)(row >> 4) * 32 + bj * 16 + wc * 4 + fq) * 128 + (row & 15) * 8) = w;
                    else *(u32x4*)(rowp + bj * HALF) = w;
                }
            }
        }
    }
};
struct EpiSig {
    static constexpr bool PERM = true, AFTER_DRAIN = false, HAS_MID = false;
    const PG8_LAS float* rst; bf16_t* SG;
    __device__ __forceinline__ void operator()(const f32x4 (&acc)[2][2][4][2], const Unit& u, int wr, int wc, int, int) const {
        const int ln_ = lane_now(), fr = ln_ & 15, fq = ln_ >> 4;
        const int row0 = u.pm * BM + wr * 64 + fr, col0 = u.pn * HALF + wc * 32 + 8 * fq;
#pragma unroll
        for (int ai = 0; ai < 2; ++ai)
#pragma unroll
            for (int m = 0; m < 4; ++m) {
                const int row = row0 + ai * HALF + m * 16; const float rs = rst[row & 255] * (-1.4426950408889634f);
                bf16_t* rowp = SG + (size_t)row * NPG + col0;
                f32x4 a0 = acc[ai][0][m][0] * rs, a1 = acc[ai][0][m][1] * rs, c0 = acc[ai][1][m][0] * rs, c1 = acc[ai][1][m][1] * rs;
#pragma unroll
                for (int j = 0; j < 4; ++j) {
                    const float ea0 = 1.0f + __builtin_amdgcn_exp2f(a0[j]), ea1 = 1.0f + __builtin_amdgcn_exp2f(a1[j]), ec0 = 1.0f + __builtin_amdgcn_exp2f(c0[j]), ec1 = 1.0f + __builtin_amdgcn_exp2f(c1[j]);
                    a0[j] = ec0 * __builtin_amdgcn_rcpf(ea0); a1[j] = ec1 * __builtin_amdgcn_rcpf(ea1);
                    c0[j] = __builtin_amdgcn_rcpf(ec0); c1[j] = __builtin_amdgcn_rcpf(ec1); }
                u32x4 w; w.x = cvt_pk_bf16(a0[0], a0[1]); w.y = cvt_pk_bf16(a0[2], a0[3]); w.z = cvt_pk_bf16(a1[0], a1[1]); w.w = cvt_pk_bf16(a1[2], a1[3]);
                *(u32x4*)(rowp) = w;
                w.x = cvt_pk_bf16(c0[0], c0[1]); w.y = cvt_pk_bf16(c0[2], c0[3]); w.z = cvt_pk_bf16(c1[0], c1[1]); w.w = cvt_pk_bf16(c1[2], c1[3]);
                *(u32x4*)(rowp + 1024) = w;
            }
    }
};
struct EpiMerged {
    static constexpr bool PERM = true, AFTER_DRAIN = false, HAS_MID = true;
    const bf16_t* SG; bf16_t* O;
    __device__ __forceinline__ void mid(f32x4 (&acc)[2][2][4][2], const Unit& u, int wr, int wc, int, int) const {
        const int ln_ = lane_now(), fr = ln_ & 15, fq = ln_ >> 4;
        const int row0 = u.pm * BM + wr * 64 + fr, col0 = u.pn * BM + wc * 32 + 8 * fq;
#pragma unroll
        for (int ai = 0; ai < 2; ++ai) {
            u32x4 rin[4][2];
#pragma unroll
            for (int m = 0; m < 4; ++m)
#pragma unroll
                for (int bj = 0; bj < 2; ++bj) rin[m][bj] = *(const u32x4*)(SG + (size_t)(row0 + ai * HALF + m * 16) * NPG + col0 + bj * HALF);
            __builtin_amdgcn_sched_barrier(0);
#pragma unroll
            for (int m = 0; m < 4; ++m)
#pragma unroll
                for (int bj = 0; bj < 2; ++bj) {
                    const u32x4 a = rin[m][bj];
#pragma unroll
                    for (int j = 0; j < 4; ++j) {
                        const float r0 = __builtin_bit_cast(float, a[j] << 16), r1 = __builtin_bit_cast(float, a[j] & 0xffff0000u);
                        acc[ai][bj][m][j >> 1][(j & 1) * 2] *= r0; acc[ai][bj][m][j >> 1][(j & 1) * 2 + 1] *= r1;
                    }
                }
        }
    }
    __device__ __forceinline__ void operator()(const f32x4 (&acc)[2][2][4][2], const Unit& u, int wr, int wc, int, int) const {
        const int ln_ = lane_now(), fr = ln_ & 15, fq = ln_ >> 4;
        const int row0 = u.pm * BM + wr * 64 + fr, col0 = u.pn * BM + wc * 32 + 8 * fq;
#pragma unroll
        for (int ai = 0; ai < 2; ++ai) {
            u32x4 cin[4][2];
#pragma unroll
            for (int m = 0; m < 4; ++m)
#pragma unroll
                for (int bj = 0; bj < 2; ++bj) cin[m][bj] = *(const u32x4*)(SG + (size_t)(row0 + ai * HALF + m * 16) * NPG + 1024 + col0 + bj * HALF);
            __builtin_amdgcn_sched_barrier(0);
#pragma unroll
            for (int m = 0; m < 4; ++m) {
                const int row = row0 + ai * HALF + m * 16;
                bf16_t* rowp = O + (size_t)row * 1024 + col0;
#pragma unroll
                for (int bj = 0; bj < 2; ++bj) {
                    const u32x4 c = cin[m][bj];
                    float o[8];
#pragma unroll
                    for (int j = 0; j < 4; ++j) {
                        const float c0 = __builtin_bit_cast(float, c[j] << 16), c1 = __builtin_bit_cast(float, c[j] & 0xffff0000u);
                        o[2 * j] = acc[ai][bj][m][j >> 1][(j & 1) * 2] * c0; o[2 * j + 1] = acc[ai][bj][m][j >> 1][(j & 1) * 2 + 1] * c1;
                    }
                    u32x4 w; w.x = cvt_pk_bf16(o[0], o[1]); w.y = cvt_pk_bf16(o[2], o[3]); w.z = cvt_pk_bf16(o[4], o[5]); w.w = cvt_pk_bf16(o[6], o[7]);
                    *(u32x4*)(rowp + bj * HALF) = w;
                }
            }
        }
    }
};
struct EpiRelu2 {
    static constexpr bool PERM = true, AFTER_DRAIN = false, HAS_MID = false;
    const PG8_LAS float* rst; bf16_t* O;
    __device__ __forceinline__ void operator()(const f32x4 (&acc)[2][2][4][2], const Unit& u, int wr, int wc, int, int) const {
        const int ln_ = lane_now(), fr = ln_ & 15, fq = ln_ >> 4;
        const int row0 = u.pm * BM + wr * 64 + fr, col0 = u.pn * BM + wc * 32 + 8 * fq;
#pragma unroll
        for (int ai = 0; ai < 2; ++ai)
#pragma unroll
            for (int m = 0; m < 4; ++m) {
                const int row = row0 + ai * HALF + m * 16; const float rs = rst[row & 255];
                bf16_t* rowp = O + (size_t)row * MLP_H + col0;
#pragma unroll
                for (int bj = 0; bj < 2; ++bj) {
                    f32x4 v0 = acc[ai][bj][m][0] * rs, v1 = acc[ai][bj][m][1] * rs;
#pragma unroll
                    for (int j = 0; j < 4; ++j) { const float a = fmaxf(v0[j], 0.f), b = fmaxf(v1[j], 0.f); v0[j] = a * a; v1[j] = b * b; }
                    u32x4 w; w.x = cvt_pk_bf16(v0[0], v0[1]); w.y = cvt_pk_bf16(v0[2], v0[3]); w.z = cvt_pk_bf16(v1[0], v1[1]); w.w = cvt_pk_bf16(v1[2], v1[3]);
                    *(u32x4*)(rowp + bj * HALF) = w;
                }
            }
    }
};
struct EpiResid {
    static constexpr bool PERM = true, AFTER_DRAIN = true, HAS_MID = false;
    bf16_t* xb; float* outf; float* rowsq; const float* gfin; unsigned* pcnt; int same_xcc;
    __device__ __forceinline__ void fused(f32x4 (&acc)[2][2][4][2], const Unit& u, int wr, int wc, int, int, PG8_LAS unsigned char* lds, int wid, int) const {
        const int lane = lane_now(), fr = lane & 15, fq = lane >> 4;
        PG8_LAS float* Pt = (PG8_LAS float*)lds;
        const int col0 = u.pn * BM + wc * 32 + 8 * fq;
        const bool last = (outf != nullptr);
#pragma unroll
        for (int ai = 0; ai < 2; ++ai) {
        u32x4 xin[4][2];
#pragma unroll
        for (int m = 0; m < 4; ++m)
#pragma unroll
            for (int bj = 0; bj < 2; ++bj) xin[m][bj] = *(const u32x4*)(xb + (size_t)(u.pm * BM + ai * HALF + wr * 64 + m * 16 + fr) * D_MODEL + col0 + bj * HALF);
        __builtin_amdgcn_sched_barrier(0);
#pragma unroll
            for (int m = 0; m < 4; ++m) {
                const int r = ai * HALF + wr * 64 + m * 16 + fr; const size_t off = (size_t)(u.pm * BM + r) * D_MODEL + col0; float s = 0.f;
#pragma unroll
                for (int bj = 0; bj < 2; ++bj) {
                    const u32x4 b = xin[m][bj];
                    f32x4 x0, x1;
                    x0[0] = __builtin_bit_cast(float, b[0] << 16); x0[1] = __builtin_bit_cast(float, b[0] & 0xffff0000u); x0[2] = __builtin_bit_cast(float, b[1] << 16); x0[3] = __builtin_bit_cast(float, b[1] & 0xffff0000u);
                    x1[0] = __builtin_bit_cast(float, b[2] << 16); x1[1] = __builtin_bit_cast(float, b[2] & 0xffff0000u); x1[2] = __builtin_bit_cast(float, b[3] << 16); x1[3] = __builtin_bit_cast(float, b[3] & 0xffff0000u);
                    x0 = x0 + acc[ai][bj][m][0]; x1 = x1 + acc[ai][bj][m][1];
                    if (last) { acc[ai][bj][m][0] = x0; acc[ai][bj][m][1] = x1; }
                    else { u32x4 w; w[0] = cvt_pk_bf16(x0[0], x0[1]); w[1] = cvt_pk_bf16(x0[2], x0[3]); w[2] = cvt_pk_bf16(x1[0], x1[1]); w[3] = cvt_pk_bf16(x1[2], x1[3]);
                        *(u32x4*)(xb + off + bj * HALF) = w;
                        x0[0] = __builtin_bit_cast(float, w[0] << 16); x0[1] = __builtin_bit_cast(float, w[0] & 0xffff0000u); x0[2] = __builtin_bit_cast(float, w[1] << 16); x0[3] = __builtin_bit_cast(float, w[1] & 0xffff0000u);
                        x1[0] = __builtin_bit_cast(float, w[2] << 16); x1[1] = __builtin_bit_cast(float, w[2] & 0xffff0000u); x1[2] = __builtin_bit_cast(float, w[3] << 16); x1[3] = __builtin_bit_cast(float, w[3] & 0xffff0000u); }
                    s += ((x0[0] * x0[0] + x0[1] * x0[1]) + (x0[2] * x0[2] + x0[3] * x0[3])) + ((x1[0] * x1[0] + x1[1] * x1[1]) + (x1[2] * x1[2] + x1[3] * x1[3]));
                }
                s += __shfl_xor(s, 16); s += __shfl_xor(s, 32);
                if (fq == 0) Pt[r * 4 + wc] = s;
                asm volatile("" ::: "memory");
            }
        }
        asm volatile("s_waitcnt lgkmcnt(0)" ::: "memory"); __builtin_amdgcn_s_barrier(); asm volatile("" ::: "memory");
        const int tid = wid * 64 + lane;
        if (tid < 256) rowsq[(size_t)u.pn * MROWS + u.pm * BM + tid] = (Pt[tid * 4] + Pt[tid * 4 + 1]) + (Pt[tid * 4 + 2] + Pt[tid * 4 + 3]);
        if (!last) return;
        asm volatile("s_waitcnt vmcnt(0)" ::: "memory"); __builtin_amdgcn_s_barrier(); asm volatile("" ::: "memory");
        if (tid == 0) {
            if (!same_xcc) __builtin_amdgcn_fence(__ATOMIC_RELEASE, "agent");
            asm volatile("s_waitcnt vmcnt(0)" ::: "memory");
            unsigned* c = pcnt + 64 * u.pm;
            __hip_atomic_fetch_add(c, 1u, __ATOMIC_RELAXED, __HIP_MEMORY_SCOPE_AGENT);
            unsigned sp = 0u;
            while (__hip_atomic_load(c, __ATOMIC_RELAXED, __HIP_MEMORY_SCOPE_AGENT) < 4u) { __builtin_amdgcn_s_sleep(1); if (++sp > (1u << 20)) break; }
            __builtin_amdgcn_fence(__ATOMIC_ACQUIRE, "agent");
            asm volatile("s_waitcnt vmcnt(0)" ::: "memory");
        }
        asm volatile("" ::: "memory"); __builtin_amdgcn_s_barrier(); asm volatile("" ::: "memory");
        f32x4 gv[2][2];
#pragma unroll
        for (int bj = 0; bj < 2; ++bj)
#pragma unroll
            for (int n = 0; n < 2; ++n) gv[bj][n] = *(const f32x4*)(gfin + col0 + bj * HALF + n * 4);
        float rs8[8];
#pragma unroll
        for (int i = 0; i < 8; ++i) rs8[i] = row_rstd(rowsq, u.pm * BM + (i >> 2) * HALF + wr * 64 + (i & 3) * 16 + fr);
        __builtin_amdgcn_sched_barrier(0);
#pragma unroll
        for (int ai = 0; ai < 2; ++ai)
#pragma unroll
            for (int m = 0; m < 4; ++m) {
                const int row = u.pm * BM + ai * HALF + wr * 64 + m * 16 + fr; const size_t off = (size_t)row * D_MODEL + col0;
                const float rs = rs8[ai * 4 + m];
#pragma unroll
                for (int bj = 0; bj < 2; ++bj)
#pragma unroll
                    for (int n = 0; n < 2; ++n) *(f32x4*)(outf + off + bj * HALF + n * 4) = acc[ai][bj][m][n] * rs * gv[bj][n];
            }
    }
};
template <class Epi, class Sched, bool ALIGN_EPI = false, bool SP2 = false>
__device__ __forceinline__ void gemm_phase(PG8_LAS unsigned char* lds, const Gemm g, const Sched& S, const Epi& E, const int wid) {
    const int lane = lane_now(), tid = wid * 64 + lane, wr = wid >> 2, wc = wid & 3, fr = lane & 15, fq = lane >> 4;
    const int K = g.K, nt = K / BK;
    unsigned voffA[2], voffB[2];
#pragma unroll
    for (int i = 0; i < 2; ++i) { int R, C; stage_rc(tid * 16 + i * 8192, R, C); const int Rb = Epi::PERM ? ((R & ~31) + perm32(R & 31)) : R;
        voffA[i] = (unsigned)(R * K + C) * 2u; voffB[i] = (unsigned)(Rb * K + C) * 2u; }
    const size_t kstep = (size_t)(BK * 2);
    const size_t hstep = (size_t)HALF * K * 2;
    const size_t tstep = 2 * hstep;
    const unsigned ldsw = (unsigned)wid * 1024u;
    const int aoff = lds_byte(wr * 64 + fr, fq * 8), boff = lds_byte(wc * 32 + fr, fq * 8);
#define PG8_SA(b, h) (((b) * 2 + (h)) * HTB)
#define PG8_SB(b, h) ((4 + (b) * 2 + (h)) * HTB)
#define PG8_STAGE(bufoff, gbase, voff) do { _Pragma("unroll") for (int _i = 0; _i < 2; ++_i) \
        __builtin_amdgcn_global_load_lds((const unsigned*)((const char*)(gbase) + (voff)[_i]), (PG8_LAS unsigned*)(lds + (bufoff) + ldsw + _i * 8192), 16, 0, 0); } while (0)
#define PG8_LDA(dst, b, h) do { _Pragma("unroll") for (int m = 0; m < 4; ++m) _Pragma("unroll") for (int k = 0; k < 2; ++k) dst[m][k] = *(const PG8_LAS bf16x8*)(lds + PG8_SA(b, h) + aoff + m * 2048 + k * 1024); } while (0)
#define PG8_LDB(dst, b, h) do { _Pragma("unroll") for (int n = 0; n < 2; ++n) _Pragma("unroll") for (int k = 0; k < 2; ++k) dst[n][k] = *(const PG8_LAS bf16x8*)(lds + PG8_SB(b, h) + boff + n * 2048 + k * 1024); } while (0)
#define PG8_MMA(ai, bj, At, Bt) do { __builtin_amdgcn_s_setprio(1); _Pragma("unroll") for (int m = 0; m < 4; ++m) _Pragma("unroll") for (int n = 0; n < 2; ++n) _Pragma("unroll") for (int k = 0; k < 2; ++k) \
        acc[ai][bj][m][n] = __builtin_amdgcn_mfma_f32_16x16x32_bf16(Bt[n][k], At[m][k], acc[ai][bj][m][n], 0, 0, 0); __builtin_amdgcn_s_setprio(0); } while (0)
#define PG8_WAIT_V(n) asm volatile("s_waitcnt vmcnt(" #n ")" ::: "memory")
#define PG8_WAIT_L(n) asm volatile("s_waitcnt lgkmcnt(" #n ")" ::: "memory")
#define PG8_BAR __builtin_amdgcn_s_barrier()
#define PG8_SCHED __builtin_amdgcn_sched_barrier(0)
    Unit cur, nxt; int ui = 0;
    if (!S.next(0, cur)) return;
    f32x4 acc[2][2][4][2];
#pragma unroll
    for (int a = 0; a < 2; ++a)
#pragma unroll
        for (int b = 0; b < 2; ++b)
#pragma unroll
            for (int m = 0; m < 4; ++m)
#pragma unroll
                for (int n = 0; n < 2; ++n) acc[a][b][m][n] = (f32x4){0.f, 0.f, 0.f, 0.f};
    bf16x8 At[4][2], B0[2][2], B1[2][2];
    const char* cA = (const char*)g.A + (size_t)cur.pm * tstep; const char* cB = (const char*)g.Bt + (size_t)cur.pn * tstep;
    S.a_ready(cur);
    if constexpr (SP2) {
        PG8_STAGE(PG8_SB(0, 0), cB, voffB); PG8_STAGE(PG8_SB(0, 1), cB + hstep, voffB); PG8_STAGE(PG8_SA(0, 0), cA, voffA); PG8_STAGE(PG8_SA(0, 1), cA + hstep, voffA);
        if (wr == 1) PG8_BAR;
        PG8_WAIT_V(2); PG8_BAR;
        PG8_STAGE(PG8_SB(1, 0), cB + kstep, voffB); PG8_STAGE(PG8_SA(1, 0), cA + kstep, voffA); PG8_STAGE(PG8_SB(1, 1), cB + hstep + kstep, voffB);
        PG8_WAIT_V(6); PG8_BAR;
    } else {
        PG8_STAGE(PG8_SB(0, 0), cB, voffB); PG8_STAGE(PG8_SA(0, 0), cA, voffA); PG8_STAGE(PG8_SB(0, 1), cB + hstep, voffB); PG8_STAGE(PG8_SA(0, 1), cA + hstep, voffA);
        if (wr == 1) PG8_BAR;
        PG8_WAIT_V(4); PG8_BAR;
        PG8_STAGE(PG8_SB(1, 0), cB + kstep, voffB); PG8_STAGE(PG8_SA(1, 0), cA + kstep, voffA); PG8_STAGE(PG8_SB(1, 1), cB + hstep + kstep, voffB);
        PG8_WAIT_V(6); PG8_BAR;
    }
    for (;;) {
        const bool has_next = S.next(ui + 1, nxt);
        const char* nA = has_next ? (const char*)g.A + (size_t)nxt.pm * tstep : cA; const char* nB = has_next ? (const char*)g.Bt + (size_t)nxt.pn * tstep : cB;
        for (int t = 0; t < nt; t += 2) {
            const bool last = (t == nt - 2);
            const char* a1 = cA + (size_t)(t + 1) * kstep;
            const char* a2 = last ? nA : cA + (size_t)(t + 2) * kstep; const char* b2 = last ? nB : cB + (size_t)(t + 2) * kstep;
            const char* a3 = a2 + kstep; const char* b3 = b2 + kstep;
            if (last && has_next) S.a_ready(nxt);
            if constexpr (Epi::HAS_MID) { if (t == (nt >> 1)) E.mid(acc, cur, wr, wc, fr, fq); }
            if constexpr (SP2) {
            PG8_LDB(B0, 0, 0); PG8_LDB(B1, 0, 1); PG8_SCHED; PG8_LDA(At, 0, 0); PG8_STAGE(PG8_SA(1, 1), a1 + hstep, voffA);
            PG8_WAIT_V(8); PG8_WAIT_L(0); PG8_BAR; PG8_MMA(0, 0, At, B0); PG8_MMA(0, 1, At, B1); PG8_BAR; PG8_SCHED;
            PG8_LDA(At, 0, 1); PG8_STAGE(PG8_SB(0, 0), b2, voffB); PG8_STAGE(PG8_SB(0, 1), b2 + hstep, voffB); PG8_STAGE(PG8_SA(0, 0), a2, voffA);
            PG8_WAIT_V(8); PG8_WAIT_L(0); PG8_BAR; PG8_MMA(1, 0, At, B0); PG8_MMA(1, 1, At, B1); PG8_BAR; PG8_SCHED;
            PG8_LDB(B0, 1, 0); PG8_LDB(B1, 1, 1); PG8_SCHED; PG8_LDA(At, 1, 0); PG8_STAGE(PG8_SA(0, 1), a2 + hstep, voffA);
            PG8_WAIT_V(8); PG8_WAIT_L(0); PG8_BAR; PG8_MMA(0, 0, At, B0); PG8_MMA(0, 1, At, B1); PG8_BAR; PG8_SCHED;
            PG8_LDA(At, 1, 1); PG8_STAGE(PG8_SB(1, 0), b3, voffB); PG8_STAGE(PG8_SB(1, 1), b3 + hstep, voffB); PG8_STAGE(PG8_SA(1, 0), a3, voffA);
            PG8_WAIT_V(8); PG8_WAIT_L(0); PG8_BAR; PG8_MMA(1, 0, At, B0); PG8_MMA(1, 1, At, B1); PG8_BAR; PG8_SCHED;
            } else {
            PG8_LDB(B0, 0, 0); PG8_SCHED; PG8_LDA(At, 0, 0); PG8_STAGE(PG8_SA(1, 1), a1 + hstep, voffA);
            PG8_WAIT_L(8); PG8_BAR; PG8_WAIT_L(0); PG8_MMA(0, 0, At, B0); PG8_BAR; PG8_SCHED;
            PG8_LDB(B1, 0, 1); PG8_STAGE(PG8_SB(0, 0), b2, voffB);
            PG8_BAR; PG8_WAIT_L(0); PG8_MMA(0, 1, At, B1); PG8_BAR;
            PG8_LDA(At, 0, 1); PG8_STAGE(PG8_SA(0, 0), a2, voffA);
            PG8_BAR; PG8_WAIT_L(0); PG8_MMA(1, 0, At, B0); PG8_BAR; PG8_SCHED;
            PG8_STAGE(PG8_SB(0, 1), b2 + hstep, voffB);
            PG8_WAIT_V(6); PG8_BAR; PG8_MMA(1, 1, At, B1); PG8_BAR;
            PG8_LDB(B0, 1, 0); PG8_SCHED; PG8_LDA(At, 1, 0); PG8_STAGE(PG8_SA(0, 1), a2 + hstep, voffA);
            PG8_WAIT_L(8); PG8_BAR; PG8_WAIT_L(0); PG8_MMA(0, 0, At, B0); PG8_BAR; PG8_SCHED;
            PG8_LDB(B1, 1, 1); PG8_STAGE(PG8_SB(1, 0), b3, voffB);
            PG8_BAR; PG8_WAIT_L(0); PG8_MMA(0, 1, At, B1); PG8_BAR;
            PG8_LDA(At, 1, 1); PG8_STAGE(PG8_SA(1, 0), a3, voffA);
            PG8_BAR; PG8_WAIT_L(0); PG8_MMA(1, 0, At, B0); PG8_BAR; PG8_SCHED;
            PG8_STAGE(PG8_SB(1, 1), b3 + hstep, voffB);
            PG8_WAIT_V(6); PG8_BAR; PG8_MMA(1, 1, At, B1); PG8_BAR;
            }
        }
        if constexpr (ALIGN_EPI) { if (wr == 0) PG8_BAR; }
        if constexpr (!Epi::AFTER_DRAIN) { E(acc, cur, wr, wc, fr, fq); S.done(cur); }
        if (!has_next) break;
#pragma unroll
        for (int a = 0; a < 2; ++a)
#pragma unroll
            for (int b = 0; b < 2; ++b)
#pragma unroll
                for (int m = 0; m < 4; ++m)
#pragma unroll
                    for (int n = 0; n < 2; ++n) acc[a][b][m][n] = (f32x4){0.f, 0.f, 0.f, 0.f};
        cur = nxt; cA = nA; cB = nB; ++ui;
        if constexpr (ALIGN_EPI) { if (wr == 1) PG8_BAR; }
    }
    PG8_WAIT_V(0);
    if constexpr (!ALIGN_EPI) { if (wr == 0) PG8_BAR; }
    PG8_BAR;
    if constexpr (Epi::AFTER_DRAIN) { E.fused(acc, cur, wr, wc, fr, fq, lds, wid, lane); S.done(cur); }
#undef PG8_SA
#undef PG8_SB
#undef PG8_STAGE
#undef PG8_LDA
#undef PG8_LDB
#undef PG8_MMA
#undef PG8_WAIT_V
#undef PG8_WAIT_L
#undef PG8_BAR
#undef PG8_SCHED
}
}
constexpr int NWAVES = 8;
constexpr int RING_OFF = 0, RING_BYTES = 131072;
constexpr int LDS_BYTES = 147456;
constexpr int MISC_OFF = 140000;
static_assert(MISC_OFF % 16 == 0 && MISC_OFF + 256 <= LDS_BYTES, "LDS map");
constexpr int RSTD_OFF = MISC_OFF + 1024;
static_assert(RSTD_OFF + 1024 <= LDS_BYTES, "LDS map");

typedef unsigned v4u __attribute__((ext_vector_type(4)));
typedef float f32x4 __attribute__((ext_vector_type(4)));
#define LDS_WAIT() asm volatile("s_waitcnt lgkmcnt(0)" ::: "memory")
#define VM_WAIT() asm volatile("s_waitcnt vmcnt(0)" ::: "memory")

__device__ __forceinline__ float wave_sum(float v) {
#pragma unroll
    for (int o = 1; o < 64; o <<= 1) v += __shfl_xor(v, o);
    return v;
}

__device__ __forceinline__ int rperm(int p) { return p < 16 ? ((p & 3) | ((p & 4) << 1) | ((p & 8) >> 1)) : p; }
__device__ __forceinline__ int win_src_col(int n) {
    if (n < 512) return OFF_Q + (n & ~63) + rperm(n & 63);
    if (n < 1024) { const int m = n - 512; return OFF_K + (m & ~63) + rperm(m & 63); }
    if (n < 1536) return OFF_V + (n - 1024);
    if (n < 1792) { const int m = n - 1536; return OFF_IQ + (m & ~63) + rperm(m & 63); }
    if (n < 1856) return OFF_IK + rperm(n - 1792);
    if (n < 1860) return OFF_IW + (n - 1856);
    if (n < 2048) return -1;
    if (n < 2560) return OFF_CB + (n - 2048);
    if (n < 3584) { const int m = n - 2560, G = m >> 3, i = m & 7; return i < 4 ? OFF_CC + 4 * G + i : OFF_CH + 4 * G + (i - 4); }
    { const int g = n - 3584, T = g >> 8, c = g & 255;
      return OFF_G + (c < 128 ? T * 128 + c : 1024 + T * 128 + (c - 128)); }
}
template <bool MAPPED>
__device__ __forceinline__ void transpose_item(const float* __restrict__ W, int Nsrc, bf16* WT, int dst_ld, int dst_col0, int k0, int n0, LAS unsigned char* scr, int lane, const float* __restrict__ gk = nullptr) {
    const int c4 = (lane & 15) * 4, r0 = lane >> 4;
    const int sc = MAPPED ? win_src_col(n0 + c4) : (n0 + c4);
    f32x4 v[16];
#pragma unroll
    for (int i = 0; i < 16; ++i) v[i] = (sc >= 0) ? *(const f32x4*)(W + (size_t)(k0 + 8 * (i >> 1) + 2 * r0 + (i & 1)) * Nsrc + sc) : (f32x4){0.f, 0.f, 0.f, 0.f};
    if (gk) {
#pragma unroll
        for (int i = 0; i < 16; ++i) v[i] = v[i] * gk[k0 + 8 * (i >> 1) + 2 * r0 + (i & 1)];
    }
#pragma unroll
    for (int p = 0; p < 8; ++p) {
        const int kk = 8 * p + 2 * r0;
#pragma unroll
        for (int c = 0; c < 4; ++c) *(LAS unsigned*)(scr + (c4 + c) * 144 + kk * 2) = pk2(v[2 * p][c], v[2 * p + 1][c]);
    }
    LDS_WAIT(); asm volatile("" ::: "memory");
    const int ch = lane & 7;
#pragma unroll
    for (int j = 0; j < 8; ++j) { const int n = (lane >> 3) + 8 * j;
        const v4u o = *(const LAS v4u*)(scr + n * 144 + ch * 16);
        *(GAS v4u*)(WT + (size_t)(n0 + n) * dst_ld + dst_col0 + k0 + 8 * ch) = o; }
    LDS_WAIT(); asm volatile("" ::: "memory");
}
__device__ __forceinline__ void sincos_acc(float ang_f, float& s_out, float& c_out) {
    const double a = (double)ang_f;
    const double q = rint(a * 0.63661977236758134308);
    double r = fma(-q, 1.57079632679489655800e+00, a);
    r = fma(-q, 6.12323399573676603587e-17, r);
    const double r2 = r * r;
    double sp = 1.0 / 6227020800.0; sp = fma(sp, r2, -1.0 / 39916800.0); sp = fma(sp, r2, 1.0 / 362880.0); sp = fma(sp, r2, -1.0 / 5040.0);
    sp = fma(sp, r2, 1.0 / 120.0); sp = fma(sp, r2, -1.0 / 6.0); sp = fma(sp, r2, 1.0);
    const double sn = sp * r;
    double cp = 1.0 / 87178291200.0; cp = fma(cp, r2, -1.0 / 479001600.0); cp = fma(cp, r2, 1.0 / 3628800.0); cp = fma(cp, r2, -1.0 / 40320.0);
    cp = fma(cp, r2, 1.0 / 720.0); cp = fma(cp, r2, -1.0 / 24.0); cp = fma(cp, r2, 0.5); cp = fma(-cp, r2, 1.0);
    const int qi = ((int)q) & 3;
    double s, c;
    if (qi == 0) { s = sn; c = cp; } else if (qi == 1) { s = cp; c = -sn; } else if (qi == 2) { s = -sn; c = -cp; } else { s = -cp; c = sn; }
    s_out = (float)s; c_out = (float)c;
}
__device__ __forceinline__ float rope_inv(int j) {
    return j == 0 ? 1.0f : j == 1 ? 0.193922758102417f : j == 2 ? 0.03760603070259094f : j == 3 ? 0.00729266507551074f : j == 4 ? 0.001414213445968926f
         : j == 5 ? 0.00027424818836152554f : j == 6 ? 5.318296462064609e-05f : 1.0313385246263351e-05f;
}
__device__ __forceinline__ void xg_row(const float* xrow, const float* g, bf16* orow, float* rowsq, int row, int lane) {
    const GAS f32x4* xr = (const GAS f32x4*)xrow + lane; (void)g;
    f32x4 v[4]; float s = 0.f;
#pragma unroll
    for (int j = 0; j < 4; ++j) { v[j] = xr[64 * j]; s += (v[j].x * v[j].x + v[j].y * v[j].y) + (v[j].z * v[j].z + v[j].w * v[j].w); }
    s = wave_sum(s);
    GAS unsigned long long* o8 = (GAS unsigned long long*)orow + lane;
#pragma unroll
    for (int j = 0; j < 4; ++j) { o8[64 * j] = (unsigned long long)pk2(v[j].x, v[j].y) | ((unsigned long long)pk2(v[j].z, v[j].w) << 32); }
    if (lane < 4) rowsq[lane * MROWS + row] = (lane == 0) ? s : 0.f;
}

__device__ __forceinline__ void xg_row2(const float* xrowA, const float* xrowB, bf16* orowA, bf16* orowB, float* rowsq, int rowA, int rowB, int lane) {
    const GAS f32x4* xa = (const GAS f32x4*)xrowA + lane; const GAS f32x4* xb = (const GAS f32x4*)xrowB + lane;
    f32x4 va[4], vb[4];
#pragma unroll
    for (int j = 0; j < 4; ++j) { va[j] = xa[64 * j]; vb[j] = xb[64 * j]; }
    float sa = 0.f, sb = 0.f;
#pragma unroll
    for (int j = 0; j < 4; ++j) { sa += (va[j].x * va[j].x + va[j].y * va[j].y) + (va[j].z * va[j].z + va[j].w * va[j].w); sb += (vb[j].x * vb[j].x + vb[j].y * vb[j].y) + (vb[j].z * vb[j].z + vb[j].w * vb[j].w); }
    sa = wave_sum(sa); sb = wave_sum(sb);
    GAS unsigned long long* oa = (GAS unsigned long long*)orowA + lane; GAS unsigned long long* ob = (GAS unsigned long long*)orowB + lane;
#pragma unroll
    for (int j = 0; j < 4; ++j) { oa[64 * j] = (unsigned long long)pk2(va[j].x, va[j].y) | ((unsigned long long)pk2(va[j].z, va[j].w) << 32);
                                  ob[64 * j] = (unsigned long long)pk2(vb[j].x, vb[j].y) | ((unsigned long long)pk2(vb[j].z, vb[j].w) << 32); }
    if (lane < 4) { rowsq[lane * MROWS + rowA] = (lane == 0) ? sa : 0.f; rowsq[lane * MROWS + rowB] = (lane == 0) ? sb : 0.f; }
}

namespace sel {
typedef short bf16x8 __attribute__((ext_vector_type(8)));
typedef float f32x4 __attribute__((ext_vector_type(4)));
typedef unsigned u32x4 __attribute__((ext_vector_type(4)));
constexpr int ROWB = 8208;
constexpr int K16_BYTES = 16 * ROWB;
constexpr int MSK_OFF = K16_BYTES;
static_assert(MSK_OFF + 8192 <= MISC_OFF, "selection LDS map");
__device__ __forceinline__ int lane_now() { int l; asm volatile("v_mbcnt_lo_u32_b32 %0, -1, 0\n\tv_mbcnt_hi_u32_b32 %0, -1, %0" : "=v"(l)); return l; }
__device__ __forceinline__ void wg_barrier() { asm volatile("s_waitcnt vmcnt(0) lgkmcnt(0)\n\ts_barrier" ::: "memory"); }
__device__ __forceinline__ unsigned key_pair(float a, float b) {
    const unsigned x = __builtin_bit_cast(unsigned, __builtin_amdgcn_cvt_pkrtz(a, b));
    unsigned t; asm("v_pk_ashrrev_i16 %0, %2, %1" : "=v"(t) : "v"(x), "s"(0x000f000fu));
    return x ^ (t | 0x80008000u);
}
__device__ __forceinline__ float relu_i(float x) { const int i = __builtin_bit_cast(int, x); return __builtin_bit_cast(float, i > 0 ? i : 0); }
#define SEL_CMP8(OP, m, x0, x1, x2, x3, c) asm( \
    OP " %0, %8, %12 src0_sel:WORD_0 src1_sel:DWORD\n\t" OP " %1, %8, %12 src0_sel:WORD_1 src1_sel:DWORD\n\t" \
    OP " %2, %9, %12 src0_sel:WORD_0 src1_sel:DWORD\n\t" OP " %3, %9, %12 src0_sel:WORD_1 src1_sel:DWORD\n\t" \
    OP " %4, %10, %12 src0_sel:WORD_0 src1_sel:DWORD\n\t" OP " %5, %10, %12 src0_sel:WORD_1 src1_sel:DWORD\n\t" \
    OP " %6, %11, %12 src0_sel:WORD_0 src1_sel:DWORD\n\t" OP " %7, %11, %12 src0_sel:WORD_1 src1_sel:DWORD" \
    : "=&s"(m[0]), "=&s"(m[1]), "=&s"(m[2]), "=&s"(m[3]), "=&s"(m[4]), "=&s"(m[5]), "=&s"(m[6]), "=&s"(m[7]) : "v"(x0), "v"(x1), "v"(x2), "v"(x3), "s"(c))
__device__ __forceinline__ void count_ge2(const unsigned (&xa)[32], const unsigned (&xb)[32], const int nst, const unsigned candA, const unsigned candB, int& ca, int& cb) {
    const unsigned cmA = (candA - 1u) * 0x00010001u, cmB = (candB - 1u) * 0x00010001u, one = 0x00010001u;
    unsigned a0 = 0u, a1 = 0u, a2 = 0u, a3 = 0u, b0 = 0u, b1 = 0u, b2 = 0u, b3 = 0u;
#pragma unroll
    for (int g4 = 0; g4 < 8; ++g4) if (g4 * 4 < nst) {
        unsigned t0, t1, t2, t3, u0, u1, u2, u3;
        asm("v_pk_sub_u16 %0, %1, %2 clamp" : "=v"(t0) : "v"(xa[g4 * 4 + 0]), "s"(cmA));
        asm("v_pk_sub_u16 %0, %1, %2 clamp" : "=v"(t1) : "v"(xa[g4 * 4 + 1]), "s"(cmA));
        asm("v_pk_sub_u16 %0, %1, %2 clamp" : "=v"(t2) : "v"(xa[g4 * 4 + 2]), "s"(cmA));
        asm("v_pk_sub_u16 %0, %1, %2 clamp" : "=v"(t3) : "v"(xa[g4 * 4 + 3]), "s"(cmA));
        asm("v_pk_sub_u16 %0, %1, %2 clamp" : "=v"(u0) : "v"(xb[g4 * 4 + 0]), "s"(cmB));
        asm("v_pk_sub_u16 %0, %1, %2 clamp" : "=v"(u1) : "v"(xb[g4 * 4 + 1]), "s"(cmB));
        asm("v_pk_sub_u16 %0, %1, %2 clamp" : "=v"(u2) : "v"(xb[g4 * 4 + 2]), "s"(cmB));
        asm("v_pk_sub_u16 %0, %1, %2 clamp" : "=v"(u3) : "v"(xb[g4 * 4 + 3]), "s"(cmB));
        asm("v_pk_min_u16 %0, %1, %2" : "=v"(t0) : "v"(t0), "s"(one)); asm("v_pk_min_u16 %0, %1, %2" : "=v"(t1) : "v"(t1), "s"(one));
        asm("v_pk_min_u16 %0, %1, %2" : "=v"(t2) : "v"(t2), "s"(one)); asm("v_pk_min_u16 %0, %1, %2" : "=v"(t3) : "v"(t3), "s"(one));
        asm("v_pk_min_u16 %0, %1, %2" : "=v"(u0) : "v"(u0), "s"(one)); asm("v_pk_min_u16 %0, %1, %2" : "=v"(u1) : "v"(u1), "s"(one));
        asm("v_pk_min_u16 %0, %1, %2" : "=v"(u2) : "v"(u2), "s"(one)); asm("v_pk_min_u16 %0, %1, %2" : "=v"(u3) : "v"(u3), "s"(one));
        asm("v_pk_add_u16 %0, %1, %2" : "=v"(a0) : "v"(a0), "v"(t0)); asm("v_pk_add_u16 %0, %1, %2" : "=v"(a1) : "v"(a1), "v"(t1));
        asm("v_pk_add_u16 %0, %1, %2" : "=v"(a2) : "v"(a2), "v"(t2)); asm("v_pk_add_u16 %0, %1, %2" : "=v"(a3) : "v"(a3), "v"(t3));
        asm("v_pk_add_u16 %0, %1, %2" : "=v"(b0) : "v"(b0), "v"(u0)); asm("v_pk_add_u16 %0, %1, %2" : "=v"(b1) : "v"(b1), "v"(u1));
        asm("v_pk_add_u16 %0, %1, %2" : "=v"(b2) : "v"(b2), "v"(u2)); asm("v_pk_add_u16 %0, %1, %2" : "=v"(b3) : "v"(b3), "v"(u3));
    }
    asm("v_pk_add_u16 %0, %1, %2" : "=v"(a0) : "v"(a0), "v"(a1)); asm("v_pk_add_u16 %0, %1, %2" : "=v"(a2) : "v"(a2), "v"(a3));
    asm("v_pk_add_u16 %0, %1, %2" : "=v"(b0) : "v"(b0), "v"(b1)); asm("v_pk_add_u16 %0, %1, %2" : "=v"(b2) : "v"(b2), "v"(b3));
    asm("v_pk_add_u16 %0, %1, %2" : "=v"(a0) : "v"(a0), "v"(a2)); asm("v_pk_add_u16 %0, %1, %2" : "=v"(b0) : "v"(b0), "v"(b2));
    int va = (int)((a0 & 0xffffu) + (a0 >> 16)), vb = (int)((b0 & 0xffffu) + (b0 >> 16));
    va += __builtin_amdgcn_update_dpp(0, va, 0x111, 0xf, 0xf, true); vb += __builtin_amdgcn_update_dpp(0, vb, 0x111, 0xf, 0xf, true);
    va += __builtin_amdgcn_update_dpp(0, va, 0x112, 0xf, 0xf, true); vb += __builtin_amdgcn_update_dpp(0, vb, 0x112, 0xf, 0xf, true);
    va += __builtin_amdgcn_update_dpp(0, va, 0x114, 0xf, 0xf, true); vb += __builtin_amdgcn_update_dpp(0, vb, 0x114, 0xf, 0xf, true);
    va += __builtin_amdgcn_update_dpp(0, va, 0x118, 0xf, 0xf, true); vb += __builtin_amdgcn_update_dpp(0, vb, 0x118, 0xf, 0xf, true);
    ca = (__builtin_amdgcn_readlane(va, 15) + __builtin_amdgcn_readlane(va, 31)) + (__builtin_amdgcn_readlane(va, 47) + __builtin_amdgcn_readlane(va, 63));
    cb = (__builtin_amdgcn_readlane(vb, 15) + __builtin_amdgcn_readlane(vb, 31)) + (__builtin_amdgcn_readlane(vb, 47) + __builtin_amdgcn_readlane(vb, 63));
}
__device__ __forceinline__ void bit_transpose32(const unsigned (&x)[32], unsigned (&w)[32]) {
#pragma unroll
    for (int k = 0; k < 16; ++k) { w[k] = __builtin_amdgcn_perm(x[k + 16], x[k], 0x05040100u); w[k + 16] = __builtin_amdgcn_perm(x[k + 16], x[k], 0x07060302u); }
#pragma unroll
    for (int k = 0; k < 32; ++k) if (!(k & 8)) { const unsigned a = w[k], b = w[k + 8]; w[k] = __builtin_amdgcn_perm(b, a, 0x06020400u); w[k + 8] = __builtin_amdgcn_perm(b, a, 0x07030501u); }
#define BT_STAGE(s, m) _Pragma("unroll") for (int k = 0; k < 32; ++k) if (!(k & s)) { const unsigned a = w[k], b = w[k + s]; w[k] = (a & m) | ((b << s) & ~m); w[k + s] = ((a >> s) & m) | (b & ~m); }
    BT_STAGE(4, 0x0F0F0F0Fu) BT_STAGE(2, 0x33333333u) BT_STAGE(1, 0x55555555u)
#undef BT_STAGE
}
struct SelU { int b, t0, N, NST; };
__device__ __forceinline__ SelU sel_mk(const int b, const int qb16) { SelU u; u.b = b; u.t0 = qb16 * 16; u.N = ((u.t0 >> 6) + 1) << 6; u.NST = (u.N + 127) >> 7; return u; }
__device__ __forceinline__ void sel_score(LAS unsigned char* lds, const SelU u, const bf16* __restrict__ IQ, const bf16* __restrict__ IK, const float* __restrict__ IW, const int wid) {
    const int lane = lane_now();
    const int q = lane & 15, g = lane >> 4;
    const int t0 = u.t0, N = u.N, NST = u.NST;
    const size_t rb = (size_t)u.b * SEQ;
    bf16x8 bq[4][2];
#pragma unroll
    for (int h = 0; h < 4; ++h)
#pragma unroll
        for (int ks = 0; ks < 2; ++ks) bq[h][ks] = *(const bf16x8*)(IQ + (((rb + t0) >> 4) * 32 + h * 8 + ks * 4 + g) * 128 + q * 8);
    const f32x4 w4 = *(const f32x4*)(IW + (rb + t0 + q) * 4);
    for (int st = wid; st < NST; st += 8) {
        const int k0 = st * 128;
        const unsigned hmask = ((k0 + 64) < N) ? 0xffffffffu : 0x0000ffffu;
        bf16x8 ak[4][4];
#pragma unroll
        for (int kt = 0; kt < 4; ++kt) {
            const bf16* ikA = IK + (((rb + k0) >> 4) + kt) * 1024 + g * 128 + q * 8;
            const bf16* ikB = ikA + 4 * 1024;
            ak[kt][0] = *(const bf16x8*)ikA; ak[kt][1] = *(const bf16x8*)(ikA + 512); ak[kt][2] = *(const bf16x8*)ikB; ak[kt][3] = *(const bf16x8*)(ikB + 512); }
        __builtin_amdgcn_sched_barrier(0);
#pragma unroll
        for (int kt = 0; kt < 4; ++kt) {
            const bf16x8 aA0 = ak[kt][0], aA1 = ak[kt][1], aB0 = ak[kt][2], aB1 = ak[kt][3];
            typedef float f32x2s __attribute__((ext_vector_type(2)));
            f32x2s sA01 = {0.f, 0.f}, sA23 = {0.f, 0.f}, sB01 = {0.f, 0.f}, sB23 = {0.f, 0.f};
#pragma unroll
            for (int h = 0; h < 4; ++h) {
                f32x4 cA = __builtin_amdgcn_mfma_f32_16x16x32_bf16(aA0, bq[h][0], (f32x4){0.f, 0.f, 0.f, 0.f}, 0, 0, 0);
                cA = __builtin_amdgcn_mfma_f32_16x16x32_bf16(aA1, bq[h][1], cA, 0, 0, 0);
                f32x4 cB = __builtin_amdgcn_mfma_f32_16x16x32_bf16(aB0, bq[h][0], (f32x4){0.f, 0.f, 0.f, 0.f}, 0, 0, 0);
                cB = __builtin_amdgcn_mfma_f32_16x16x32_bf16(aB1, bq[h][1], cB, 0, 0, 0);
#pragma unroll
                for (int r = 0; r < 1; ++r) { const f32x2s wv = {w4[h], w4[h]};
                    sA01 = __builtin_elementwise_fma((f32x2s){relu_i(cA[0]), relu_i(cA[1])}, wv, sA01); sA23 = __builtin_elementwise_fma((f32x2s){relu_i(cA[2]), relu_i(cA[3])}, wv, sA23);
                    sB01 = __builtin_elementwise_fma((f32x2s){relu_i(cB[0]), relu_i(cB[1])}, wv, sB01); sB23 = __builtin_elementwise_fma((f32x2s){relu_i(cB[2]), relu_i(cB[3])}, wv, sB23); }
            }
            u32x4 d;
#pragma unroll
            for (int r = 0; r < 4; ++r) d[r] = key_pair((r < 2) ? sA01[r & 1] : sA23[r & 1], (r < 2) ? sB01[r & 1] : sB23[r & 1]) & hmask;
            { const int p0 = 32 * (g >> 1) + 4 * kt + 2 * (g & 1);
              *(LAS unsigned long long*)(lds + q * ROWB + (st * 64 + p0) * 4) = (unsigned long long)d[0] | ((unsigned long long)d[2] << 32);
              *(LAS unsigned long long*)(lds + q * ROWB + (st * 64 + p0 + 16) * 4) = (unsigned long long)d[1] | ((unsigned long long)d[3] << 32); }
        }
    }
}
__device__ __forceinline__ void sel_loadx(LAS unsigned char* lds, const SelU u, unsigned (&xq)[2][32], const int wid) {
    const int lane = lane_now(); const int NST = u.NST;
#pragma unroll
    for (int j = 0; j < 32; ++j) { const unsigned keep = (j < NST) ? 0xffffffffu : 0u;
        xq[0][j] = ((const LAS unsigned*)(lds + (2 * wid) * ROWB))[j * 64 + lane] & keep;
        xq[1][j] = ((const LAS unsigned*)(lds + (2 * wid + 1) * ROWB))[j * 64 + lane] & keep; }
}
__device__ __forceinline__ void sel_pick(LAS unsigned char* lds, const SelU u, const unsigned (&xq)[2][32], const int wid) {
    const int lane = lane_now(); const int N = u.N, NST = u.NST;
    unsigned Tq[2] = {0u, 0u}; int cTq[2] = {0, 0};
    if (N > 256) {
#pragma unroll
        for (int qq = 0; qq < 2; ++qq) {
            unsigned pl[32];
            bit_transpose32(xq[qq], pl);
            __builtin_amdgcn_sched_barrier(0);
            unsigned m0 = ~0u, m1 = ~0u, T = 0u; int g = 0, cT = 0;
#pragma unroll
            for (int bit = 15; bit >= 0; --bit) {
                const unsigned t0 = m0 & pl[bit], t1 = m1 & pl[16 + bit];
                int v = __builtin_popcount(t0) + __builtin_popcount(t1);
                v += __builtin_amdgcn_update_dpp(0, v, 0x111, 0xf, 0xf, true); v += __builtin_amdgcn_update_dpp(0, v, 0x112, 0xf, 0xf, true);
                v += __builtin_amdgcn_update_dpp(0, v, 0x114, 0xf, 0xf, true); v += __builtin_amdgcn_update_dpp(0, v, 0x118, 0xf, 0xf, true);
                const int n = g + (__builtin_amdgcn_readlane(v, 15) + __builtin_amdgcn_readlane(v, 31)) + (__builtin_amdgcn_readlane(v, 47) + __builtin_amdgcn_readlane(v, 63));
                const bool take = n >= 256;
                if (take) { T |= 1u << bit; cT = n; } else g = n;
                const unsigned f = take ? 0u : ~0u;
                m0 &= pl[bit] ^ f; m1 &= pl[16 + bit] ^ f;
            }
            Tq[qq] = T; cTq[qq] = cT;
            __builtin_amdgcn_sched_barrier(0);
        }
    }
#pragma unroll
    for (int qq = 0; qq < 2; ++qq) {
        const int ql = 2 * wid + qq;
        const unsigned (&xh)[32] = xq[qq];
        const unsigned T = Tq[qq]; const int cT = cTq[qq];
        unsigned mlo = 0u, mhi = 0u;
#define SEL_WL(tile, mm) do { asm volatile("v_writelane_b32 %0, %1, %2" : "+v"(mlo) : "s"(__builtin_amdgcn_readfirstlane((unsigned)(mm))), "n"(tile)); \
                              asm volatile("v_writelane_b32 %0, %1, %2" : "+v"(mhi) : "s"(__builtin_amdgcn_readfirstlane((unsigned)((mm) >> 32))), "n"(tile)); } while (0)
        if (N <= 256) {
#pragma unroll
            for (int tile = 0; tile < 4; ++tile) { const unsigned long long m = (tile * 64 < N) ? ~0ull : 0ull; SEL_WL(tile, m); }
        } else {
#pragma unroll
            for (int g4 = 0; g4 < 8; ++g4) if (g4 * 4 < NST) {
                unsigned long long m[8];
                SEL_CMP8("v_cmp_ge_u16_sdwa", m, xh[g4 * 4], xh[g4 * 4 + 1], xh[g4 * 4 + 2], xh[g4 * 4 + 3], T);
#pragma unroll
                for (int k = 0; k < 8; ++k) {
                    asm volatile("v_writelane_b32 %0, %1, %2" : "+v"(mlo) : "s"((unsigned)m[k]), "n"(g4 * 8 + k));
                    asm volatile("v_writelane_b32 %0, %1, %2" : "+v"(mhi) : "s"((unsigned)(m[k] >> 32)), "n"(g4 * 8 + k)); }
            }
            int d = cT - 256;
            if (d > 0) {
#pragma unroll
                for (int g4 = 7; g4 >= 0; --g4) if (g4 * 4 < NST && d > 0) {
                    unsigned long long e[8];
                    SEL_CMP8("v_cmp_eq_u16_sdwa", e, xh[g4 * 4], xh[g4 * 4 + 1], xh[g4 * 4 + 2], xh[g4 * 4 + 3], T);
#pragma unroll
                    for (int k = 7; k >= 0; --k) {
                        unsigned long long ek = e[k];
                        if (d > 0 && ek != 0ull) {
                            const int pop = __builtin_popcountll(ek);
                            unsigned long long clr = 0ull;
                            if (pop <= d) { clr = ek; d -= pop; }
                            else { for (int i_ = 0; i_ < d; ++i_) { const unsigned long long hb = 1ull << (63 - __builtin_clzll(ek)); clr |= hb; ek ^= hb; } d = 0; }
                            const unsigned lo_ = (unsigned)__builtin_amdgcn_readlane((int)mlo, g4 * 8 + k) & ~(unsigned)clr;
                            const unsigned hi_ = (unsigned)__builtin_amdgcn_readlane((int)mhi, g4 * 8 + k) & ~(unsigned)(clr >> 32);
                            asm volatile("v_writelane_b32 %0, %1, %2" : "+v"(mlo) : "s"(__builtin_amdgcn_readfirstlane(lo_)), "n"(g4 * 8 + k));
                            asm volatile("v_writelane_b32 %0, %1, %2" : "+v"(mhi) : "s"(__builtin_amdgcn_readfirstlane(hi_)), "n"(g4 * 8 + k));
                        }
                    }
                }
            }
        }
#undef SEL_WL
        *(LAS unsigned long long*)(lds + MSK_OFF + ql * 512 + lane * 8) = (unsigned long long)mlo | ((unsigned long long)mhi << 32);
    }
}
__device__ __forceinline__ void sel_write(LAS unsigned char* lds, const SelU u, unsigned long long* __restrict__ MASK, const int wid) {
    const int lane = lane_now();
    const int tid = wid * 64 + lane, tile = tid >> 3, pr = tid & 7;
    const unsigned long long m0 = *(const LAS unsigned long long*)(lds + MSK_OFF + (2 * pr) * 512 + tile * 8);
    const unsigned long long m1 = *(const LAS unsigned long long*)(lds + MSK_OFF + (2 * pr + 1) * 512 + tile * 8);
    u32x4 o; o.x = (unsigned)m0; o.y = (unsigned)(m0 >> 32); o.z = (unsigned)m1; o.w = (unsigned)(m1 >> 32);
    *(u32x4*)(MASK + ((size_t)(u.b * 64 + tile) * SEQ + u.t0 + 2 * pr)) = o;
}
template <class F>
__device__ __forceinline__ void sel_pipeline(LAS unsigned char* lds, const int n, F unit_of, const bf16* __restrict__ IQ, const bf16* __restrict__ IK, const float* __restrict__ IW,
                                             unsigned long long* __restrict__ MASK, const int wid) {
    if (n <= 0) return;
    unsigned xq[2][32];
    SelU cur = unit_of(0);
    sel_score(lds, cur, IQ, IK, IW, wid);
    wg_barrier();
    sel_loadx(lds, cur, xq, wid);
    wg_barrier();
#pragma unroll 1
    for (int i = 0; i < n; ++i) {
        const bool more = (i + 1 < n);
        SelU nxt = cur; if (more) nxt = unit_of(i + 1);
        if (more && !(wid & 1)) sel_score(lds, nxt, IQ, IK, IW, wid);
        sel_pick(lds, cur, xq, wid);
        if (more && (wid & 1)) sel_score(lds, nxt, IQ, IK, IW, wid);
        wg_barrier();
        sel_write(lds, cur, MASK, wid);
        if (more) sel_loadx(lds, nxt, xq, wid);
        asm volatile("s_waitcnt lgkmcnt(0)\n\ts_barrier" ::: "memory");
        cur = nxt;
    }
}
__device__ __forceinline__ void convmid_rows(const bf16* __restrict__ CB, const bf16* __restrict__ P, const float* __restrict__ cw, bf16* __restrict__ A2, const int row_base, const int wid) {
    const int lane = lane_now(); const int c8 = lane * 8;
    f32x4 w[3][2];
#pragma unroll
    for (int k = 0; k < 3; ++k) { w[k][0] = *(const f32x4*)(cw + k * 512 + c8); w[k][1] = *(const f32x4*)(cw + k * 512 + c8 + 4); }
    const int r0 = row_base + wid * 8; const bool hist = ((r0 & (SEQ - 1)) != 0);
    u32x4 pr[10], cbv[8];
    const u32x4 zero = (u32x4){0u, 0u, 0u, 0u};
    pr[0] = zero; pr[1] = zero;
    if (hist) { pr[0] = *(const u32x4*)(P + (size_t)(r0 - 2) * 512 + c8); pr[1] = *(const u32x4*)(P + (size_t)(r0 - 1) * 512 + c8); }
#pragma unroll
    for (int i = 0; i < 8; ++i) { pr[2 + i] = *(const u32x4*)(P + (size_t)(r0 + i) * 512 + c8); cbv[i] = *(const u32x4*)(CB + (size_t)(r0 + i) * 512 + c8); }
    __builtin_amdgcn_sched_barrier(0);
#pragma unroll
    for (int i = 0; i < 8; ++i) {
        const u32x4 p0 = pr[2 + i], p1 = pr[1 + i], p2 = pr[i], cb = cbv[i];
        float o[8];
#pragma unroll
        for (int j = 0; j < 4; ++j) {
            const float a0 = __builtin_bit_cast(float, p0[j] << 16), a1 = __builtin_bit_cast(float, p0[j] & 0xffff0000u);
            const float b0 = __builtin_bit_cast(float, p1[j] << 16), b1 = __builtin_bit_cast(float, p1[j] & 0xffff0000u);
            const float c0 = __builtin_bit_cast(float, p2[j] << 16), c1 = __builtin_bit_cast(float, p2[j] & 0xffff0000u);
            const float g0 = __builtin_bit_cast(float, cb[j] << 16), g1 = __builtin_bit_cast(float, cb[j] & 0xffff0000u);
            const int e0 = 2 * j, e1 = 2 * j + 1;
            o[e0] = g0 * (w[0][e0 >> 2][e0 & 3] * c0 + w[1][e0 >> 2][e0 & 3] * b0 + w[2][e0 >> 2][e0 & 3] * a0);
            o[e1] = g1 * (w[0][e1 >> 2][e1 & 3] * c1 + w[1][e1 >> 2][e1 & 3] * b1 + w[2][e1 >> 2][e1 & 3] * a1);
        }
        u32x4 r; r.x = pk2(o[0], o[1]); r.y = pk2(o[2], o[3]); r.z = pk2(o[4], o[5]); r.w = pk2(o[6], o[7]);
        *(u32x4*)(A2 + (size_t)(r0 + i) * 1024 + 512 + c8) = r;
    }
}
}
namespace att {
typedef short bf16x8 __attribute__((ext_vector_type(8)));
typedef short s16x4 __attribute__((ext_vector_type(4)));
typedef float f32x16 __attribute__((ext_vector_type(16)));
typedef unsigned u32x4 __attribute__((ext_vector_type(4)));
typedef float f32x2_t __attribute__((ext_vector_type(2))); typedef __bf16 bf16x2_t __attribute__((ext_vector_type(2)));
constexpr int NSLOT = 4, SLOTB = 8192, MSLOTB = 2048;
constexpr int LDS_K = 0, LDS_V = NSLOT * SLOTB, LDS_M = 2 * NSLOT * SLOTB, LDS_WS = LDS_M + NSLOT * MSLOTB, LDS_OST = LDS_WS + 8 * 64 * 4, LDS_FLAG = LDS_OST + 8 * 4096, LDS_END = LDS_FLAG + 64;
static_assert(LDS_END <= RING_BYTES, "attention LDS map");
__device__ __forceinline__ int lane_now() { int l; asm volatile("v_mbcnt_lo_u32_b32 %0, -1, 0\n\tv_mbcnt_hi_u32_b32 %0, -1, %0" : "=v"(l)); return l; }
__device__ __forceinline__ int crow(int r, int hi) { return (r & 3) + 8 * (r >> 2) + 4 * hi; }
__device__ __forceinline__ void glds16(const void* gsrc, unsigned lds_dst) { unsigned keep;
    asm volatile("s_mov_b32 %0, m0\n\ts_mov_b32 m0, %2\n\ts_nop 0\n\tglobal_load_lds_dwordx4 %1, off\n\ts_mov_b32 m0, %0" : "=&s"(keep) : "v"(gsrc), "s"(lds_dst) : "memory"); }
__device__ __forceinline__ void glds4(const void* gsrc, unsigned lds_dst) { unsigned keep;
    asm volatile("s_mov_b32 %0, m0\n\ts_mov_b32 m0, %2\n\ts_nop 0\n\tglobal_load_lds_dword %1, off\n\ts_mov_b32 m0, %0" : "=&s"(keep) : "v"(gsrc), "s"(lds_dst) : "memory"); }
__device__ __forceinline__ unsigned cvtpk(float lo, float hi) { f32x2_t v = {lo, hi}; bf16x2_t b = __builtin_convertvector(v, bf16x2_t); return __builtin_bit_cast(unsigned, b); }
#define ATT_WAIT_BAR(N) asm volatile("s_waitcnt vmcnt(" #N ") lgkmcnt(0)\n\ts_barrier" ::: "memory")
#define ATT_SBAR() __builtin_amdgcn_sched_barrier(0)
__device__ __forceinline__ void pv(f32x16* o, int vb, bf16x8 pa0, bf16x8 pa1, bf16x8 pa2, bf16x8 pa3) {
#pragma unroll
    for (int d0 = 0; d0 < 2; ++d0) { s16x4 lo[4], hi[4];
#pragma unroll
        for (int ks = 0; ks < 4; ++ks) {
            asm volatile("ds_read_b64_tr_b16 %0,%1 offset:%c2" : "=&v"(lo[ks]) : "v"(vb), "i"(d0 * 4096 + ks * 1024) : "memory");
            asm volatile("ds_read_b64_tr_b16 %0,%1 offset:%c2" : "=&v"(hi[ks]) : "v"(vb), "i"(d0 * 4096 + ks * 1024 + 512) : "memory"); }
        asm volatile("s_waitcnt lgkmcnt(0)" ::: "memory"); ATT_SBAR();
#define ATT_PK(k) (bf16x8){lo[k][0], lo[k][1], lo[k][2], lo[k][3], hi[k][0], hi[k][1], hi[k][2], hi[k][3]}
        o[d0] = __builtin_amdgcn_mfma_f32_32x32x16_bf16(pa0, ATT_PK(0), o[d0], 0, 0, 0);
        o[d0] = __builtin_amdgcn_mfma_f32_32x32x16_bf16(pa1, ATT_PK(1), o[d0], 0, 0, 0);
        o[d0] = __builtin_amdgcn_mfma_f32_32x32x16_bf16(pa2, ATT_PK(2), o[d0], 0, 0, 0);
        o[d0] = __builtin_amdgcn_mfma_f32_32x32x16_bf16(pa3, ATT_PK(3), o[d0], 0, 0, 0);
#undef ATT_PK
    }
}
template <bool SAFE>
__device__ __forceinline__ bool attn_unit(const int b, const int h, const int qb, const bf16* __restrict__ Q, const bf16* __restrict__ K, const bf16* __restrict__ V,
                                          const unsigned long long* __restrict__ MASK, bf16* __restrict__ O, LAS unsigned char* shm, const int wid) {
    const int lane = lane_now(), r32 = lane & 31, hi = lane >> 5;
    const size_t rowbase = (size_t)b * SEQ; const int q0 = qb * 256;
    const bf16* Qw = Q + (rowbase + q0 + wid * 32) * 512 + h * 64;
    const bf16* Kh = K + rowbase * 512 + h * 64; const bf16* Vh = V + rowbase * 512 + h * 64;
    const unsigned lds0 = (unsigned)(uintptr_t)shm;
    LAS float* wsf = (LAS float*)(shm + LDS_WS) + wid * 64;
    const bf16* ksrc = Kh + (size_t)lane * 512 + wid * 8;
    const bf16* vsrc = Vh + (size_t)(16 * (wid & 3) + (lane >> 2)) * 512 + (wid >> 2) * 32 + (lane & 3) * 8;
    const unsigned* msrc = (const unsigned*)(MASK + ((size_t)b * 64 * SEQ + q0 + wid * 32)) + lane;
    const unsigned kdst = lds0 + LDS_K + wid * 1024, vdst = lds0 + LDS_V + wid * 1024, mdst = lds0 + LDS_M + wid * 256;
#define ATT_DMA(t, slot) do { glds4(msrc + (size_t)(t) * (SEQ * 2), (unsigned)__builtin_amdgcn_readfirstlane(mdst + (slot) * MSLOTB)); \
        glds16(ksrc + (size_t)(t) * 64 * 512, (unsigned)__builtin_amdgcn_readfirstlane(kdst + (slot) * SLOTB)); \
        glds16(vsrc + (size_t)(t) * 64 * 512, (unsigned)__builtin_amdgcn_readfirstlane(vdst + (slot) * SLOTB)); } while (0)
    const int vb0 = (int)(lds0 + LDS_V) + ((lane >> 4) & 1) * 32 + (lane & 3) * 8 + (4 * hi + ((lane & 15) >> 2)) * 64;
    const int NT = (q0 + 256) / 64;
    bf16x8 qr[4];
#pragma unroll
    for (int d0 = 0; d0 < 4; ++d0) qr[d0] = *(const bf16x8*)(Qw + (size_t)r32 * 512 + d0 * 16 + hi * 8);
    asm volatile("s_waitcnt vmcnt(0)" : "+v"(qr[0]), "+v"(qr[1]), "+v"(qr[2]), "+v"(qr[3]) :: "memory");
    ATT_DMA(0, 0); ATT_DMA(1, 1); ATT_DMA(2, 2);
    bool redo = false;
    if constexpr (SAFE) {
    constexpr float THR = 8.0f, NEGBIG = -1.0e30f;
    float mhat = 0.f, l_run = 0.f; f32x16 o[2]; o[0] = f32x16{}; o[1] = f32x16{};
#define ATT_QKT(C0, C1, slot_) do { \
        const unsigned long long mw_ = *(const LAS unsigned long long*)(shm + LDS_M + (slot_) * MSLOTB + wid * 256 + r32 * 8); \
        const unsigned long long ms_ = mw_ >> (2 * hi);              \
        const int mlo_ = (int)(unsigned)ms_, mhi_ = (int)(unsigned)(ms_ >> 32); \
        const unsigned nm_ = __float_as_uint(-mhat), ng_ = __float_as_uint(NEGBIG); \
        f32x16 i0_, i1_; \
        _Pragma("unroll") for (int r = 0; r < 16; ++r) { const int pos = 16 * (r & 1) + 4 * (r >> 3) + ((r >> 1) & 1); const int wsel = (r >> 2) & 1; \
            const unsigned t0_ = (unsigned)__builtin_amdgcn_sbfe(wsel ? mhi_ : mlo_, pos, 1), t1_ = (unsigned)__builtin_amdgcn_sbfe(wsel ? mhi_ : mlo_, pos + 8, 1); \
            i0_[r] = __uint_as_float((nm_ & t0_) | (ng_ & ~t0_)); i1_[r] = __uint_as_float((nm_ & t1_) | (ng_ & ~t1_)); } \
        const LAS unsigned char* kb_ = shm + LDS_K + (slot_) * SLOTB + hi * 1024 + r32 * 16; \
        _Pragma("unroll") for (int d0 = 0; d0 < 4; ++d0) { \
            const bf16x8 b0_ = *(const LAS bf16x8*)(kb_ + d0 * 2048), b1_ = *(const LAS bf16x8*)(kb_ + d0 * 2048 + 512); \
            if (d0 == 0) { C0 = __builtin_amdgcn_mfma_f32_32x32x16_bf16(b0_, qr[0], i0_, 0, 0, 0); C1 = __builtin_amdgcn_mfma_f32_32x32x16_bf16(b1_, qr[0], i1_, 0, 0, 0); } \
            else { C0 = __builtin_amdgcn_mfma_f32_32x32x16_bf16(b0_, qr[d0], C0, 0, 0, 0); C1 = __builtin_amdgcn_mfma_f32_32x32x16_bf16(b1_, qr[d0], C1, 0, 0, 0); } } } while (0)
    f32x16 p0, p1, c0, c1;
    if (NT > 3) ATT_WAIT_BAR(6); else ATT_WAIT_BAR(0);
    ATT_QKT(p0, p1, 0);
    int slot = 0;
#pragma unroll 1
    for (int t = 0; t < NT; ++t) {
        if (t + 2 < NT) ATT_WAIT_BAR(3); else ATT_WAIT_BAR(0);
        if (t + 3 < NT) { const int s3 = (slot == 0) ? NSLOT - 1 : slot - 1; ATT_DMA(t + 3, s3); }
        const int slot1 = (slot == NSLOT - 1) ? 0 : slot + 1;
        float rm = fmaxf(p0[0], p1[0]);
#pragma unroll
        for (int r = 1; r < 16; ++r) rm = fmaxf(rm, fmaxf(p0[r], p1[r]));
        { auto rr = __builtin_amdgcn_permlane32_swap(__float_as_uint(rm), __float_as_uint(rm), false, false); rm = fmaxf(__uint_as_float(rr[0]), __uint_as_float(rr[1])); }
        if (__builtin_expect(__any(rm > THR), 0)) {
            const float dl = fmaxf(rm, 0.f); mhat += dl;
#pragma unroll
            for (int r = 0; r < 16; ++r) { p0[r] -= dl; p1[r] -= dl; }
            const float f = __builtin_amdgcn_exp2f(-dl); l_run *= f;
            if (hi == 0) wsf[r32] = f;
            asm volatile("s_waitcnt lgkmcnt(0)" ::: "memory");
#pragma unroll
            for (int r = 0; r < 16; ++r) { const float a = wsf[crow(r, hi)]; o[0][r] *= a; o[1][r] *= a; }
        }
        if (t + 1 < NT) ATT_QKT(c0, c1, slot1);
        float sacc = 0.f;
#pragma unroll
        for (int r = 0; r < 16; ++r) { p0[r] = __builtin_amdgcn_exp2f(p0[r]); p1[r] = __builtin_amdgcn_exp2f(p1[r]); sacc += p0[r] + p1[r]; }
        l_run += sacc;
        u32x4 pw0, pw1, pw2, pw3;
        pw0 = (u32x4){cvtpk(p0[0], p0[1]), cvtpk(p0[2], p0[3]), cvtpk(p0[4], p0[5]), cvtpk(p0[6], p0[7])};
        pw1 = (u32x4){cvtpk(p0[8], p0[9]), cvtpk(p0[10], p0[11]), cvtpk(p0[12], p0[13]), cvtpk(p0[14], p0[15])};
        pw2 = (u32x4){cvtpk(p1[0], p1[1]), cvtpk(p1[2], p1[3]), cvtpk(p1[4], p1[5]), cvtpk(p1[6], p1[7])};
        pw3 = (u32x4){cvtpk(p1[8], p1[9]), cvtpk(p1[10], p1[11]), cvtpk(p1[12], p1[13]), cvtpk(p1[14], p1[15])};
        pv(o, vb0 + slot * SLOTB, __builtin_bit_cast(bf16x8, pw0), __builtin_bit_cast(bf16x8, pw1), __builtin_bit_cast(bf16x8, pw2), __builtin_bit_cast(bf16x8, pw3));
        p0 = c0; p1 = c1;
        slot = slot1;
    }
#undef ATT_QKT
    { auto rr = __builtin_amdgcn_permlane32_swap(__float_as_uint(l_run), __float_as_uint(l_run), false, false); l_run = __uint_as_float(rr[0]) + __uint_as_float(rr[1]); }
    if (hi == 0) wsf[32 + r32] = l_run;
    asm volatile("s_waitcnt lgkmcnt(0)" ::: "memory");
    float rli[16];
#pragma unroll
    for (int r = 0; r < 16; ++r) rli[r] = __builtin_amdgcn_rcpf(wsf[32 + crow(r, hi)]);
    bf16* Ow = O + (rowbase + q0 + wid * 32) * 1024 + h * 64;
    { LAS bf16* stg = (LAS bf16*)(shm + LDS_OST) + wid * 2048;
#pragma unroll
      for (int r = 0; r < 16; ++r) { const int orow = crow(r, hi);
#pragma unroll
          for (int d0 = 0; d0 < 2; ++d0) stg[orow * 64 + d0 * 32 + r32] = (bf16)f2bf(o[d0][r] * rli[r]); }
      asm volatile("s_waitcnt lgkmcnt(0)" ::: "memory");
#pragma unroll
      for (int i = 0; i < 4; ++i) { const int row = i * 8 + (lane >> 3), ch = lane & 7; const u32x4 v = *(const LAS u32x4*)(stg + row * 64 + ch * 8); *(u32x4*)(Ow + (size_t)row * 1024 + ch * 8) = v; } }
    asm volatile("s_waitcnt vmcnt(0) lgkmcnt(0)\n\ts_barrier" ::: "memory");
    } else {
    f32x16 o[2]; o[0] = f32x16{}; o[1] = f32x16{}; f32x16 lsum = f32x16{};
    const bf16x8 ones8 = (bf16x8){0x3f80, 0x3f80, 0x3f80, 0x3f80, 0x3f80, 0x3f80, 0x3f80, 0x3f80};
    const unsigned ngb = __float_as_uint(-1.0e30f);
    bf16x8 kf[8]; s16x4 vlo[8], vhi[8];
    const unsigned kaddr0 = lds0 + LDS_K + hi * 1024 + r32 * 16;
#define ATT_KRD(slot_) do { const unsigned ka_ = kaddr0 + (slot_) * SLOTB; \
        _Pragma("unroll") for (int d0 = 0; d0 < 4; ++d0) { \
            asm volatile("ds_read_b128 %0, %1 offset:%c2" : "=v"(kf[2 * d0]) : "v"(ka_), "i"(d0 * 2048) : "memory"); \
            asm volatile("ds_read_b128 %0, %1 offset:%c2" : "=v"(kf[2 * d0 + 1]) : "v"(ka_), "i"(d0 * 2048 + 512) : "memory"); } } while (0)
#define ATT_VRD(slot_) do { const int va_ = vb0 + (slot_) * SLOTB; \
        _Pragma("unroll") for (int i = 0; i < 8; ++i) { \
            asm volatile("ds_read_b64_tr_b16 %0, %1 offset:%c2" : "=v"(vlo[i]) : "v"(va_), "i"((i >> 2) * 4096 + (i & 3) * 1024) : "memory"); \
            asm volatile("ds_read_b64_tr_b16 %0, %1 offset:%c2" : "=v"(vhi[i]) : "v"(va_), "i"((i >> 2) * 4096 + (i & 3) * 1024 + 512) : "memory"); } } while (0)
    bf16x8 ai[2];
#pragma unroll
    for (int s = 0; s < 2; ++s)
#pragma unroll
        for (int e = 0; e < 8; ++e) ai[s][e] = (r32 == 16 * s + 8 * hi + e) ? (short)0xFE80 : (short)0;
#define ATT_MB(MB, slot_) do { \
        const unsigned dw_ = ~*(const LAS unsigned*)(shm + LDS_M + (slot_) * MSLOTB + wid * 256 + r32 * 8 + hi * 4); \
        const unsigned s5_ = dw_ << 5, s10_ = dw_ << 10, s1_ = dw_ >> 1; \
        _Pragma("unroll") for (int i = 0; i < 16; ++i) { \
            const unsigned w_ = (i < 5) ? (s10_ & (0x00010001u << (i + 10))) : (i < 10) ? (s5_ & (0x00010001u << (i + 5))) : (i < 15) ? (dw_ & (0x00010001u << i)) : (s1_ & 0x40004000u); \
            MB[i >> 2][i & 3] = w_; } } while (0)
#define ATT_QK8(C0, C1, MB) do { \
        C0 = __builtin_amdgcn_mfma_f32_32x32x16_bf16(ai[0], __builtin_bit_cast(bf16x8, MB[0]), f32x16{}, 0, 0, 0); C1 = __builtin_amdgcn_mfma_f32_32x32x16_bf16(ai[0], __builtin_bit_cast(bf16x8, MB[2]), f32x16{}, 0, 0, 0); \
        C0 = __builtin_amdgcn_mfma_f32_32x32x16_bf16(ai[1], __builtin_bit_cast(bf16x8, MB[1]), C0, 0, 0, 0); C1 = __builtin_amdgcn_mfma_f32_32x32x16_bf16(ai[1], __builtin_bit_cast(bf16x8, MB[3]), C1, 0, 0, 0); \
        _Pragma("unroll") for (int d0 = 0; d0 < 4; ++d0) { C0 = __builtin_amdgcn_mfma_f32_32x32x16_bf16(kf[2 * d0], qr[d0], C0, 0, 0, 0); C1 = __builtin_amdgcn_mfma_f32_32x32x16_bf16(kf[2 * d0 + 1], qr[d0], C1, 0, 0, 0); } } while (0)
#define ATT_VF(i) (bf16x8){vlo[i][0], vlo[i][1], vlo[i][2], vlo[i][3], vhi[i][0], vhi[i][1], vhi[i][2], vhi[i][3]}
    f32x16 c0, c1;
    const int my_nt = 4 * qb + (wid >> 1) + 1;
    u32x4 mb[4]; u32x4 pw0, pw1, pw2, pw3;
#define ATT_RE(t_, slot_, slot1_) do { if ((t_) < my_nt) { \
        if ((t_) + 1 < my_nt) ATT_KRD(slot1_);                        \
        ATT_VRD(slot_); \
        ATT_SBAR(); \
        _Pragma("unroll") for (int r = 0; r < 16; ++r) { c0[r] = __builtin_amdgcn_exp2f(c0[r]); c1[r] = __builtin_amdgcn_exp2f(c1[r]); } \
        pw0 = (u32x4){cvtpk(c0[0], c0[1]), cvtpk(c0[2], c0[3]), cvtpk(c0[4], c0[5]), cvtpk(c0[6], c0[7])}; \
        pw1 = (u32x4){cvtpk(c0[8], c0[9]), cvtpk(c0[10], c0[11]), cvtpk(c0[12], c0[13]), cvtpk(c0[14], c0[15])}; \
        pw2 = (u32x4){cvtpk(c1[0], c1[1]), cvtpk(c1[2], c1[3]), cvtpk(c1[4], c1[5]), cvtpk(c1[6], c1[7])}; \
        pw3 = (u32x4){cvtpk(c1[8], c1[9]), cvtpk(c1[10], c1[11]), cvtpk(c1[12], c1[13]), cvtpk(c1[14], c1[15])}; \
        if ((t_) + 1 < my_nt) ATT_MB(mb, slot1_); \
        asm volatile("s_waitcnt lgkmcnt(0)" ::: "memory"); ATT_SBAR(); } } while (0)
#define ATT_MM(t_) do { if ((t_) < my_nt) { __builtin_amdgcn_s_setprio(1);      \
        o[0] = __builtin_amdgcn_mfma_f32_32x32x16_bf16(__builtin_bit_cast(bf16x8, pw0), ATT_VF(0), o[0], 0, 0, 0); \
        o[1] = __builtin_amdgcn_mfma_f32_32x32x16_bf16(__builtin_bit_cast(bf16x8, pw0), ATT_VF(4), o[1], 0, 0, 0); \
        o[0] = __builtin_amdgcn_mfma_f32_32x32x16_bf16(__builtin_bit_cast(bf16x8, pw1), ATT_VF(1), o[0], 0, 0, 0); \
        o[1] = __builtin_amdgcn_mfma_f32_32x32x16_bf16(__builtin_bit_cast(bf16x8, pw1), ATT_VF(5), o[1], 0, 0, 0); \
        o[0] = __builtin_amdgcn_mfma_f32_32x32x16_bf16(__builtin_bit_cast(bf16x8, pw2), ATT_VF(2), o[0], 0, 0, 0); \
        o[1] = __builtin_amdgcn_mfma_f32_32x32x16_bf16(__builtin_bit_cast(bf16x8, pw2), ATT_VF(6), o[1], 0, 0, 0); \
        o[0] = __builtin_amdgcn_mfma_f32_32x32x16_bf16(__builtin_bit_cast(bf16x8, pw3), ATT_VF(3), o[0], 0, 0, 0); \
        o[1] = __builtin_amdgcn_mfma_f32_32x32x16_bf16(__builtin_bit_cast(bf16x8, pw3), ATT_VF(7), o[1], 0, 0, 0); \
          \
        lsum = __builtin_amdgcn_mfma_f32_32x32x16_bf16(__builtin_bit_cast(bf16x8, pw0), ones8, lsum, 0, 0, 0); \
        lsum = __builtin_amdgcn_mfma_f32_32x32x16_bf16(__builtin_bit_cast(bf16x8, pw1), ones8, lsum, 0, 0, 0); \
        lsum = __builtin_amdgcn_mfma_f32_32x32x16_bf16(__builtin_bit_cast(bf16x8, pw2), ones8, lsum, 0, 0, 0); \
        lsum = __builtin_amdgcn_mfma_f32_32x32x16_bf16(__builtin_bit_cast(bf16x8, pw3), ones8, lsum, 0, 0, 0); \
        if ((t_) + 1 < my_nt) ATT_QK8(c0, c1, mb); __builtin_amdgcn_s_setprio(0); } } while (0)
    ATT_WAIT_BAR(6);
    { ATT_KRD(0); ATT_MB(mb, 0);
      asm volatile("s_waitcnt lgkmcnt(0)" ::: "memory"); ATT_SBAR();
      ATT_QK8(c0, c1, mb); }
    int slot = 0;
    const bool halfB = (wid >= 4);
#define ATT_STEP_BAR(t_) do { if ((t_) + 2 < NT) ATT_WAIT_BAR(3); else ATT_WAIT_BAR(0);       \
        if ((t_) + 3 < NT) { const int s3 = (slot == 0) ? NSLOT - 1 : slot - 1; ATT_DMA((t_) + 3, s3); } } while (0)
#pragma unroll 1
    for (int t = 0; t < NT; ++t) {
        const int slot1 = (slot == NSLOT - 1) ? 0 : slot + 1;
        if (halfB) ATT_STEP_BAR(t);
        if (t > 0) ATT_MM(t - 1);
        if (!halfB) ATT_STEP_BAR(t);
        ATT_RE(t, slot, slot1);
        slot = slot1;
    }
    ATT_MM(NT - 1);
#undef ATT_STEP_BAR
#undef ATT_RE
#undef ATT_MM
#undef ATT_KRD
#undef ATT_VRD
#undef ATT_MB
#undef ATT_QK8
#undef ATT_VF
    float rli[16]; bool bad = false;
#pragma unroll
    for (int r = 0; r < 16; ++r) { bad = bad || !(lsum[r] > 0.f && lsum[r] < 1.0e37f); rli[r] = __builtin_amdgcn_rcpf(lsum[r]); }
    { const unsigned anyb = __any(bad) ? 1u : 0u; if (lane == 0) ((LAS unsigned*)(shm + LDS_FLAG))[wid] = anyb; }
    bf16* Ow = O + (rowbase + q0 + wid * 32) * 1024 + h * 64;
    { LAS bf16* stg = (LAS bf16*)(shm + LDS_OST) + wid * 2048;
#pragma unroll
      for (int r = 0; r < 16; ++r) { const int orow = crow(r, hi);
#pragma unroll
          for (int d0 = 0; d0 < 2; ++d0) stg[orow * 64 + d0 * 32 + r32] = (bf16)f2bf(o[d0][r] * rli[r]); }
      asm volatile("s_waitcnt lgkmcnt(0)" ::: "memory");
#pragma unroll
      for (int i = 0; i < 4; ++i) { const int row = i * 8 + (lane >> 3), ch = lane & 7; const u32x4 v = *(const LAS u32x4*)(stg + row * 64 + ch * 8); *(u32x4*)(Ow + (size_t)row * 1024 + ch * 8) = v; } }
    asm volatile("s_waitcnt lgkmcnt(0)\n\ts_barrier" ::: "memory");
    { const LAS unsigned* fl = (const LAS unsigned*)(shm + LDS_FLAG); redo = (fl[0] | fl[1] | fl[2] | fl[3] | fl[4] | fl[5] | fl[6] | fl[7]) != 0u; }
    asm volatile("s_waitcnt lgkmcnt(0)\n\ts_barrier" ::: "memory");
    }
#undef ATT_DMA
    return redo;
}
#undef ATT_WAIT_BAR
#undef ATT_SBAR
}
struct Args { const float* in[11]; float* out; unsigned char* ws; };

#define XB_TMO      128
#define XB_XCNT(j)  (256  + 64 * (j))
#define XB_XSUB(j)  (1280 + 64 * (j))
#define XB_XGEN(j)  (2304 + 64 * (j))
#define XB_TOP      3328
#define XB_TOPGEN   3392
#define XCD_BAR_WORDS 3456
#define XB_SPIN_CAP (1u << 18)

__device__ __forceinline__ unsigned xb_ld(unsigned* p)              { return __hip_atomic_load((GAS unsigned*)p, __ATOMIC_RELAXED, __HIP_MEMORY_SCOPE_AGENT); }
__device__ __forceinline__ unsigned xb_add(unsigned* p, unsigned v) { return __hip_atomic_fetch_add((GAS unsigned*)p, v, __ATOMIC_RELAXED, __HIP_MEMORY_SCOPE_AGENT); }
__device__ __forceinline__ unsigned xb_xcc_id() { return (unsigned)__builtin_amdgcn_s_getreg((3 << 11) | 20) & 0xFu; }
#define XB_SPIN(cond, bar) do { unsigned _sp = 0; while (cond) { __builtin_amdgcn_s_sleep(1); \
    if ((++_sp & 255u) == 0u) { if (xb_ld(&(bar)[XB_TMO])) break; if (_sp > XB_SPIN_CAP) { atomicAdd(&(bar)[XB_TMO], 1u); break; } } } } while (0)

struct XcdBarrier {
    unsigned* bar; unsigned x;
    volatile LAS unsigned* st;
};

__device__ __forceinline__ XcdBarrier xcd_barrier_post(unsigned* bar, volatile LAS unsigned* st, const int wave) {
    XcdBarrier b; b.bar = bar; b.x = xb_xcc_id(); b.st = st;
    if (wave == 0 && pg8::lane_now() == 0) (void)xb_add(&bar[XB_XCNT(b.x)], 1u);
    return b;
}
__device__ __forceinline__ void xcd_barrier_complete(unsigned* bar, unsigned x, unsigned& nloc, unsigned& nx) {
    const unsigned G = gridDim.x * gridDim.y * gridDim.z;
    unsigned sum, cnt, mine, sp = 0u;
    for (;;) {
        sum = 0u; cnt = 0u; mine = 0u;
#pragma unroll 1
        for (unsigned j = 0; j < 16; ++j) { const unsigned c = xb_ld(&bar[XB_XCNT(j)]); sum += c; cnt += (c > 0u) ? 1u : 0u; mine = (j == x) ? c : mine; }
        if (sum == G) break;
        __builtin_amdgcn_s_sleep(1);
        if ((++sp & 255u) == 0u) { if (xb_ld(&bar[XB_TMO])) break; if (sp > XB_SPIN_CAP) { atomicAdd(&bar[XB_TMO], 1u); break; } }
    }
    nloc = mine > 0u ? mine : 1u; nx = cnt > 0u ? cnt : 1u;
}

__device__ __forceinline__ void xcd_barrier(const XcdBarrier& b, const int wave) {
    asm volatile("s_waitcnt vmcnt(0)" ::: "memory");
    __syncthreads();
    if (wave == 0 && pg8::lane_now() == 0) {
        unsigned* bar = b.bar;
        __builtin_amdgcn_s_waitcnt(0);
        unsigned nloc = b.st[0], nx = b.st[1];
        if (nloc == 0u) { xcd_barrier_complete(bar, b.x, nloc, nx); b.st[0] = nloc; b.st[1] = nx; }
        const unsigned old = xb_add(&bar[XB_XSUB(b.x)], 1u);
        const unsigned gen = old / nloc;
        if (old + 1u == (gen + 1u) * nloc) {
            __builtin_amdgcn_fence(__ATOMIC_RELEASE, "agent");
            asm volatile("s_waitcnt vmcnt(0)" ::: "memory");
            (void)xb_add(&bar[XB_TOP], 1u);
            XB_SPIN(xb_ld(&bar[XB_TOP]) < nx * (gen + 1u), bar);
            __builtin_amdgcn_fence(__ATOMIC_ACQUIRE, "agent");
            asm volatile("s_waitcnt vmcnt(0)" ::: "memory");
        } else {
            XB_SPIN(xb_ld(&bar[XB_TOP]) < nx * (gen + 1u), bar);
            __builtin_amdgcn_fence(__ATOMIC_ACQUIRE, "agent");
            asm volatile("s_waitcnt vmcnt(0)" ::: "memory");
        }
    }
    __syncthreads();
}

constexpr int CW_WIN = 16 * (NPALL / 64), CW_EARLY = CW_WIN + 8 * 16 + 8 * 16 + 16 * 16, CW_LAYER = CW_EARLY + 16 * 64 + 64 * 16;
__device__ __forceinline__ void convert_weights(const Args& a, LAS unsigned char* lds, int wave, int lane, int gw, int NGW, int l, int r_lo, int r_hi) {
    unsigned char* ws = a.ws;
    LAS unsigned char* scr = lds + RING_OFF + wave * 16384;
    constexpr int I_IN = 16 * (NPALL / 64), I_AO = 8 * 16, I_CO = 8 * 16, I_MX = 16 * 16, I_UP = 16 * 64, I_DN = 64 * 16;
    constexpr int I_LAYER = I_IN + I_AO + I_CO + I_MX + I_UP + I_DN;
    static_assert(I_LAYER == CW_LAYER && I_IN + I_AO + I_CO + I_MX == CW_EARLY, "weight item space");
    for (int it = r_lo + gw; it < r_hi; it += NGW) {
        int r = it;
        if (r < I_IN) { const int nb = r % (NPALL / 64), kb = r / (NPALL / 64);
            transpose_item<true>(a.in[2] + (size_t)l * D_MODEL * IN_COLS, IN_COLS, (bf16*)(ws + WS_WIN) + (size_t)l * NPALL * 1024, 1024, 0, kb * 64, nb * 64, scr, lane, a.in[1] + l * D_MODEL); continue; } r -= I_IN;
        if (r < I_AO) { const int nb = r % 16, kb = r / 16;
            transpose_item<false>(a.in[4] + (size_t)l * 512 * 1024, 1024, (bf16*)(ws + WS_WOC) + (size_t)l * 1024 * 1024, 1024, 0, kb * 64, nb * 64, scr, lane); continue; } r -= I_AO;
        if (r < I_CO) { const int nb = r % 16, kb = r / 16;
            transpose_item<false>(a.in[5] + (size_t)l * 512 * 1024, 1024, (bf16*)(ws + WS_WOC) + (size_t)l * 1024 * 1024, 1024, 512, kb * 64, nb * 64, scr, lane); continue; } r -= I_CO;
        if (r < I_MX) { const int nb = r % 16, kb = r / 16;
            transpose_item<false>(a.in[6] + (size_t)l * 1024 * 1024, 1024, (bf16*)(ws + WS_WMIX) + (size_t)l * 1024 * 1024, 1024, 0, kb * 64, nb * 64, scr, lane); continue; } r -= I_MX;
        if (r < I_UP) { const int nb = r % 64, kb = r / 64;
            transpose_item<false>(a.in[8] + (size_t)l * 1024 * 4096, 4096, (bf16*)(ws + WS_WUP) + (size_t)l * 4096 * 1024, 1024, 0, kb * 64, nb * 64, scr, lane, a.in[7] + l * D_MODEL); continue; } r -= I_UP;
        { const int nb = r % 16, kb = r / 16;
            transpose_item<false>(a.in[9] + (size_t)l * 4096 * 1024, 1024, (bf16*)(ws + WS_WDN) + (size_t)l * 1024 * 4096, 4096, 0, kb * 64, nb * 64, scr, lane); }
    }
}
__device__ __forceinline__ void p0_prologue(const Args& a, LAS unsigned char* lds, int wave, int lane, int vcu, int G) {
    unsigned char* ws = a.ws;
    const int gw = vcu * NWAVES + wave, NGW = G * NWAVES;
    convert_weights(a, lds, wave, lane, gw, NGW, 0, 0, CW_WIN);
    float* cs = (float*)(ws + WS_CS);
    for (int i = gw * 64 + lane; i < SEQ * 8; i += NGW * 64) { const int t = i >> 3, j = i & 7; float s, c; sincos_acc((float)t * rope_inv(j), s, c); cs[i] = c; cs[SEQ * 8 + i] = s; }
    for (int m = gw; m < MROWS; m += 2 * NGW) {
        const int m2 = m + NGW;
        if (m2 < MROWS) xg_row2(a.in[0] + (size_t)m * D_MODEL, a.in[0] + (size_t)m2 * D_MODEL, (bf16*)(ws + WS_XG) + (size_t)m * D_MODEL, (bf16*)(ws + WS_XG) + (size_t)m2 * D_MODEL, (float*)(ws + WS_ROWSQ), m, m2, lane);
        else xg_row(a.in[0] + (size_t)m * D_MODEL, a.in[1], (bf16*)(ws + WS_XG) + (size_t)m * D_MODEL, (float*)(ws + WS_ROWSQ), m, lane); }
}

constexpr int CW_PANEL = 8192;
constexpr int CW_BAR = 4096;
static_assert((CW_BAR + XCD_BAR_WORDS) * 4 <= 65536, "barrier words inside the per-call memset");
constexpr int CW_XTAB = 7680;
constexpr int CW_GROUP = 12288;
static_assert(CW_BAR + XCD_BAR_WORDS <= CW_XTAB && CW_XTAB + 256 <= CW_PANEL && CW_PANEL + 64 * 64 <= CW_GROUP && (CW_GROUP + 64 * 64) * 4 <= 65536, "control words inside the per-call memset");
#define RSTD_TABLE(S_) do { pg8::Unit u0_; if (S_.next(0, u0_)) { const int t_ = wave * 64 + lane; \
        if (t_ < 256) { const float* rq_ = (const float*)(ws + WS_ROWSQ) + (size_t)u0_.pm * 256 + t_; \
            ((LAS float*)(lds + RSTD_OFF))[t_] = __builtin_amdgcn_rsqf(((rq_[0] + rq_[MROWS]) + (rq_[2 * MROWS] + rq_[3 * MROWS])) * (1.0f / 1024.0f) + 1e-6f); } } \
        __syncthreads(); } while (0)
__global__ void __launch_bounds__(NWAVES * 64, 2) mk_fwd(Args args) {
    extern __shared__ __attribute__((aligned(16))) unsigned char lds_raw[];
    LAS unsigned char* lds = (LAS unsigned char*)lds_raw;
    const int wave = __builtin_amdgcn_readfirstlane(threadIdx.x >> 6);
#define lane (pg8::lane_now())
    const int G = gridDim.x; const int bx = blockIdx.x; const int vcu = (G % 8 == 0) ? (bx % 8) * (G / 8) + bx / 8 : bx;
    unsigned char* const ws0 = args.ws;
    unsigned char* ws = ws0;
#define WS_FRESH() size_t wz_ = 0; asm volatile("" : "+s"(wz_)); unsigned char* ws = ws0 + wz_
    if (wave == 0) ((LAS unsigned*)(lds + MISC_OFF))[lane] = 0u;
    __syncthreads();
    const XcdBarrier bar = xcd_barrier_post((unsigned*)(ws + WS_CTL) + CW_BAR, (volatile LAS unsigned*)(lds + MISC_OFF) + 8, wave);
#define GRID_BAR() do { XcdBarrier b_ = bar; size_t bz_ = 0; asm volatile("" : "+s"(bz_)); b_.bar = bar.bar + bz_; xcd_barrier(b_, wave); } while (0)
    if (wave == 0 && lane == 0) __hip_atomic_store((GAS unsigned*)((unsigned*)(ws + WS_CTL) + CW_XTAB) + blockIdx.x, bar.x + 1u, __ATOMIC_RELAXED, __HIP_MEMORY_SCOPE_AGENT);
    p0_prologue(args, lds, wave, lane, vcu, G);
    GRID_BAR();
    bool group_ok = false;
    if (G == 256) { const unsigned* xt_ = (const unsigned*)(ws + WS_CTL) + CW_XTAB; const int l_ = lane;
        const unsigned x0_ = xb_ld((unsigned*)xt_ + l_), x1_ = xb_ld((unsigned*)xt_ + l_ + 64), x2_ = xb_ld((unsigned*)xt_ + l_ + 128), x3_ = xb_ld((unsigned*)xt_ + l_ + 192);
        group_ok = __all((x0_ != 0u) && (x0_ == x1_) && (x0_ == x2_) && (x0_ == x3_)) != 0; }
    unsigned grp_epoch = 0u;
#define GROUP_BAR() do { if (!group_ok) { GRID_BAR(); break; } \
        asm volatile("s_waitcnt vmcnt(0)" ::: "memory"); __syncthreads();                    \
        grp_epoch += 1u; \
        if (wave == 0) { if (lane == 0) { unsigned* c_ = (unsigned*)(ws0 + WS_CTL) + CW_GROUP + 64 * ((int)blockIdx.x & 63); \
                (void)xb_add(c_, 1u); unsigned sp_ = 0u; \
                while (xb_ld(c_) < 4u * grp_epoch) { __builtin_amdgcn_s_sleep(1); if (++sp_ > XB_SPIN_CAP) break; } } \
            __builtin_amdgcn_fence(__ATOMIC_ACQUIRE, "agent"); asm volatile("s_waitcnt vmcnt(0)" ::: "memory"); }     \
        __syncthreads(); } while (0)
#pragma unroll 1
    for (int L = 0; L < DEPTH; ++L) {
    {   WS_FRESH();
        pg8::Gemm g{(const bf16*)(ws + WS_XG), (const bf16*)(ws + WS_WIN) + (size_t)L * NPALL * 1024, MROWS, NP1, D_MODEL};
        pg8::StaticOrder S; S.init(MROWS, NP1, G, (int)blockIdx.x);
        RSTD_TABLE(S);
        pg8::EpiProj E{(const LAS float*)(lds + RSTD_OFF), (const float*)(ws + WS_CS), (bf16*)(ws + WS_Q), (bf16*)(ws + WS_K), (bf16*)(ws + WS_V), (bf16*)(ws + WS_IQ), (bf16*)(ws + WS_IK),
                       (bf16*)(ws + WS_CB), (bf16*)(ws + WS_P), (float*)(ws + WS_IW)};
        pg8::gemm_phase<pg8::EpiProj, pg8::StaticOrder, true, true>(lds + RING_OFF, g, S, E, wave);
        { pg8::Unit ux; if (!S.next(3, ux)) {
            const int nidle = G - (MROWS / 256 * (NP1 / 256) - 3 * G), rank = (int)blockIdx.x - (G - nidle);
            if (nidle > 0 && rank >= 0) {
                convert_weights(args, lds, wave, lane, rank * NWAVES + wave, nidle * NWAVES, L, CW_WIN, CW_LAYER);
                if (L + 1 < DEPTH) convert_weights(args, lds, wave, lane, rank * NWAVES + wave, nidle * NWAVES, L + 1, 0, CW_WIN); } } }
    }
    GRID_BAR();
    {   WS_FRESH();
        {   const int nid = (512 - vcu + G - 1) / G;
            sel::sel_pipeline(lds, 2 * nid, [&](int i) { const int id = vcu + (i >> 1) * G; const int b = id >> 7, pp = id & 127; return sel::sel_mk(b, (i & 1) ? pp : 255 - pp); },
                              (const bf16*)(ws + WS_IQ), (const bf16*)(ws + WS_IK), (const float*)(ws + WS_IW), (unsigned long long*)(ws + WS_MASK), wave); }
        for (int rb = vcu * 64; rb < MROWS; rb += G * 64)
            sel::convmid_rows((const bf16*)(ws + WS_CB), (const bf16*)(ws + WS_P), args.in[3] + (size_t)L * 3 * 512, (bf16*)(ws + WS_A2), rb, wave);
    }
    GRID_BAR();
    {   WS_FRESH();
        for (int u = vcu; u < 512; u += G) { const int bh = (u & 255) >> 3, s = u & 7, qb = (u >> 8) ? s : 15 - s;
            if (att::attn_unit<false>(bh >> 3, bh & 7, qb, (const bf16*)(ws + WS_Q), (const bf16*)(ws + WS_K), (const bf16*)(ws + WS_V), (const unsigned long long*)(ws + WS_MASK), (bf16*)(ws + WS_A2), lds, wave))
                (void)att::attn_unit<true>(bh >> 3, bh & 7, qb, (const bf16*)(ws + WS_Q), (const bf16*)(ws + WS_K), (const bf16*)(ws + WS_V), (const unsigned long long*)(ws + WS_MASK), (bf16*)(ws + WS_A2), lds, wave); }
    }
    GRID_BAR();
    {   WS_FRESH();
        pg8::Gemm g{(const bf16*)(ws + WS_XG), (const bf16*)(ws + WS_WIN) + (size_t)L * NPALL * 1024 + (size_t)NP1 * 1024, MROWS, NPG, D_MODEL};
        pg8::StaticOrder S; S.init(MROWS, NPG, G, (int)blockIdx.x);
        RSTD_TABLE(S);
        pg8::EpiSig E{(const LAS float*)(lds + RSTD_OFF), (bf16*)(ws + WS_SG)};
        pg8::gemm_phase<pg8::EpiSig, pg8::StaticOrder, true, true>(lds + RING_OFF, g, S, E, wave);
    }
    GROUP_BAR();
    {   WS_FRESH();
        pg8::Gemm g{(const bf16*)(ws + WS_A2), (const bf16*)(ws + WS_WOC) + (size_t)L * 1024 * 1024, MROWS, D_MODEL, 1024};
        pg8::StaticOrder S; S.init(MROWS, D_MODEL, G, (int)blockIdx.x);
        pg8::EpiMerged E{(const bf16*)(ws + WS_SG), (bf16*)(ws + WS_MERGED)};
        pg8::gemm_phase<pg8::EpiMerged, pg8::StaticOrder, true, true>(lds + RING_OFF, g, S, E, wave);
    }
    GROUP_BAR();
    {   WS_FRESH();
        pg8::Gemm g{(const bf16*)(ws + WS_MERGED), (const bf16*)(ws + WS_WMIX) + (size_t)L * 1024 * 1024, MROWS, D_MODEL, 1024};
        pg8::StaticOrder S; S.init(MROWS, D_MODEL, G, (int)blockIdx.x);
        pg8::EpiResid E{(bf16*)(ws + WS_XG), (float*)nullptr, (float*)(ws + WS_ROWSQ), (const float*)nullptr, (unsigned*)nullptr, 0};
        pg8::gemm_phase<pg8::EpiResid, pg8::StaticOrder, false, true>(lds + RING_OFF, g, S, E, wave);
    }
    GRID_BAR();
    {   WS_FRESH();
        pg8::Gemm g{(const bf16*)(ws + WS_XG), (const bf16*)(ws + WS_WUP) + (size_t)L * 4096 * 1024, MROWS, MLP_H, D_MODEL};
        pg8::StaticOrder S; S.init(MROWS, MLP_H, G, (int)blockIdx.x);
        RSTD_TABLE(S);
        pg8::EpiRelu2 E{(const LAS float*)(lds + RSTD_OFF), (bf16*)(ws + WS_H)};
        pg8::gemm_phase<pg8::EpiRelu2, pg8::StaticOrder, true, true>(lds + RING_OFF, g, S, E, wave);
    }
    GROUP_BAR();
    {   WS_FRESH();
        pg8::Gemm g{(const bf16*)(ws + WS_H), (const bf16*)(ws + WS_WDN) + (size_t)L * 1024 * 4096, MROWS, D_MODEL, MLP_H};
        pg8::StaticOrder S; S.init(MROWS, D_MODEL, G, (int)blockIdx.x);
        pg8::EpiResid E{(bf16*)(ws + WS_XG), (L + 1 < DEPTH) ? (float*)nullptr : args.out, (float*)(ws + WS_ROWSQ), args.in[10], (unsigned*)(ws + WS_CTL) + CW_PANEL, group_ok ? 1 : 0};
        pg8::gemm_phase<pg8::EpiResid, pg8::StaticOrder, false, true>(lds + RING_OFF, g, S, E, wave);
    }
    if (L + 1 < DEPTH) GRID_BAR();
    }
#undef GROUP_BAR
#undef GRID_BAR
#undef lane
}

extern "C" void kernel_launch(void* const* d_in, const int* in_sizes, int n_in, void* d_out, int out_size, void* d_ws, size_t ws_size, hipStream_t stream) {
    static int grid = 0;
    if (grid == 0) {
        int dev = 0, cus = 0, per_cu = 0;
        if (n_in != 11 || out_size != MROWS * D_MODEL || ws_size < WS_END) { fprintf(stderr, "kernel_launch: unexpected problem shape / workspace (%d inputs, out %d, ws %zu)\n", n_in, out_size, ws_size); grid = -1; return; }
        if (hipGetDevice(&dev) != hipSuccess || hipDeviceGetAttribute(&cus, hipDeviceAttributeMultiprocessorCount, dev) != hipSuccess) { grid = -1; return; }
        if (hipFuncSetAttribute((const void*)mk_fwd, hipFuncAttributeMaxDynamicSharedMemorySize, LDS_BYTES) != hipSuccess) { fprintf(stderr, "kernel_launch: hipFuncSetAttribute failed\n"); grid = -1; return; }
        if (hipOccupancyMaxActiveBlocksPerMultiprocessor(&per_cu, (const void*)mk_fwd, NWAVES * 64, LDS_BYTES) != hipSuccess || per_cu < 1) { fprintf(stderr, "kernel_launch: the occupancy query admits %d workgroups per CU; nothing launched\n", per_cu); grid = -1; return; }
        (void)hipGetLastError();
        grid = cus;
    }
    if (grid < 0) return;
    if (hipMemsetAsync((char*)d_ws + WS_CTL, 0, 65536, stream) != hipSuccess) { fprintf(stderr, "kernel_launch: hipMemsetAsync failed\n"); return; }
    Args a{};
    for (int i = 0; i < 11; ++i) a.in[i] = (const float*)d_in[i];
    a.out = (float*)d_out; a.ws = (unsigned char*)d_ws;
    hipLaunchKernelGGL(mk_fwd, dim3(grid), dim3(NWAVES * 64), LDS_BYTES, stream, a);
}
```
